# Optimizing an MI355X kernel written in HIP

```python
import math
import jax, jax.numpy as jnp
from jax import lax
import numpy as np

D_MODEL = 2048
BATCH = 1
SEQ = 8192
DEPTH = 2

DN_HEADS = 8
DN_HEAD_DIM = 128
DN_WIDTH = DN_HEADS * DN_HEAD_DIM
CONV_WIDTH = 4
DN_CHUNK = 64
SA_HEADS = 8
SA_HEAD_DIM = 128
SA_WIDTH = SA_HEADS * SA_HEAD_DIM
IDX_HEADS = 16
IDX_HEAD_DIM = 64
TOPK_MAX = 256
Q_BLOCK = 128
ROPE_THETA = 10000.0
D_FF = 5632
N_EXPERTS = 8
TOP_K_EXPERTS = 2
D_FF_EXPERT = 2816
RMS_EPS = 1e-6
L2_EPS = 1e-6

SPLITS = (3 * DN_WIDTH, DN_WIDTH, DN_HEADS, DN_HEADS,
          SA_WIDTH, SA_WIDTH, SA_WIDTH,
          IDX_HEADS * IDX_HEAD_DIM, IDX_HEAD_DIM, IDX_HEADS,
          D_MODEL, D_MODEL)
IN_WIDTH = sum(SPLITS)

kernel_name = "hybrid_deltanet_dsa_moe"


def rms_norm(x, gain):
    xf = x.astype(jnp.float32)
    y = xf * lax.rsqrt(jnp.mean(xf * xf, axis=-1, keepdims=True) + RMS_EPS)
    return (y * gain.astype(jnp.float32)).astype(x.dtype)


def l2_normalize(x):
    return x * lax.rsqrt(jnp.sum(x * x, axis=-1, keepdims=True) + L2_EPS)


def rope_tables(positions, dim):
    inv_freq = ROPE_THETA ** (-jnp.arange(0, dim, 2, dtype=jnp.float32) / dim)
    ang = positions.astype(jnp.float32)[..., None] * inv_freq
    return jnp.cos(ang), jnp.sin(ang)


def apply_rope(x, cos, sin):
    xf = x.astype(jnp.float32)
    x1, x2 = jnp.split(xf, 2, axis=-1)
    c = cos[:, :, None, :]
    s = sin[:, :, None, :]
    return jnp.concatenate([x1 * c - x2 * s, x2 * c + x1 * s], axis=-1).astype(x.dtype)


def causal_depthwise_conv(x, w):
    c = x.shape[-1]
    return lax.conv_general_dilated(
        x, w[:, None, :].astype(x.dtype), window_strides=(1,),
        padding=[(CONV_WIDTH - 1, 0)], dimension_numbers=("NWC", "WIO", "NWC"),
        feature_group_count=c)


def gated_delta_rule(q, k, v, g, beta):
    B, S, H, Dk = q.shape
    Dv = v.shape[-1]
    n = S // DN_CHUNK

    def to_chunks(t):
        return t.reshape(B, n, DN_CHUNK, H, t.shape[-1]).transpose(1, 0, 3, 2, 4)

    qc, kc, vc = to_chunks(q), to_chunks(k), to_chunks(v)
    gc = jnp.cumsum(g.reshape(B, n, DN_CHUNK, H).transpose(1, 0, 3, 2), axis=-1)
    bc = beta.reshape(B, n, DN_CHUNK, H).transpose(1, 0, 3, 2)

    tril = jnp.tril(jnp.ones((DN_CHUNK, DN_CHUNK), dtype=bool))
    strict = jnp.tril(jnp.ones((DN_CHUNK, DN_CHUNK), dtype=bool), -1)
    eye = jnp.eye(DN_CHUNK, dtype=jnp.float32)
    decay_mat = jnp.exp(jnp.where(tril, gc[..., :, None] - gc[..., None, :], -jnp.inf))

    kb = kc * bc[..., None]
    a_strict = jnp.where(strict, jnp.einsum("nbhcd,nbhsd->nbhcs", kb, kc) * decay_mat, 0.0)
    m = a_strict + eye
    w_c = lax.linalg.triangular_solve(m, kb * jnp.exp(gc)[..., None], left_side=True,
                                      lower=True, unit_diagonal=True)
    u_c = lax.linalg.triangular_solve(m, vc * bc[..., None], left_side=True,
                                      lower=True, unit_diagonal=True)
    attn_intra = jnp.where(tril, jnp.einsum("nbhcd,nbhsd->nbhcs", qc, kc) * decay_mat, 0.0)
    q_dec = qc * jnp.exp(gc)[..., None]
    k_dec = kc * jnp.exp(gc[..., -1:] - gc)[..., None]
    g_last = jnp.exp(gc[..., -1])

    def step(state, inp):
        qd, kd, wc, uc, att, gl = inp
        v_new = uc - jnp.einsum("bhcd,bhde->bhce", wc, state)
        o = jnp.einsum("bhcd,bhde->bhce", qd, state) + jnp.einsum("bhcs,bhse->bhce", att, v_new)
        state = state * gl[..., None, None] + jnp.einsum("bhcd,bhce->bhde", kd, v_new)
        return state, o

    s0 = jnp.zeros((B, H, Dk, Dv), jnp.float32)
    _, o = lax.scan(step, s0, (q_dec, k_dec, w_c, u_c, attn_intra, g_last))
    return o.transpose(1, 0, 3, 2, 4).reshape(B, S, H, Dv)


def dsa_sparse_attention(q, k, v, q_idx, k_idx, w_idx):
    B, S, H, Dh = q.shape
    n_keys = S
    topk = min(TOPK_MAX, n_keys // 4)
    n_blocks = S // Q_BLOCK
    key_pos = jnp.arange(n_keys)
    k_idx_f = k_idx.astype(jnp.float32)
    scale = Dh ** -0.5
    gather = jax.vmap(lambda t, i: t[i])

    def block(i):
        start = i * Q_BLOCK
        qb = lax.dynamic_slice_in_dim(q, start, Q_BLOCK, axis=1)
        qib = lax.dynamic_slice_in_dim(q_idx, start, Q_BLOCK, axis=1).astype(jnp.float32)
        wb = lax.dynamic_slice_in_dim(w_idx, start, Q_BLOCK, axis=1).astype(jnp.float32)
        q_pos = start + jnp.arange(Q_BLOCK)
        rel = jax.nn.relu(jnp.einsum("bqhd,bsd->bqhs", qib, k_idx_f))
        score = jnp.einsum("bqhs,bqh->bqs", rel, wb)
        causal = key_pos[None, :] <= q_pos[:, None]
        score = jnp.where(causal[None], score, -jnp.inf)
        _, sel = lax.top_k(score, topk)
        valid = sel <= q_pos[None, :, None]
        ks = gather(k, sel)
        vs = gather(v, sel)
        logits = jnp.einsum("bqhd,bqkhd->bhqk", qb, ks).astype(jnp.float32) * scale
        logits = jnp.where(valid[:, None], logits, -jnp.inf)
        p = jax.nn.softmax(logits, axis=-1).astype(v.dtype)
        return jnp.einsum("bhqk,bqkhd->bqhd", p, vs)

    out = lax.map(block, jnp.arange(n_blocks))
    return out.transpose(1, 0, 2, 3, 4).reshape(B, S, H, Dh)


def hybrid_mixer(h, cos_sa, sin_sa, cos_ix, sin_ix, w_in, conv_w, a_log, dt_bias, dn_norm,
                 w_dn_out, w_sa_out, w_o):
    B, S, _ = h.shape
    split_points = np.cumsum(SPLITS)[:-1].tolist()
    (qkv_dn, z, a, b, q_sa, k_sa, v_sa, q_ix, k_ix, w_ix, g_dn, g_sa) = jnp.split(
        h @ w_in, split_points, axis=-1)

    qkv = jax.nn.silu(causal_depthwise_conv(qkv_dn, conv_w)).astype(jnp.float32)
    q_dn, k_dn, v_dn = [t.reshape(B, S, DN_HEADS, DN_HEAD_DIM) for t in jnp.split(qkv, 3, axis=-1)]
    q_dn = l2_normalize(q_dn) * (DN_HEAD_DIM ** -0.5)
    k_dn = l2_normalize(k_dn)
    beta = jax.nn.sigmoid(b.astype(jnp.float32))
    g = -jnp.exp(a_log.astype(jnp.float32)) * jax.nn.softplus(
        a.astype(jnp.float32) + dt_bias.astype(jnp.float32))
    o_dn = gated_delta_rule(q_dn, k_dn, v_dn, g, beta)
    o_dn = rms_norm(o_dn, dn_norm) * jax.nn.silu(z.astype(jnp.float32).reshape(B, S, DN_HEADS, DN_HEAD_DIM))
    y_dn = o_dn.reshape(B, S, DN_WIDTH).astype(h.dtype) @ w_dn_out

    q_sa = apply_rope(q_sa.reshape(B, S, SA_HEADS, SA_HEAD_DIM), cos_sa, sin_sa)
    k_sa = apply_rope(k_sa.reshape(B, S, SA_HEADS, SA_HEAD_DIM), cos_sa, sin_sa)
    v_sa = v_sa.reshape(B, S, SA_HEADS, SA_HEAD_DIM)
    q_ix = apply_rope(q_ix.reshape(B, S, IDX_HEADS, IDX_HEAD_DIM), cos_ix, sin_ix)
    k_ix = apply_rope(k_ix[:, :, None, :], cos_ix, sin_ix)[:, :, 0, :]
    w_ix = w_ix * (IDX_HEADS ** -0.5 * IDX_HEAD_DIM ** -0.5)
    o_sa = dsa_sparse_attention(q_sa, k_sa, v_sa, q_ix, k_ix, w_ix)
    y_sa = o_sa.reshape(B, S, SA_WIDTH) @ w_sa_out

    merged = jax.nn.sigmoid(g_dn) * y_dn + jax.nn.sigmoid(g_sa) * y_sa
    return merged @ w_o


def swiglu(h, w_gate, w_up, w_down):
    return (jax.nn.silu(h @ w_gate) * (h @ w_up)) @ w_down


def moe_ffn(h, w_router, w_gate, w_up, w_down):
    B, S, D = h.shape
    t = h.reshape(B * S, D)
    logits = (t @ w_router).astype(jnp.float32)
    top_vals, top_idx = lax.top_k(logits, TOP_K_EXPERTS)
    top_w = jax.nn.softmax(top_vals, axis=-1)
    combine = jnp.sum(jax.nn.one_hot(top_idx, N_EXPERTS, dtype=jnp.float32) * top_w[..., None], axis=1)
    out = jnp.zeros_like(t)
    for e in range(N_EXPERTS):
        out = out + combine[:, e:e + 1].astype(t.dtype) * swiglu(t, w_gate[e], w_up[e], w_down[e])
    return out.reshape(B, S, D)


def setup_inputs(seed: int = 0) -> dict:
    key = jax.random.key(seed)
    ks = jax.random.split(key, 24)
    n_dense = (DEPTH + 1) // 2
    n_moe = DEPTH // 2
    f32 = jnp.float32

    def nrm(k, shape, fan_in):
        return jax.random.normal(k, shape, f32) * (fan_in ** -0.5)

    def gain(k, shape):
        return 1.0 + 0.02 * jax.random.normal(k, shape, f32)

    dt = jnp.exp(jax.random.uniform(ks[6], (DEPTH, DN_HEADS), f32, math.log(1e-3), math.log(1e-1)))
    return {
        "x": jax.random.normal(ks[0], (BATCH, SEQ, D_MODEL), f32),
        "positions": jnp.broadcast_to(jnp.arange(SEQ, dtype=jnp.int32), (BATCH, SEQ)),
        "norm_mix": gain(ks[1], (DEPTH, D_MODEL)),
        "w_in": nrm(ks[2], (DEPTH, D_MODEL, IN_WIDTH), D_MODEL),
        "conv_w": nrm(ks[3], (DEPTH, CONV_WIDTH, 3 * DN_WIDTH), CONV_WIDTH),
        "a_log": jnp.log(jax.random.uniform(ks[4], (DEPTH, DN_HEADS), f32, 1.0, 16.0)),
        "dt_bias": dt + jnp.log(-jnp.expm1(-dt)),
        "dn_norm": gain(ks[5], (DEPTH, DN_HEAD_DIM)),
        "w_dn_out": nrm(ks[7], (DEPTH, DN_WIDTH, D_MODEL), DN_WIDTH),
        "w_sa_out": nrm(ks[8], (DEPTH, SA_WIDTH, D_MODEL), SA_WIDTH),
        "w_o": nrm(ks[9], (DEPTH, D_MODEL, D_MODEL), D_MODEL),
        "norm_ffn": gain(ks[10], (DEPTH, D_MODEL)),
        "dense_w_gate": nrm(ks[11], (n_dense, D_MODEL, D_FF), D_MODEL),
        "dense_w_up": nrm(ks[12], (n_dense, D_MODEL, D_FF), D_MODEL),
        "dense_w_down": nrm(ks[13], (n_dense, D_FF, D_MODEL), D_FF),
        "moe_router": nrm(ks[14], (n_moe, D_MODEL, N_EXPERTS), D_MODEL),
        "moe_w_gate": nrm(ks[15], (n_moe, N_EXPERTS, D_MODEL, D_FF_EXPERT), D_MODEL),
        "moe_w_up": nrm(ks[16], (n_moe, N_EXPERTS, D_MODEL, D_FF_EXPERT), D_MODEL),
        "moe_w_down": nrm(ks[17], (n_moe, N_EXPERTS, D_FF_EXPERT, D_MODEL), D_FF_EXPERT),
        "final_norm": gain(ks[18], (D_MODEL,)),
    }


def reference(x, positions, norm_mix, w_in, conv_w, a_log, dt_bias, dn_norm, w_dn_out, w_sa_out,
              w_o, norm_ffn, dense_w_gate, dense_w_up, dense_w_down, moe_router, moe_w_gate,
              moe_w_up, moe_w_down, final_norm):
    cos_sa, sin_sa = rope_tables(positions, SA_HEAD_DIM)
    cos_ix, sin_ix = rope_tables(positions, IDX_HEAD_DIM)
    for layer in range(DEPTH):
        h = rms_norm(x, norm_mix[layer])
        x = x + hybrid_mixer(h, cos_sa, sin_sa, cos_ix, sin_ix, w_in[layer], conv_w[layer],
                             a_log[layer], dt_bias[layer], dn_norm[layer], w_dn_out[layer],
                             w_sa_out[layer], w_o[layer])
        h = rms_norm(x, norm_ffn[layer])
        j = layer // 2
        if layer % 2 == 0:
            x = x + swiglu(h, dense_w_gate[j], dense_w_up[j], dense_w_down[j])
        else:
            x = x + moe_ffn(h, moe_router[j], moe_w_gate[j], moe_w_up[j], moe_w_down[j])
    return rms_norm(x, final_norm)
```

```cpp
#include <hip/hip_runtime.h>
#include <cstdio>
#include <cstdint>

#define GAS __attribute__((address_space(1)))
#define LAS __attribute__((address_space(3)))
typedef unsigned short bf16_t;
typedef short bf16x8 __attribute__((ext_vector_type(8)));
typedef float f32x2 __attribute__((ext_vector_type(2)));
typedef float f32x4 __attribute__((ext_vector_type(4)));
typedef float f32x16 __attribute__((ext_vector_type(16)));
typedef unsigned u32x2 __attribute__((ext_vector_type(2)));
typedef _Float16 h2_t __attribute__((ext_vector_type(2)));
typedef unsigned short u16x2_t __attribute__((ext_vector_type(2)));
typedef unsigned u32x4 __attribute__((ext_vector_type(4)));

constexpr int S = 8192, DM = 2048, NLAYER = 2;
constexpr int DNH = 8, HD = 128, DNW = 1024;
constexpr int IXH = 16, IXD = 64, TOPK = 256;
constexpr int DFF = 5632, NEXP = 8, DFE = 2816;
constexpr int NIN = 12384;
constexpr int NPB = 12288;
constexpr int NPW = 12544;
constexpr int NPH = 6144;
constexpr int PC_QKV = 0, PC_QSA = 3072, PC_KSA = 4096, PC_QIX = 5120, PC_Z = 6144, PC_VSA = 7168, PC_GDN = 8192, PC_GSA = 10240;
constexpr float F8_WIN = 32.f; constexpr int F8_SC_WIN = 127 - 5;
constexpr int SC_KIX = 0, SC_WIX = 64, SC_A = 80, SC_B = 88;
constexpr float RMS_EPS = 1e-6f, L2_EPS = 1e-6f;
constexpr float F8_WGU = 32.f, F8_WD = 64.f, F8_HID = 8.f; constexpr int F8_SC_WGU = 127 - 5, F8_SC_WD = 127 - 6, F8_SC_HID = 127 - 3;
constexpr int SMALL_KS = 4;
constexpr int MOE_ROWS = 2 * S + NEXP * 256;
constexpr int MOE_MAXT = MOE_ROWS / 256;

constexpr size_t MiB = 1u << 20;
constexpr size_t WS_CTL = 0, CTL_ZERO_BYTES = 1 * MiB;
constexpr size_t WS_WIN = 1 * MiB;
constexpr size_t WS_WDN = WS_WIN + 98 * MiB;
constexpr size_t WS_WSA = WS_WDN + 8 * MiB;
constexpr size_t WS_WO = WS_WSA + 8 * MiB;
constexpr size_t WS_WGU0 = WS_WO + 16 * MiB;
constexpr size_t WS_WD0 = WS_WGU0 + 44 * MiB;
constexpr size_t WS_WGU1 = WS_WD0 + 22 * MiB;
constexpr size_t WS_WD1 = WS_WGU1 + 176 * MiB;
constexpr size_t WS_X = WS_WD1 + 88 * MiB;
constexpr size_t WS_XN = WS_X + 64 * MiB;
constexpr size_t WS_PROJ = WS_XN + 32 * MiB;
constexpr size_t WS_SMALL = WS_PROJ + 192 * MiB;
constexpr size_t WS_DNQKV = WS_SMALL + 8 * MiB;
constexpr size_t WS_ODNRAW = WS_DNQKV + 48 * MiB;
constexpr size_t WS_ODN = WS_ODNRAW + 32 * MiB;
constexpr size_t WS_OSA = WS_ODN + 16 * MiB;
constexpr size_t WS_MASK = WS_OSA + 16 * MiB;
constexpr size_t WS_MERGED = WS_MASK + 8 * MiB;
constexpr size_t WS_KIX = WS_MERGED + 32 * MiB;
constexpr size_t WS_WIX = WS_KIX + 1 * MiB;
constexpr size_t WS_GB = WS_WIX + MiB / 2;
constexpr size_t WS_ROPE = WS_GB + MiB / 2;
constexpr size_t WS_ROUTE = WS_ROPE + 6 * MiB;
constexpr size_t WS_ODNRAW2 = WS_ROUTE + 1 * MiB;
constexpr size_t WS_GL = WS_ODNRAW2 + 32 * MiB;
constexpr size_t WS_XN8 = WS_GL + 1 * MiB;
constexpr size_t WS_END = WS_XN8 + 16 * MiB;
constexpr size_t WS_DNF = WS_DNQKV;
static_assert(1024 * 81920 == 80 * MiB, "DNF");
constexpr size_t WS_HID = WS_PROJ;
constexpr size_t WS_AS = WS_PROJ;
constexpr size_t WS_HIDM = WS_PROJ + 72 * MiB;
constexpr size_t WS_YS = WS_DNQKV;
static_assert(72 + 99 <= 192 && 72 <= 48 + 32, "overlays");
constexpr size_t RT_SEL = 0;
constexpr size_t RT_CNTB = 128 * 1024;
constexpr size_t RT_TOKROW = 160 * 1024;
constexpr size_t RT_ROWW = 256 * 1024;
constexpr size_t RT_SS = 512 * 1024;
constexpr int CW_BAR = 4096, CW_SELQ = 64;

constexpr int RING_BYTES = 131072;
constexpr int LDSCTL_OFF = RING_BYTES, MISC_OFF = LDSCTL_OFF + 320;
constexpr int LDS_BYTES = 147456;
constexpr int DN_TAB_OFF = LDSCTL_OFF + 4096;

__device__ __forceinline__ float bf2f(unsigned b) { return __uint_as_float(b << 16); }
typedef __bf16 bf16x2_t __attribute__((ext_vector_type(2)));
__device__ __forceinline__ unsigned cvt_pk_bf16_asm(float lo, float hi) { unsigned r; asm volatile("v_cvt_pk_bf16_f32 %0, %1, %2" : "=v"(r) : "v"(lo), "v"(hi)); return r; }
__device__ __forceinline__ unsigned cvt_pk_bf16(float lo, float hi) { const f32x2 v = {lo, hi}; const bf16x2_t b = __builtin_convertvector(v, bf16x2_t); return __builtin_bit_cast(unsigned, b); }
__device__ __forceinline__ unsigned cvt4_fp8(float a, float b, float c2, float d) { int w = 0; w = __builtin_amdgcn_cvt_pk_fp8_f32(a, b, w, false); w = __builtin_amdgcn_cvt_pk_fp8_f32(c2, d, w, true); return (unsigned)w; }
__device__ __forceinline__ float clamp448(float x) { return __builtin_amdgcn_fmed3f(x, -448.f, 448.f); }
__device__ __forceinline__ unsigned cvt4_fp8c(float a, float b, float c2, float d) { return cvt4_fp8(clamp448(a), clamp448(b), clamp448(c2), clamp448(d)); }
__device__ __forceinline__ bf16_t f2bf(float f) { return (bf16_t)(cvt_pk_bf16(f, 0.f) & 0xffffu); }
__device__ __forceinline__ void unpack8(const u32x4 w, float* f) {
    f[0] = __uint_as_float(w.x << 16); f[1] = __uint_as_float(w.x & 0xffff0000u); f[2] = __uint_as_float(w.y << 16); f[3] = __uint_as_float(w.y & 0xffff0000u);
    f[4] = __uint_as_float(w.z << 16); f[5] = __uint_as_float(w.z & 0xffff0000u); f[6] = __uint_as_float(w.w << 16); f[7] = __uint_as_float(w.w & 0xffff0000u); }
__device__ __forceinline__ u32x4 pack8(const float* f) { u32x4 w; w.x = cvt_pk_bf16(f[0], f[1]); w.y = cvt_pk_bf16(f[2], f[3]); w.z = cvt_pk_bf16(f[4], f[5]); w.w = cvt_pk_bf16(f[6], f[7]); return w; }
__device__ __forceinline__ float wave_sum(float v) {
#pragma unroll
    for (int o = 1; o < 64; o <<= 1) v += __shfl_xor(v, o);
    return v; }
__device__ __forceinline__ float wave_max(float v) {
#pragma unroll
    for (int o = 1; o < 64; o <<= 1) v = fmaxf(v, __shfl_xor(v, o));
    return v; }
template <int CTRL> __device__ __forceinline__ float dpp_f(float v) { return __builtin_bit_cast(float, __builtin_amdgcn_update_dpp(0, __builtin_bit_cast(int, v), CTRL, 0xF, 0xF, true)); }
__device__ __forceinline__ float row16_sum(float v) {
    v += dpp_f<0xB1>(v);
    v += dpp_f<0x4E>(v);
    v += dpp_f<0x141>(v);
    v += dpp_f<0x140>(v);
    return v; }
template <int CTRL, int RM> __device__ __forceinline__ int dpp_i(int v) { return __builtin_amdgcn_update_dpp(0, v, CTRL, RM, 0xF, false); }
__device__ __forceinline__ int wave_isum(int v) {
    v += dpp_i<0xB1, 0xF>(v); v += dpp_i<0x4E, 0xF>(v); v += dpp_i<0x141, 0xF>(v); v += dpp_i<0x140, 0xF>(v);
    v += dpp_i<0x142, 0xA>(v); v += dpp_i<0x143, 0xC>(v);
    return __builtin_amdgcn_readlane(v, 63); }
__device__ __forceinline__ float sigmoidf_(float x) { return __builtin_amdgcn_rcpf(1.f + __expf(-x)); }
__device__ __forceinline__ float siluf_(float x) { return x * sigmoidf_(x); }
#define LDS_WAIT() asm volatile("s_waitcnt lgkmcnt(0)" ::: "memory")
#define VM_WAIT() asm volatile("s_waitcnt vmcnt(0)" ::: "memory")

__constant__ double RF_SA[64] = {1.59154943091895346e-01, 1.37822502603982849e-01, 1.19349370211248862e-01, 1.03352296618434064e-01, 8.94994016088910133e-02, 7.75032887553740585e-02, 6.71150830052272551e-02, 5.81192674418762462e-02, 5.03292121044870353e-02, 4.35833021053073297e-02, 3.77415847174197711e-02, 3.26828658723569976e-02, 2.83021958306233987e-02, 2.45086918620698521e-02, 2.12236527647776604e-02, 1.83789261056796667e-02, 1.59154943091895339e-02, 1.37822502603982839e-02, 1.19349370211248862e-02, 1.03352296618434061e-02, 8.94994016088910063e-03, 7.75032887553740550e-03, 6.71150830052272534e-03, 5.81192674418762410e-03, 5.03292121044870370e-03, 4.35833021053073227e-03, 3.77415847174197719e-03, 3.26828658723569932e-03, 2.83021958306233987e-03, 2.45086918620698565e-03, 2.12236527647776578e-03, 1.83789261056796667e-03, 1.59154943091895356e-03, 1.37822502603982878e-03, 1.19349370211248871e-03, 1.03352296618434048e-03, 8.94994016088910237e-04, 7.75032887553740507e-04, 6.71150830052272490e-04, 5.81192674418762388e-04, 5.03292121044870326e-04, 4.35833021053073292e-04, 3.77415847174197687e-04, 3.26828658723569922e-04, 2.83021958306233954e-04, 2.45086918620698489e-04, 2.12236527647776578e-04, 1.83789261056796662e-04, 1.59154943091895351e-04, 1.37822502603982856e-04, 1.19349370211248862e-04, 1.03352296618434061e-04, 8.94994016088910047e-05, 7.75032887553740561e-05, 6.71150830052272545e-05, 5.81192674418762388e-05, 5.03292121044870354e-05, 4.35833021053073292e-05, 3.77415847174197768e-05, 3.26828658723569989e-05, 2.83021958306233995e-05, 2.45086918620698523e-05, 2.12236527647776592e-05, 1.83789261056796682e-05};

namespace pg8 {
constexpr int BM = 256, BK = 64, HALF = 128, HTB = HALF * BK * 2, STAGE_BYTES = 8 * HTB, NXCD = 8, WGM = 8;
__host__ __device__ __forceinline__ int lds_byte(int r, int c) { const int st = (r >> 4) * 2 + (c >> 5), rr = r & 15, cc = c & 31, ob = rr * 64 + cc * 2; return st * 1024 + (ob ^ (((ob >> 9) & 1) << 5)); }
__host__ __device__ __forceinline__ void stage_rc(int b, int& R, int& C) { const int st = b / 1024, sb = b % 1024, swz = sb ^ (((sb >> 9) & 1) << 5); R = (st >> 1) * 16 + swz / 64; C = (st & 1) * 32 + (swz % 64) / 2; }
__host__ __device__ __forceinline__ int perm32(int rho) { const int n = rho >> 4, i = rho & 15; return 8 * (i >> 2) + 4 * n + (i & 3); }

struct Unit { int pm, pn; const char* a; const char* b; };

struct StaticOrder {
    int nM, nN, nwg, G, c; const char* A; const char* Bt; size_t tstep;
    __device__ void init(const bf16_t* A_, const bf16_t* Bt_, int M, int N, int K, int G_, int c_) { nM = M / BM; nN = N / BM; nwg = nM * nN; G = G_; c = c_; A = (const char*)A_; Bt = (const char*)Bt_; tstep = (size_t)BM * K * 2; }
    __device__ bool tile(int i, int& pm, int& pn) const {
        const long L = (long)i * G + c; if (L >= nwg) return false;
        int wgid = (int)L; { const int q = nwg / NXCD, r = nwg % NXCD, xcd = wgid % NXCD, off = wgid / NXCD; wgid = (xcd < r ? xcd * (q + 1) : r * (q + 1) + (xcd - r) * q) + off; }
        const int nig = WGM * nN, gid = wgid / nig, fm = gid * WGM, gsz = (nM - fm) < WGM ? (nM - fm) : WGM;
        pm = fm + ((wgid % nig) % gsz); pn = (wgid % nig) / gsz; return true;
    }
    __device__ bool next(int i, Unit& u) const { if (!tile(i, u.pm, u.pn)) return false; u.a = A + (size_t)u.pm * tstep; u.b = Bt + (size_t)u.pn * tstep; return true; }
};
struct SplitKOrder {
    int nM, nks, G, c; const char* A; const char* Bt; size_t tstep; int ksb;
    __device__ bool next(int i, Unit& u) const { const long L = (long)i * G + c; if (L >= (long)nM * nks) return false; u.pm = (int)(L % nM); u.pn = (int)(L / nM);
        u.a = A + (size_t)u.pm * tstep + (size_t)u.pn * ksb; u.b = Bt + (size_t)u.pn * ksb; return true; }
};
struct GroupOrder {
    StaticOrder so; const LAS int* te; size_t estride;
    __device__ bool next(int i, Unit& u) const { if (!so.tile(i, u.pm, u.pn)) return false; u.a = so.A + (size_t)u.pm * so.tstep; u.b = so.Bt + (size_t)te[u.pm] * estride + (size_t)u.pn * so.tstep; return true; }
};

typedef int i32x4_t __attribute__((ext_vector_type(4)));
typedef int i32x8_t __attribute__((ext_vector_type(8)));
template <class Epi, class Sched, bool ALIGN_EPI = true, bool SP2 = true, bool F8 = false>
__device__ __forceinline__ void gemm_phase(LAS unsigned char* lds, const int tid, const int K, const Sched& S, const Epi& E, const int sW = 127, const int sX = 127, const int KP_ = 0) {
    const int wid = __builtin_amdgcn_readfirstlane(tid >> 6), lane = tid & 63, wr = wid >> 2, wc = wid & 3, fr = lane & 15, fq = lane >> 4;
    const int nt = K / BK, KP = KP_ ? KP_ : K;
    unsigned voffA[2], voffB[2];
#pragma unroll
    for (int i = 0; i < 2; ++i) { int R, C; stage_rc(tid * 16 + i * 8192, R, C); const int Rb = Epi::PERM ? ((R & ~31) + perm32(R & 31)) : R;
        voffA[i] = (unsigned)(R * KP + C) * 2u; voffB[i] = (unsigned)(Rb * KP + C) * 2u; }
    const size_t kstep = (size_t)(BK * 2);
    const size_t hstep = (size_t)HALF * KP * 2;
    const unsigned ldsw = (unsigned)wid * 1024u;
    const int aoff = lds_byte(wr * 64 + fr, fq * 8), boff = lds_byte(wc * 32 + fr, fq * 8);
#define PG8_SA(b, h) (((b) * 2 + (h)) * HTB)
#define PG8_SB(b, h) ((4 + (b) * 2 + (h)) * HTB)
#define PG8_STAGE(bufoff, gbase, voff) do { _Pragma("unroll") for (int _i = 0; _i < 2; ++_i) \
        __builtin_amdgcn_global_load_lds((const unsigned*)((const char*)(gbase) + (voff)[_i]), (LAS unsigned*)(lds + (bufoff) + ldsw + _i * 8192), 16, 0, 0); } while (0)
#define PG8_LD32(p_) PG8_CAT(*(const LAS i32x4_t*)(p_), *(const LAS i32x4_t*)((p_) + 1024))
#define PG8_LDA(dst, b, h) do { _Pragma("unroll") for (int m = 0; m < 4; ++m) dst[m] = PG8_LD32(lds + PG8_SA(b, h) + aoff + m * 2048); } while (0)
#define PG8_LDB(dst, b, h) do { _Pragma("unroll") for (int n = 0; n < 2; ++n) dst[n] = PG8_LD32(lds + PG8_SB(b, h) + boff + n * 2048); } while (0)
#define PG8_CAT(x0, x1) __builtin_shufflevector(x0, x1, 0, 1, 2, 3, 4, 5, 6, 7)
#define PG8_LO(x) __builtin_bit_cast(bf16x8, __builtin_shufflevector(x, x, 0, 1, 2, 3))
#define PG8_HI(x) __builtin_bit_cast(bf16x8, __builtin_shufflevector(x, x, 4, 5, 6, 7))
#define PG8_MMA(ai, bj, At, Bt) do { __builtin_amdgcn_s_setprio(1); _Pragma("unroll") for (int m = 0; m < 4; ++m) _Pragma("unroll") for (int n = 0; n < 2; ++n) { \
        if constexpr (F8) asm("v_mfma_scale_f32_16x16x128_f8f6f4 %0, %1, %2, %0, %3, %4 op_sel_hi:[0,0,0]" : "+v"(acc[ai][bj][m][n]) : "v"(Bt[n]), "v"(At[m]), "v"(sW), "v"(sX));   \
        else { acc[ai][bj][m][n] = __builtin_amdgcn_mfma_f32_16x16x32_bf16(PG8_LO(Bt[n]), PG8_LO(At[m]), acc[ai][bj][m][n], 0, 0, 0); acc[ai][bj][m][n] = __builtin_amdgcn_mfma_f32_16x16x32_bf16(PG8_HI(Bt[n]), PG8_HI(At[m]), acc[ai][bj][m][n], 0, 0, 0); } } __builtin_amdgcn_s_setprio(0); } while (0)
#define PG8_WAIT_V(n) asm volatile("s_waitcnt vmcnt(" #n ")" ::: "memory")
#define PG8_WAIT_L(n) asm volatile("s_waitcnt lgkmcnt(" #n ")" ::: "memory")
#define PG8_BAR __builtin_amdgcn_s_barrier()
#define PG8_SCHED __builtin_amdgcn_sched_barrier(0)
    Unit cur, nxt; int ui = 0;
    if (!S.next(0, cur)) return;
    f32x4 acc[2][2][4][2];
#pragma unroll
    for (int a = 0; a < 2; ++a)
#pragma unroll
        for (int b = 0; b < 2; ++b)
#pragma unroll
            for (int m = 0; m < 4; ++m)
#pragma unroll
                for (int n = 0; n < 2; ++n) acc[a][b][m][n] = (f32x4){0.f, 0.f, 0.f, 0.f};
    i32x8_t At[4], B0[2], B1[2];
    const char* cA = cur.a; const char* cB = cur.b;
    if constexpr (SP2) {
        PG8_STAGE(PG8_SB(0, 0), cB, voffB); PG8_STAGE(PG8_SB(0, 1), cB + hstep, voffB); PG8_STAGE(PG8_SA(0, 0), cA, voffA); PG8_STAGE(PG8_SA(0, 1), cA + hstep, voffA);
        if (wr == 1) PG8_BAR;
        PG8_WAIT_V(2); PG8_BAR;
        PG8_STAGE(PG8_SB(1, 0), cB + kstep, voffB); PG8_STAGE(PG8_SA(1, 0), cA + kstep, voffA); PG8_STAGE(PG8_SB(1, 1), cB + hstep + kstep, voffB);
        PG8_WAIT_V(6); PG8_BAR;
    } else {
        PG8_STAGE(PG8_SB(0, 0), cB, voffB); PG8_STAGE(PG8_SA(0, 0), cA, voffA); PG8_STAGE(PG8_SB(0, 1), cB + hstep, voffB); PG8_STAGE(PG8_SA(0, 1), cA + hstep, voffA);
        if (wr == 1) PG8_BAR;
        PG8_WAIT_V(4); PG8_BAR;
        PG8_STAGE(PG8_SB(1, 0), cB + kstep, voffB); PG8_STAGE(PG8_SA(1, 0), cA + kstep, voffA); PG8_STAGE(PG8_SB(1, 1), cB + hstep + kstep, voffB);
        PG8_WAIT_V(6); PG8_BAR;
    }
    for (;;) {
        const bool has_next = S.next(ui + 1, nxt);
        const char* nA = has_next ? nxt.a : cA; const char* nB = has_next ? nxt.b : cB;
        for (int t = 0; t < nt; t += 2) {
            const bool last = (t == nt - 2);
            const char* a1 = cA + (size_t)(t + 1) * kstep;
            const char* a2 = last ? nA : cA + (size_t)(t + 2) * kstep; const char* b2 = last ? nB : cB + (size_t)(t + 2) * kstep;
            const char* a3 = a2 + kstep; const char* b3 = b2 + kstep;
            if constexpr (SP2) {
            PG8_LDB(B0, 0, 0); PG8_LDB(B1, 0, 1); PG8_SCHED; PG8_LDA(At, 0, 0); PG8_STAGE(PG8_SA(1, 1), a1 + hstep, voffA);
            PG8_WAIT_V(8); PG8_WAIT_L(0); PG8_BAR; PG8_MMA(0, 0, At, B0); PG8_MMA(0, 1, At, B1); PG8_BAR; PG8_SCHED;
            PG8_LDA(At, 0, 1); PG8_STAGE(PG8_SB(0, 0), b2, voffB); PG8_STAGE(PG8_SB(0, 1), b2 + hstep, voffB); PG8_STAGE(PG8_SA(0, 0), a2, voffA);
            PG8_WAIT_V(8); PG8_WAIT_L(0); PG8_BAR; PG8_MMA(1, 0, At, B0); PG8_MMA(1, 1, At, B1); PG8_BAR; PG8_SCHED;
            PG8_LDB(B0, 1, 0); PG8_LDB(B1, 1, 1); PG8_SCHED; PG8_LDA(At, 1, 0); PG8_STAGE(PG8_SA(0, 1), a2 + hstep, voffA);
            PG8_WAIT_V(8); PG8_WAIT_L(0); PG8_BAR; PG8_MMA(0, 0, At, B0); PG8_MMA(0, 1, At, B1); PG8_BAR; PG8_SCHED;
            PG8_LDA(At, 1, 1); PG8_STAGE(PG8_SB(1, 0), b3, voffB); PG8_STAGE(PG8_SB(1, 1), b3 + hstep, voffB); PG8_STAGE(PG8_SA(1, 0), a3, voffA);
            PG8_WAIT_V(8); PG8_WAIT_L(0); PG8_BAR; PG8_MMA(1, 0, At, B0); PG8_MMA(1, 1, At, B1); PG8_BAR; PG8_SCHED;
            } else {
            PG8_LDB(B0, 0, 0); PG8_SCHED; PG8_LDA(At, 0, 0); PG8_STAGE(PG8_SA(1, 1), a1 + hstep, voffA);
            PG8_WAIT_L(8); PG8_BAR; PG8_WAIT_L(0); PG8_MMA(0, 0, At, B0); PG8_BAR; PG8_SCHED;
            PG8_LDB(B1, 0, 1); PG8_STAGE(PG8_SB(0, 0), b2, voffB);
            PG8_BAR; PG8_WAIT_L(0); PG8_MMA(0, 1, At, B1); PG8_BAR;
            PG8_LDA(At, 0, 1); PG8_STAGE(PG8_SA(0, 0), a2, voffA);
            PG8_BAR; PG8_WAIT_L(0); PG8_MMA(1, 0, At, B0); PG8_BAR; PG8_SCHED;
            PG8_STAGE(PG8_SB(0, 1), b2 + hstep, voffB);
            PG8_WAIT_V(6); PG8_BAR; PG8_MMA(1, 1, At, B1); PG8_BAR;
            PG8_LDB(B0, 1, 0); PG8_SCHED; PG8_LDA(At, 1, 0); PG8_STAGE(PG8_SA(0, 1), a2 + hstep, voffA);
            PG8_WAIT_L(8); PG8_BAR; PG8_WAIT_L(0); PG8_MMA(0, 0, At, B0); PG8_BAR; PG8_SCHED;
            PG8_LDB(B1, 1, 1); PG8_STAGE(PG8_SB(1, 0), b3, voffB);
            PG8_BAR; PG8_WAIT_L(0); PG8_MMA(0, 1, At, B1); PG8_BAR;
            PG8_LDA(At, 1, 1); PG8_STAGE(PG8_SA(1, 0), a3, voffA);
            PG8_BAR; PG8_WAIT_L(0); PG8_MMA(1, 0, At, B0); PG8_BAR; PG8_SCHED;
            PG8_STAGE(PG8_SB(1, 1), b3 + hstep, voffB);
            PG8_WAIT_V(6); PG8_BAR; PG8_MMA(1, 1, At, B1); PG8_BAR;
            }
        }
        if constexpr (ALIGN_EPI) { if (wr == 0) PG8_BAR; }
        if constexpr (F8) asm volatile("s_nop 15\n\ts_nop 15" ::: "memory");
        E(acc, cur, wr, wc, fr, fq);
        if (!has_next) break;
#pragma unroll
        for (int a = 0; a < 2; ++a)
#pragma unroll
            for (int b = 0; b < 2; ++b)
#pragma unroll
                for (int m = 0; m < 4; ++m)
#pragma unroll
                    for (int n = 0; n < 2; ++n) acc[a][b][m][n] = (f32x4){0.f, 0.f, 0.f, 0.f};
        cur = nxt; cA = nA; cB = nB; ++ui;
        if constexpr (ALIGN_EPI) { if (wr == 1) PG8_BAR; }
    }
    PG8_WAIT_V(0);
    if constexpr (!ALIGN_EPI) { if (wr == 0) PG8_BAR; }
    PG8_BAR;
#undef PG8_SA
#undef PG8_SB
#undef PG8_STAGE
#undef PG8_LDA
#undef PG8_LDB
#undef PG8_MMA
#undef PG8_CAT
#undef PG8_LO
#undef PG8_HI
#undef PG8_LD32
#undef PG8_WAIT_V
#undef PG8_WAIT_L
#undef PG8_BAR
#undef PG8_SCHED
}

typedef const f32x4 (&AccRef)[2][2][4][2];
struct EpiProj {
    static constexpr bool PERM = true;
    bf16_t* P; int coff; const unsigned long long* SS;
    __device__ __forceinline__ void operator()(AccRef acc, const Unit& u, int wr, int wc, int fr, int fq) const {
        asm volatile("" : "+v"(fr), "+v"(fq));
        const int row0 = u.pm * BM + wr * 64 + fr, cl = wc * 32 + 8 * fq;
#pragma unroll
        for (int ai = 0; ai < 2; ++ai)
#pragma unroll
            for (int m = 0; m < 4; ++m) { const int rr = row0 + ai * HALF + m * 16; const float rs = SS ? rsqrtf((float)SS[rr] * (1.f / (1048576.f * DM)) + RMS_EPS) : 1.f; bf16_t* rowp = P + (size_t)rr * NPB + coff + u.pn * BM + cl;
#pragma unroll
                for (int bj = 0; bj < 2; ++bj) { const f32x4 v0 = acc[ai][bj][m][0] * rs, v1 = acc[ai][bj][m][1] * rs;
                    u32x4 w; w.x = cvt_pk_bf16(v0[0], v0[1]); w.y = cvt_pk_bf16(v0[2], v0[3]); w.z = cvt_pk_bf16(v1[0], v1[1]); w.w = cvt_pk_bf16(v1[2], v1[3]);
                    *(u32x4*)(rowp + bj * HALF) = w; } }
    }
};
struct EpiSmallPart {
    static constexpr bool PERM = true;
    float* SP; const unsigned long long* SS;
    __device__ __forceinline__ void operator()(AccRef acc, const Unit& u, int wr, int wc, int fr, int fq) const {
        asm volatile("" : "+v"(fr), "+v"(fq));
        const int row0 = u.pm * BM + wr * 64 + fr, cl = wc * 32 + 8 * fq;
#pragma unroll
        for (int ai = 0; ai < 2; ++ai)
#pragma unroll
            for (int m = 0; m < 4; ++m) { const int rr = row0 + ai * HALF + m * 16; const float rs = SS ? rsqrtf((float)SS[rr] * (1.f / (1048576.f * DM)) + RMS_EPS) : 1.f;
                float* rowp = SP + ((size_t)u.pn * S + rr) * 128 + cl; *(f32x4*)rowp = acc[ai][0][m][0] * rs; *(f32x4*)(rowp + 4) = acc[ai][0][m][1] * rs; }
    }
};
template <bool ADD> struct EpiGate {
    static constexpr bool PERM = true;
    bf16_t* O; const bf16_t* Gt;
    __device__ __forceinline__ void operator()(AccRef acc, const Unit& u, int wr, int wc, int fr, int fq) const {
        asm volatile("" : "+v"(fr), "+v"(fq));
        const int row0 = u.pm * BM + wr * 64 + fr, col0 = u.pn * BM + wc * 32 + 8 * fq;
#pragma unroll
        for (int ai = 0; ai < 2; ++ai)
#pragma unroll
            for (int m = 0; m < 4; ++m) { const size_t r = (size_t)(row0 + ai * HALF + m * 16);
#pragma unroll
                for (int bj = 0; bj < 2; ++bj) {
                    float g[8], o[8]; unpack8(*(const u32x4*)(Gt + r * NPB + col0 + bj * HALF), g);
                    const f32x4 v0 = acc[ai][bj][m][0], v1 = acc[ai][bj][m][1];
                    bf16_t* op = O + r * DM + col0 + bj * HALF;
                    if (ADD) unpack8(*(const u32x4*)op, o); else { for (int j = 0; j < 8; ++j) o[j] = 0.f; }
#pragma unroll
                    for (int j = 0; j < 4; ++j) { o[j] += sigmoidf_(g[j]) * v0[j]; o[4 + j] += sigmoidf_(g[4 + j]) * v1[j]; }
                    *(u32x4*)op = pack8(o); } }
    }
};
struct EpiResid {
    static constexpr bool PERM = false;
    const float* Xin; float* Xout;
    __device__ __forceinline__ void operator()(AccRef acc, const Unit& u, int wr, int wc, int fr, int fq) const {
        asm volatile("" : "+v"(fr), "+v"(fq));
        const int row0 = u.pm * BM + wr * 64 + fr, col0 = u.pn * BM + wc * 32 + 4 * fq;
#pragma unroll
        for (int ai = 0; ai < 2; ++ai)
#pragma unroll
            for (int m = 0; m < 4; ++m) { const size_t off = (size_t)(row0 + ai * HALF + m * 16) * DM + col0;
#pragma unroll
                for (int bj = 0; bj < 2; ++bj)
#pragma unroll
                    for (int n = 0; n < 2; ++n) { const f32x4 b = *(const f32x4*)(Xin + off + bj * HALF + n * 16); *(f32x4*)(Xout + off + bj * HALF + n * 16) = b + acc[ai][bj][m][n]; } }
    }
};
template <bool F8OUT> struct EpiResidN {
    static constexpr bool PERM = false;
    const float* Xin; float* Xout; void* XL; unsigned long long* SS; unsigned char* XL8;
    __device__ __forceinline__ void operator()(AccRef acc, const Unit& u, int wr, int wc, int fr, int fq) const {
        asm volatile("" : "+v"(fr), "+v"(fq));
        const int row0 = u.pm * BM + wr * 64 + fr, col0 = u.pn * BM + wc * 32 + 4 * fq;
#pragma unroll
        for (int ai = 0; ai < 2; ++ai)
#pragma unroll
            for (int m = 0; m < 4; ++m) { const int rr = row0 + ai * HALF + m * 16; const size_t off = (size_t)rr * DM + col0; float ss = 0.f;
#pragma unroll
                for (int bj = 0; bj < 2; ++bj)
#pragma unroll
                    for (int n = 0; n < 2; ++n) { const f32x4 b = *(const f32x4*)(Xin + off + bj * HALF + n * 16); const f32x4 v = b + acc[ai][bj][m][n]; *(f32x4*)(Xout + off + bj * HALF + n * 16) = v;
                        ss += (v[0] * v[0] + v[1] * v[1]) + (v[2] * v[2] + v[3] * v[3]);
                        if (F8OUT) *(unsigned*)((unsigned char*)XL + off + bj * HALF + n * 16) = cvt4_fp8c(v[0], v[1], v[2], v[3]);
                        else { u32x2 w; w.x = cvt_pk_bf16(v[0], v[1]); w.y = cvt_pk_bf16(v[2], v[3]); *(u32x2*)((bf16_t*)XL + off + bj * HALF + n * 16) = w; if (XL8) *(unsigned*)(XL8 + off + bj * HALF + n * 16) = cvt4_fp8c(v[0], v[1], v[2], v[3]); } }
                ss += __shfl_xor(ss, 16); ss += __shfl_xor(ss, 32);
                if (fq == 0) atomicAdd(SS + rr, (unsigned long long)(ss * 1048576.f)); }
    }
};
struct EpiSwiglu {
    static constexpr bool PERM = true;
    bf16_t* H; int ldh;
    __device__ __forceinline__ void operator()(AccRef acc, const Unit& u, int wr, int wc, int fr, int fq) const {
        asm volatile("" : "+v"(fr), "+v"(fq));
        const int row0 = u.pm * BM + wr * 64 + fr, col0 = u.pn * HALF + wc * 32 + 8 * fq;
#pragma unroll
        for (int ai = 0; ai < 2; ++ai)
#pragma unroll
            for (int m = 0; m < 4; ++m) { float o[8];
#pragma unroll
                for (int n = 0; n < 2; ++n)
#pragma unroll
                    for (int j = 0; j < 4; ++j) o[4 * n + j] = siluf_(acc[ai][0][m][n][j]) * acc[ai][1][m][n][j];
                *(u32x4*)(H + (size_t)(row0 + ai * HALF + m * 16) * ldh + col0) = pack8(o); }
    }
};
struct EpiSwiglu8 {
    static constexpr bool PERM = true;
    unsigned char* H; int ldh; float hs; const unsigned long long* SS;
    __device__ __forceinline__ void operator()(AccRef acc, const Unit& u, int wr, int wc, int fr, int fq) const {
        asm volatile("" : "+v"(fr), "+v"(fq));
        const int row0 = u.pm * BM + wr * 64 + fr, col0 = u.pn * HALF + wc * 32 + 8 * fq;
#pragma unroll
        for (int ai = 0; ai < 2; ++ai)
#pragma unroll
            for (int m = 0; m < 4; ++m) { float o[8]; const float rs = SS ? rsqrtf((float)SS[row0 + ai * HALF + m * 16] * (1.f / (1048576.f * DM)) + RMS_EPS) : 1.f;
#pragma unroll
                for (int n = 0; n < 2; ++n)
#pragma unroll
                    for (int j = 0; j < 4; ++j) o[4 * n + j] = hs * siluf_(acc[ai][0][m][n][j] * rs) * (acc[ai][1][m][n][j] * rs);
                u32x2 w; w.x = cvt4_fp8c(o[0], o[1], o[2], o[3]); w.y = cvt4_fp8c(o[4], o[5], o[6], o[7]);
                *(u32x2*)(H + (size_t)(row0 + ai * HALF + m * 16) * ldh + col0) = w; }
    }
};
struct EpiMoeDown {
    static constexpr bool PERM = true;
    bf16_t* Y; const float* roww;
    __device__ __forceinline__ void operator()(AccRef acc, const Unit& u, int wr, int wc, int fr, int fq) const {
        asm volatile("" : "+v"(fr), "+v"(fq));
        const int row0 = u.pm * BM + wr * 64 + fr, col0 = u.pn * BM + wc * 32 + 8 * fq;
#pragma unroll
        for (int ai = 0; ai < 2; ++ai)
#pragma unroll
            for (int m = 0; m < 4; ++m) { const size_t r = (size_t)(row0 + ai * HALF + m * 16); const float w = roww[r];
#pragma unroll
                for (int bj = 0; bj < 2; ++bj) { float o[8];
#pragma unroll
                    for (int j = 0; j < 4; ++j) { o[j] = w * acc[ai][bj][m][0][j]; o[4 + j] = w * acc[ai][bj][m][1][j]; }
                    *(u32x4*)(Y + r * DM + col0 + bj * HALF) = pack8(o); } }
    }
};
}

#define XB_TMO      128
#define XB_XCNT(j)  (256  + 64 * (j))
#define XB_XSUB(j)  (1280 + 64 * (j))
#define XB_XGEN(j)  (2304 + 64 * (j))
#define XB_TOP      3328
#define XB_TOPGEN   3392
#define XCD_BAR_WORDS 3456
#define XB_SPIN_CAP (1u << 22)
__device__ __forceinline__ unsigned xb_ld(unsigned* p)              { return __hip_atomic_load(p, __ATOMIC_RELAXED, __HIP_MEMORY_SCOPE_AGENT); }
__device__ __forceinline__ unsigned xb_add(unsigned* p, unsigned v) { return __hip_atomic_fetch_add(p, v, __ATOMIC_RELAXED, __HIP_MEMORY_SCOPE_AGENT); }
__device__ __forceinline__ unsigned xb_xcc_id() { return (unsigned)__builtin_amdgcn_s_getreg((3 << 11) | 20) & 0xFu; }
#define XB_SPIN(cond, bar) do { unsigned _sp = 0; while (cond) { __builtin_amdgcn_s_sleep(1); \
    if ((++_sp & 255u) == 0u) { if (xb_ld(&(bar)[XB_TMO])) break; if (_sp > XB_SPIN_CAP) { atomicAdd(&(bar)[XB_TMO], 1u); break; } } } } while (0)
struct XcdBarrier { unsigned* bar; unsigned x; volatile LAS unsigned* st; };
__device__ __forceinline__ XcdBarrier xcd_barrier_post(unsigned* bar, volatile LAS unsigned* st) {
    XcdBarrier b; b.bar = bar; b.x = xb_xcc_id(); b.st = st;
    if (threadIdx.x == 0) (void)xb_add(&bar[XB_XCNT(b.x)], 1u);
    return b;
}
__device__ __forceinline__ void xcd_barrier_complete(unsigned* bar, unsigned x, unsigned& nloc, unsigned& nx) {
    const unsigned G = gridDim.x * gridDim.y * gridDim.z;
    unsigned sum, cnt, mine, sp = 0u;
    for (;;) {
        sum = 0u; cnt = 0u; mine = 0u;
#pragma unroll
        for (unsigned j = 0; j < 16; ++j) { const unsigned c = xb_ld(&bar[XB_XCNT(j)]); sum += c; cnt += (c > 0u) ? 1u : 0u; mine = (j == x) ? c : mine; }
        if (sum == G) break;
        __builtin_amdgcn_s_sleep(1);
        if ((++sp & 255u) == 0u) { if (xb_ld(&bar[XB_TMO])) break; if (sp > XB_SPIN_CAP) { atomicAdd(&bar[XB_TMO], 1u); break; } }
    }
    nloc = mine > 0u ? mine : 1u; nx = cnt > 0u ? cnt : 1u;
}
__device__ __forceinline__ void xcd_barrier(const XcdBarrier& b) {
    asm volatile("s_waitcnt vmcnt(0)" ::: "memory");
    __syncthreads();
    if (threadIdx.x == 0) {
        unsigned* bar = b.bar;
        __builtin_amdgcn_s_waitcnt(0);
        unsigned nloc = b.st[0], nx = b.st[1];
        if (nloc == 0u) { xcd_barrier_complete(bar, b.x, nloc, nx); b.st[0] = nloc; b.st[1] = nx; }
        const unsigned old = xb_add(&bar[XB_XSUB(b.x)], 1u);
        const unsigned gen = old / nloc;
        if (old + 1u == (gen + 1u) * nloc) {
            __builtin_amdgcn_fence(__ATOMIC_RELEASE, "agent");
            asm volatile("s_waitcnt vmcnt(0)" ::: "memory");
            const unsigned og = xb_add(&bar[XB_TOP], 1u);
            const unsigned tg = og / nx;
            if (og + 1u == (tg + 1u) * nx) xb_add(&bar[XB_TOPGEN], 1u);
            else XB_SPIN(xb_ld(&bar[XB_TOPGEN]) == tg, bar);
            __builtin_amdgcn_fence(__ATOMIC_ACQUIRE, "agent");
            xb_add(&bar[XB_XGEN(b.x)], 1u);
            asm volatile("s_waitcnt vmcnt(0)" ::: "memory");
        } else {
            XB_SPIN(xb_ld(&bar[XB_XGEN(b.x)]) == gen, bar);
            __builtin_amdgcn_fence(__ATOMIC_ACQUIRE, "agent");
            asm volatile("s_waitcnt vmcnt(0)" ::: "memory");
        }
    }
    __syncthreads();
}

struct Ctx { LAS unsigned char* lds; unsigned char* ws; int tid, lane, wave, G, gw, NGW, bx; };
enum { IN_X = 0, IN_POS, IN_NORM_MIX, IN_W_IN, IN_CONV_W, IN_A_LOG, IN_DT_BIAS, IN_DN_NORM, IN_W_DN_OUT, IN_W_SA_OUT, IN_W_O, IN_NORM_FFN, IN_DW_GATE, IN_DW_UP, IN_DW_DOWN,
       IN_ROUTER, IN_MW_GATE, IN_MW_UP, IN_MW_DOWN, IN_FINAL_NORM, IN_OUT, IN_COUNT };
constexpr int PTAB_OFF = 131072 + 512;
__device__ __forceinline__ Ctx launder(const Ctx& c0) { Ctx c = c0; int wv = c0.wave; asm volatile("" : "+s"(wv)); c.wave = wv;
    c.lane = (int)__builtin_amdgcn_mbcnt_hi(~0u, __builtin_amdgcn_mbcnt_lo(~0u, 0u)); asm volatile("" : "+v"(c.lane)); c.tid = c.wave * 64 + c.lane;
    asm volatile("" : "+s"(c.G)); { unsigned la = (unsigned)(unsigned long long)c.lds; asm volatile("" : "+s"(la)); c.lds = (LAS unsigned char*)(unsigned long long)la; } unsigned long long w = (unsigned long long)c.ws; asm volatile("" : "+s"(w)); c.ws = (unsigned char*)(GAS unsigned char*)w; int bx = c0.bx; asm volatile("" : "+s"(bx)); c.bx = bx; c.gw = bx * 8 + c.wave; c.NGW = c.G * 8; return c; }
template <class T> __device__ __forceinline__ T* inptr(const Ctx& c, int i) {
    const LAS unsigned* tab = (const LAS unsigned*)(c.lds + PTAB_OFF); unsigned lo = tab[2 * i], hi = tab[2 * i + 1];
    lo = __builtin_amdgcn_readfirstlane(lo); hi = __builtin_amdgcn_readfirstlane(hi); return (T*)(GAS T*)(((unsigned long long)hi << 32) | lo); }
struct Params { const void* in[IN_COUNT]; unsigned char* ws; int ph_lo, ph_hi; };

__device__ __forceinline__ int map_win(int n) {
    if (n < 3072) return PC_QKV + n;
    if (n < 4096) return PC_Z + (n - 3072);
    if (n < 4104) return NPB + SC_A + (n - 4096);
    if (n < 4112) return NPB + SC_B + (n - 4104);
    if (n < 5136) return PC_QSA + (n - 4112);
    if (n < 6160) return PC_KSA + (n - 5136);
    if (n < 7184) return PC_VSA + (n - 6160);
    if (n < 8208) return PC_QIX + (n - 7184);
    if (n < 8272) return NPB + SC_KIX + (n - 8208);
    if (n < 8288) return NPB + SC_WIX + (n - 8272);
    return PC_GDN + (n - 8288);
}
constexpr size_t WIN8_OFF = (size_t)(NPH + 256) * DM * 2;
__device__ __forceinline__ void ti_load(const float* W, int N, const float* gain, int nblk, int item, int lane, float (&v_)[32], f32x4 (&gv)[2]) {
    const int kb = item / nblk, nb = item % nblk, k0 = 64 * kb, n0 = 32 * nb;
#pragma unroll
    for (int i = 0; i < 32; ++i) v_[i] = __builtin_nontemporal_load(W + (size_t)(k0 + 2 * i + (lane >> 5)) * N + n0 + (lane & 31));
    if (gain) { const float* g = gain + k0 + 8 * (lane & 7); gv[0] = *(const f32x4*)g; gv[1] = *(const f32x4*)(g + 4); }
    else { const f32x4 o1 = {1.f, 1.f, 1.f, 1.f}; gv[0] = o1; gv[1] = o1; }
}
__device__ __forceinline__ void ti_store(const float (&v_)[32], const f32x4 (&gv)[2], int K, bf16_t* WT, int mode, LAS float* scr, int nblk, int item, int lane, const float f8s) {
    const int kb = item / nblk, nb = item % nblk, k0 = 64 * kb, n0 = 32 * nb;
#pragma unroll
    for (int i = 0; i < 32; ++i) scr[(2 * i + (lane >> 5)) * 33 + (lane & 31)] = v_[i];
    LDS_WAIT(); asm volatile("" ::: "memory");
    const int c = lane & 7;
#pragma unroll
    for (int j = 0; j < 4; ++j) { const int nl = (lane >> 3) + 8 * j, n = n0 + nl; const LAS float* s0_ = scr + (8 * c) * 33 + nl;
        float e[8];
#pragma unroll
        for (int q = 0; q < 8; ++q) e[q] = s0_[q * 33] * (q < 4 ? gv[0][q & 3] : gv[1][q & 3]);
        int row = n; float f8r = f8s; unsigned char* W8 = (unsigned char*)WT;
        if (mode == 1) { const int R = map_win(n); if (R >= NPH && R < NPB) { row = R - NPH; f8r = F8_WIN; W8 = (unsigned char*)WT + WIN8_OFF; } else row = R < NPH ? R : NPH + (R - NPB); }
        else if (mode == 2) row = (n >> 7) * 256 + (n & 127); else if (mode == 3) row = (n >> 7) * 256 + 128 + (n & 127);
        if (f8r != 0.f) { const float f8s = f8r; unsigned char* WTb = W8; u32x2 o; o.x = cvt4_fp8(f8s * e[0], f8s * e[1], f8s * e[2], f8s * e[3]); o.y = cvt4_fp8(f8s * e[4], f8s * e[5], f8s * e[6], f8s * e[7]);
            *(u32x2*)(WTb + (size_t)row * K + k0 + 8 * c) = o; }
        else { u32x4 o; o.x = cvt_pk_bf16(e[0], e[1]); o.y = cvt_pk_bf16(e[2], e[3]); o.z = cvt_pk_bf16(e[4], e[5]); o.w = cvt_pk_bf16(e[6], e[7]);
            *(u32x4*)(WT + (size_t)row * K + k0 + 8 * c) = o; } }
    LDS_WAIT(); asm volatile("" ::: "memory");
}
__device__ __forceinline__ void p_convert(const Ctx& c, const int j0, const int j1, const int wk, const int nwk) {
    unsigned char* ws = c.ws;
    LAS float* scr = (LAS float*)(c.lds + c.wave * 16384);
    for (int j = j0; j < j1; ++j) {
        const float* src; bf16_t* dst; const float* gain = nullptr; int K, N, mode = 0; float f8s = 0.f;
        if (j < 8) { const int l = j >> 2, k = j & 3;
            if (k == 0) { src = inptr<const float>(c, IN_W_IN) + (size_t)l * DM * NIN; dst = (bf16_t*)(ws + WS_WIN) + (size_t)l * NPW * DM; gain = inptr<const float>(c, IN_NORM_MIX) + l * DM; K = DM; N = NIN; mode = 1; }
            else if (k == 1) { src = inptr<const float>(c, IN_W_DN_OUT) + (size_t)l * DNW * DM; dst = (bf16_t*)(ws + WS_WDN) + (size_t)l * DM * DNW; K = DNW; N = DM; }
            else if (k == 2) { src = inptr<const float>(c, IN_W_SA_OUT) + (size_t)l * DNW * DM; dst = (bf16_t*)(ws + WS_WSA) + (size_t)l * DM * DNW; K = DNW; N = DM; }
            else { src = inptr<const float>(c, IN_W_O) + (size_t)l * DM * DM; dst = (bf16_t*)(ws + WS_WO) + (size_t)l * DM * DM; K = DM; N = DM; }
        } else if (j < 11) { const int k = j - 8;
            if (k == 0) { src = inptr<const float>(c, IN_DW_GATE); dst = (bf16_t*)(ws + WS_WGU0); gain = inptr<const float>(c, IN_NORM_FFN); K = DM; N = DFF; mode = 2; f8s = F8_WGU; }
            else if (k == 1) { src = inptr<const float>(c, IN_DW_UP); dst = (bf16_t*)(ws + WS_WGU0); gain = inptr<const float>(c, IN_NORM_FFN); K = DM; N = DFF; mode = 3; f8s = F8_WGU; }
            else { src = inptr<const float>(c, IN_DW_DOWN); dst = (bf16_t*)(ws + WS_WD0); K = DFF; N = DM; f8s = F8_WD; }
        } else { const int e = (j - 11) / 3, k = (j - 11) % 3;
            if (k == 0) { src = inptr<const float>(c, IN_MW_GATE) + (size_t)e * DM * DFE; dst = (bf16_t*)(ws + WS_WGU1 + (size_t)e * 2 * DFE * DM); gain = inptr<const float>(c, IN_NORM_FFN) + DM; K = DM; N = DFE; mode = 2; f8s = F8_WGU; }
            else if (k == 1) { src = inptr<const float>(c, IN_MW_UP) + (size_t)e * DM * DFE; dst = (bf16_t*)(ws + WS_WGU1 + (size_t)e * 2 * DFE * DM); gain = inptr<const float>(c, IN_NORM_FFN) + DM; K = DM; N = DFE; mode = 3; f8s = F8_WGU; }
            else { src = inptr<const float>(c, IN_MW_DOWN) + (size_t)e * DFE * DM; dst = (bf16_t*)(ws + WS_WD1 + (size_t)e * DM * DFE); K = DFE; N = DM; f8s = F8_WD; }
        }
        const int nitems = (K / 64) * (N / 32), nblk = N / 32;
        for (int it = wk; it < nitems; it += 2 * nwk) { float va[32], vb[32]; f32x4 ga[2], gb[2]; const int itb = it + nwk;
            ti_load(src, N, gain, nblk, it, c.lane, va, ga); if (itb < nitems) ti_load(src, N, gain, nblk, itb, c.lane, vb, gb);
            ti_store(va, ga, K, dst, mode, scr, nblk, it, c.lane, f8s); if (itb < nitems) ti_store(vb, gb, K, dst, mode, scr, nblk, itb, c.lane, f8s); }
    }
}
__device__ __forceinline__ void p_prologue(const Ctx& c) {
    unsigned char* ws = c.ws;
    p_convert(c, 0, 4, c.gw, c.NGW);
    for (int l = 0; l < NLAYER; ++l) { u32x4* z = (u32x4*)((bf16_t*)(ws + WS_WIN) + ((size_t)l * NPW + NPH + 96) * DM); const int n16 = (256 - 96) * DM / 8;
        for (int i = c.gw * 64 + c.lane; i < n16; i += c.NGW * 64) z[i] = (u32x4){0u, 0u, 0u, 0u}; }
    { unsigned long long* ss = (unsigned long long*)(ws + WS_ROUTE + RT_SS); for (int i = c.gw * 64 + c.lane; i < 2 * S; i += c.NGW * 64) ss[i] = 0ull; }
    float* rope = (float*)(ws + WS_ROPE); const int* posp = inptr<const int>(c, IN_POS);
    for (int i = c.gw * 64 + c.lane; i < S * 96; i += c.NGW * 64) { const int t = i / 96, k = i % 96;
        const double rf = k < 64 ? RF_SA[k] : RF_SA[2 * (k - 64)];
        double fr = (double)posp[t] * rf; fr -= __builtin_rint(fr); const float ff = (float)fr;
        const float cs = __builtin_amdgcn_cosf(ff), sn = __builtin_amdgcn_sinf(ff);
        if (k < 64) { rope[(size_t)t * 192 + k] = cs; rope[(size_t)t * 192 + 64 + k] = sn; } else { rope[(size_t)t * 192 + 128 + (k - 64)] = cs; rope[(size_t)t * 192 + 160 + (k - 64)] = sn; } }
}

template <bool ROUTER, bool F8OUT, bool BOTH = false>
__device__ __forceinline__ void p_norm(const Ctx& c, const float* X, const float* gain_r) {
    bf16_t* XN = (bf16_t*)(c.ws + WS_XN); const float* router = ROUTER ? inptr<const float>(c, IN_ROUTER) : nullptr;
    LAS int* lsel = (LAS int*)(c.lds);
    for (int it = 0; it < S / (8 * c.G) + 1; ++it) {
        const int t = (it * c.G + c.bx) * 8 + c.wave;
        if (t >= S) break;
        const f32x4* xr = (const f32x4*)(X + (size_t)t * DM) + c.lane;
        f32x4 v[8]; float ss = 0.f;
#pragma unroll
        for (int j = 0; j < 8; ++j) { v[j] = xr[64 * j]; ss += (v[j].x * v[j].x + v[j].y * v[j].y) + (v[j].z * v[j].z + v[j].w * v[j].w); }
        const float rstd = rsqrtf(wave_sum(ss) * (1.f / DM) + RMS_EPS);
        if constexpr (F8OUT) { unsigned* o4 = (unsigned*)((unsigned char*)XN + (size_t)t * DM) + c.lane;
#pragma unroll
            for (int j = 0; j < 8; ++j) o4[64 * j] = cvt4_fp8c(v[j].x * rstd, v[j].y * rstd, v[j].z * rstd, v[j].w * rstd); }
        else { u32x2* o8 = (u32x2*)(XN + (size_t)t * DM) + c.lane;
#pragma unroll
            for (int j = 0; j < 8; ++j) { u32x2 w; w.x = cvt_pk_bf16(v[j].x * rstd, v[j].y * rstd); w.y = cvt_pk_bf16(v[j].z * rstd, v[j].w * rstd); o8[64 * j] = w; }
            if constexpr (BOTH) { unsigned* o4 = (unsigned*)(c.ws + WS_XN8 + (size_t)t * DM) + c.lane;
#pragma unroll
                for (int j = 0; j < 8; ++j) o4[64 * j] = cvt4_fp8c(v[j].x * rstd, v[j].y * rstd, v[j].z * rstd, v[j].w * rstd); } }
        if constexpr (ROUTER) {
            float lg[NEXP];
#pragma unroll
            for (int e = 0; e < NEXP; ++e) lg[e] = 0.f;
#pragma unroll
            for (int j = 0; j < 8; ++j)
#pragma unroll
                for (int q = 0; q < 4; ++q) { const int k = 256 * j + 4 * c.lane + q; const float xv = v[j][q] * gain_r[k]; const f32x4* wr = (const f32x4*)(router + (size_t)k * NEXP); const f32x4 w0 = wr[0], w1 = wr[1];
                    lg[0] += xv * w0.x; lg[1] += xv * w0.y; lg[2] += xv * w0.z; lg[3] += xv * w0.w; lg[4] += xv * w1.x; lg[5] += xv * w1.y; lg[6] += xv * w1.z; lg[7] += xv * w1.w; }
#pragma unroll
            for (int e = 0; e < NEXP; ++e) lg[e] = wave_sum(lg[e]) * rstd;
            int e0 = 0; float v0 = lg[0];
#pragma unroll
            for (int e = 1; e < NEXP; ++e) if (lg[e] > v0) { v0 = lg[e]; e0 = e; }
            int e1 = -1; float v1 = -__builtin_inff();
#pragma unroll
            for (int e = 0; e < NEXP; ++e) if (e != e0 && lg[e] > v1) { v1 = lg[e]; e1 = e; }
            const float w0 = 1.f / (1.f + __expf(v1 - v0)), w1 = 1.f - w0;
            if (c.lane == 0) { u32x4 r; r.x = (unsigned)e0; r.y = (unsigned)e1; r.z = __float_as_uint(w0); r.w = __float_as_uint(w1); *(u32x4*)(c.ws + WS_ROUTE + RT_SEL + (size_t)t * 16) = r; }
        }
    }
}

__device__ __forceinline__ void p_prep(const Ctx& c, int layer, const int w0, const int nw) {
    unsigned char* ws = c.ws;
    const bf16_t* PROJ = (const bf16_t*)(ws + WS_PROJ); bf16_t* PROJw = (bf16_t*)(ws + WS_PROJ);
    const float* SM = (const float*)(ws + WS_MERGED);
    const float* rope = (const float*)(ws + WS_ROPE);
    bf16_t* KIX = (bf16_t*)(ws + WS_KIX); float* WIX = (float*)(ws + WS_WIX);
    for (int t = w0; t < S; t += nw) {
        const float* rt = rope + (size_t)t * 192;
        { const int hh = c.lane >> 3, i8 = (c.lane & 7) * 8;
            float cs[8], sn[8]; *(f32x4*)cs = *(const f32x4*)(rt + i8); *(f32x4*)(cs + 4) = *(const f32x4*)(rt + i8 + 4); *(f32x4*)sn = *(const f32x4*)(rt + 64 + i8); *(f32x4*)(sn + 4) = *(const f32x4*)(rt + 64 + i8 + 4);
#pragma unroll
            for (int qk = 0; qk < 2; ++qk) { bf16_t* b = PROJw + (size_t)t * NPB + (qk ? PC_KSA : PC_QSA) + hh * 128 + i8; float a1[8], a2[8], o1[8], o2[8]; unpack8(*(const u32x4*)b, a1); unpack8(*(const u32x4*)(b + 64), a2);
#pragma unroll
                for (int e = 0; e < 8; ++e) { o1[e] = a1[e] * cs[e] - a2[e] * sn[e]; o2[e] = a2[e] * cs[e] + a1[e] * sn[e]; }
                *(u32x4*)b = pack8(o1); *(u32x4*)(b + 64) = pack8(o2); } }
        { const int hh = c.lane >> 2, i8 = (c.lane & 3) * 8;
            float cs[8], sn[8]; *(f32x4*)cs = *(const f32x4*)(rt + 128 + i8); *(f32x4*)(cs + 4) = *(const f32x4*)(rt + 128 + i8 + 4); *(f32x4*)sn = *(const f32x4*)(rt + 160 + i8); *(f32x4*)(sn + 4) = *(const f32x4*)(rt + 160 + i8 + 4);
            bf16_t* b = PROJw + (size_t)t * NPB + PC_QIX + hh * 64 + i8; float a1[8], a2[8], o1[8], o2[8]; unpack8(*(const u32x4*)b, a1); unpack8(*(const u32x4*)(b + 32), a2);
#pragma unroll
            for (int e = 0; e < 8; ++e) { o1[e] = a1[e] * cs[e] - a2[e] * sn[e]; o2[e] = a2[e] * cs[e] + a1[e] * sn[e]; }
            *(u32x4*)b = pack8(o1); *(u32x4*)(b + 32) = pack8(o2); }
        const float* sm = SM + (size_t)t * 128;
#define SMSUM(col) ({ float a_ = 0.f; _Pragma("unroll") for (int ks_ = 0; ks_ < SMALL_KS; ++ks_) a_ += sm[(size_t)ks_ * S * 128 + (col)]; a_; })
        if (c.lane < 32) { const float a1 = SMSUM(SC_KIX + c.lane), a2 = SMSUM(SC_KIX + 32 + c.lane), cs = rt[128 + c.lane], sn = rt[160 + c.lane];
            KIX[(size_t)t * 64 + c.lane] = f2bf(a1 * cs - a2 * sn); KIX[(size_t)t * 64 + 32 + c.lane] = f2bf(a2 * cs + a1 * sn); }
        else if (c.lane < 48) { const int i = c.lane - 32; WIX[(size_t)t * 16 + i] = SMSUM(SC_WIX + i) * 0.03125f; }
#undef SMSUM
    }
}

__device__ __forceinline__ void p_dn_scan(const Ctx& c) {
    unsigned char* ws = c.ws;
    const bf16_t* DQ = (const bf16_t*)(ws + WS_DNQKV); const float* GB = (const float*)(ws + WS_GB); float* OR = (float*)(ws + WS_ODNRAW);
    if (c.wave != 0) return;
    for (int u = c.bx; u < 256; u += c.G) {
        const int h = u >> 5, j = (u & 31) * 4 + (c.lane >> 4), li = c.lane & 15;
        float s[8];
#pragma unroll
        for (int e = 0; e < 8; ++e) s[e] = 0.f;
        const bf16_t* qp = DQ + h * 128 + li * 8; const bf16_t* kp = DQ + 1024 + h * 128 + li * 8; const bf16_t* vp = DQ + 2048 + h * 128 + j;
#pragma unroll 2
        for (int t = 0; t < S; ++t) {
            float k[8], q[8]; unpack8(*(const u32x4*)(kp + (size_t)t * 3072), k); unpack8(*(const u32x4*)(qp + (size_t)t * 3072), q);
            const float v = bf2f(vp[(size_t)t * 3072]); const float a = __expf(GB[(size_t)t * 8 + h]), beta = GB[(size_t)S * 8 + (size_t)t * 8 + h];
            float d = 0.f;
#pragma unroll
            for (int e = 0; e < 8; ++e) { s[e] *= a; d += k[e] * s[e]; }
            d = row16_sum(d);
            const float dl = beta * (v - d); float o = 0.f;
#pragma unroll
            for (int e = 0; e < 8; ++e) { s[e] += dl * k[e]; o += q[e] * s[e]; }
            o = row16_sum(o);
            if (li == 0) OR[(size_t)t * 1024 + h * 128 + j] = o;
        }
    }
}
__device__ __forceinline__ void p_dn_post(const Ctx& c, int layer) {
    unsigned char* ws = c.ws;
    const float* OR = (const float*)(ws + WS_ODNRAW2); const bf16_t* PROJ = (const bf16_t*)(ws + WS_PROJ); bf16_t* ODN = (bf16_t*)(ws + WS_ODN);
    const float* gn = inptr<const float>(c, IN_DN_NORM) + layer * HD;
    for (int u = c.gw; u < S * 2; u += c.NGW) { const int t = u >> 1, col = (u & 1) * 512 + c.lane * 8, d0 = (c.lane & 15) * 8;
        float o[8], z[8]; *(f32x4*)o = *(const f32x4*)(OR + (size_t)t * 1024 + col); *(f32x4*)(o + 4) = *(const f32x4*)(OR + (size_t)t * 1024 + col + 4);
        unpack8(*(const u32x4*)(PROJ + (size_t)t * NPB + PC_Z + col), z);
        float ss = 0.f;
#pragma unroll
        for (int e = 0; e < 8; ++e) ss += o[e] * o[e];
        ss = row16_sum(ss); const float r = rsqrtf(ss * (1.f / HD) + RMS_EPS);
#pragma unroll
        for (int e = 0; e < 8; ++e) o[e] = o[e] * r * gn[d0 + e] * siluf_(z[e]);
        *(u32x4*)(ODN + (size_t)t * 1024 + col) = pack8(o); }
}


namespace dn {
typedef const f32x4 cf4;
#define OPQ(p) ({ unsigned long long t_ = (unsigned long long)(p); asm volatile("" : "+s"(t_)); (unsigned char*)(GAS unsigned char*)t_; })
constexpr int UNIT_BYTES = 81920, OFF_WF = 0, OFF_KF = 16384, OFF_QF = 32768, OFF_UF = 49152, OFF_OF = 65536;
__device__ __forceinline__ f32x4 mma(bf16x8 a, bf16x8 b, f32x4 c) { return __builtin_amdgcn_mfma_f32_16x16x32_bf16(a, b, c, 0, 0, 0); }
__device__ __forceinline__ bf16x8 pack2(f32x4 a, f32x4 b) { u32x4 w; w.x = cvt_pk_bf16(a[0], a[1]); w.y = cvt_pk_bf16(a[2], a[3]); w.z = cvt_pk_bf16(b[0], b[1]); w.w = cvt_pk_bf16(b[2], b[3]); return __builtin_bit_cast(bf16x8, w); }
__device__ __forceinline__ u32x2 pack4(f32x4 a) { u32x2 w; w.x = cvt_pk_bf16(a[0], a[1]); w.y = cvt_pk_bf16(a[2], a[3]); return w; }
__device__ __forceinline__ f32x4 unpack4(u32x2 w) { f32x4 r; r[0] = __uint_as_float(w.x << 16); r[1] = __uint_as_float(w.x & 0xffff0000u); r[2] = __uint_as_float(w.y << 16); r[3] = __uint_as_float(w.y & 0xffff0000u); return r; }
__device__ __forceinline__ float conv_rows(const char* PROJb, const char* cwb, int n, int h, int tsel, int it, int c16, unsigned xoff, unsigned woff, float (&y)[4][8]) {
    const int t = 64 * n + 16 * it + c16; float ss = 0.f;
    const char* Pb = (const char*)OPQ(PROJb) - 3 * NPB * 2; const char* Cb = (const char*)OPQ(cwb);
    u32x4 xr[4][4];
#pragma unroll
    for (int s = 0; s < 4; ++s)
#pragma unroll
        for (int j = 0; j < 4; ++j) xr[s][j] = *(const u32x4*)(Pb + (xoff + (unsigned)((64 * n + 16 * it + j) * NPB + tsel * 1024 + h * 128 + 32 * s) * 2u));
#pragma unroll
    for (int s = 0; s < 4; ++s) { const int chu = tsel * 1024 + h * 128 + 32 * s;
        float acc[8];
#pragma unroll
        for (int e = 0; e < 8; ++e) acc[e] = 0.f;
#pragma unroll
        for (int j = 0; j < 4; ++j) { float x[8]; unpack8(xr[s][j], x);
            const bool ok = t - 3 + j >= 0;
            const unsigned wo = (unsigned)(j * 3072 + chu) * 4u;
            const f32x4 w0 = *(const f32x4*)(Cb + (woff + wo)), w1 = *(const f32x4*)(Cb + (woff + wo) + 16);
#pragma unroll
            for (int e = 0; e < 4; ++e) { acc[e] += w0[e] * (ok ? x[e] : 0.f); acc[4 + e] += w1[e] * (ok ? x[4 + e] : 0.f); } }
#pragma unroll
        for (int e = 0; e < 8; ++e) { const float v = siluf_(acc[e]); y[s][e] = v; ss += v * v; } }
    asm volatile("" ::: "memory");
    return ss;
}
__device__ __forceinline__ void conv_rows_s4(const char* PROJb, const char* cwb, int n, int h, int tsel, int s, int c16, unsigned xoff, unsigned woff, float (&y)[4][8]) {
    const int chu = tsel * 1024 + h * 128 + 32 * s; const char* Pb = (const char*)OPQ(PROJb) - 3 * NPB * 2; const char* Cb = (const char*)OPQ(cwb);
    u32x4 xr[4][4]; f32x4 w0[4], w1[4];
#pragma unroll
    for (int it = 0; it < 4; ++it)
#pragma unroll
        for (int j = 0; j < 4; ++j) xr[it][j] = *(const u32x4*)(Pb + (xoff + (unsigned)((64 * n + 16 * it + j) * NPB + chu) * 2u));
#pragma unroll
    for (int j = 0; j < 4; ++j) { const unsigned wo = (unsigned)(j * 3072 + chu) * 4u; w0[j] = *(const f32x4*)(Cb + (woff + wo)); w1[j] = *(const f32x4*)(Cb + (woff + wo) + 16); }
#pragma unroll
    for (int it = 0; it < 4; ++it) { const int t = 64 * n + 16 * it + c16; float acc[8];
#pragma unroll
        for (int e = 0; e < 8; ++e) acc[e] = 0.f;
#pragma unroll
        for (int j = 0; j < 4; ++j) { float x[8]; unpack8(xr[it][j], x); const bool ok = t - 3 + j >= 0;
#pragma unroll
            for (int e = 0; e < 4; ++e) { acc[e] += w0[j][e] * (ok ? x[e] : 0.f); acc[4 + e] += w1[j][e] * (ok ? x[4 + e] : 0.f); } }
#pragma unroll
        for (int e = 0; e < 8; ++e) y[it][e] = siluf_(acc[e]); }
}
__device__ __forceinline__ void intra_unit(const Ctx& c, LAS unsigned char* wl, int n, int h, int layer) {
    unsigned char* ws = c.ws;
    const char* PROJb = (const char*)(ws + WS_PROJ); const float* SM = (const float*)(ws + WS_MERGED);
    const char* cwb = (const char*)(inptr<const float>(c, IN_CONV_W) + (size_t)layer * 4 * 3072);
    const int lane = c.lane, c16 = lane & 15, g = lane >> 4;
    const unsigned xoff = (unsigned)(c16 * NPB + 8 * g) * 2u, woff = (unsigned)(8 * g) * 4u, lane16 = (unsigned)lane * 16u, lane8 = (unsigned)lane * 8u;
    unsigned char* ub = ws + WS_DNF + (size_t)(n * DNH + h) * UNIT_BYTES;
    float gtok, beta;
    { const float* sm = SM + (size_t)(64 * n + lane) * 128; float av = 0.f, bv = 0.f;
#pragma unroll
      for (int ks = 0; ks < SMALL_KS; ++ks) { av += sm[(size_t)ks * S * 128 + SC_A + h]; bv += sm[(size_t)ks * S * 128 + SC_B + h]; }
      const float xx = av + inptr<const float>(c, IN_DT_BIAS)[layer * DNH + h];
      const float sp = xx > 20.f ? xx : log1pf(__expf(xx)); gtok = -__expf(inptr<const float>(c, IN_A_LOG)[layer * DNH + h]) * sp; beta = sigmoidf_(bv); }
    LAS float* tgc = (LAS float*)(c.lds + DN_TAB_OFF + c.wave * 1024); LAS float* tbeta = tgc + 64; LAS float* tg = tgc + 128;
    tg[lane] = gtok; tbeta[lane] = beta; LDS_WAIT();
    float gc = 0.f;
#pragma unroll
    for (int m = 0; m < 16; ++m) { const f32x4 v = *(const LAS f32x4*)(tg + 4 * m);
#pragma unroll
        for (int q = 0; q < 4; ++q) gc += (4 * m + q <= lane) ? v[q] : 0.f; }
    tgc[lane] = gc; LDS_WAIT();
    const float gc63 = tgc[63];
    if (lane == 0) ((float*)(ws + WS_GL))[n * DNH + h] = __expf(gc63);
#define LOAD_GC() float gcR[16], gcC[4]; _Pragma("unroll") for (int jt_ = 0; jt_ < 4; ++jt_) { gcC[jt_] = tgc[16 * jt_ + c16]; *(f32x4*)(&gcR[4 * jt_]) = *(const LAS f32x4*)(tgc + 16 * jt_ + 4 * g); }
    const f32x4 Z4 = {0.f, 0.f, 0.f, 0.f};
    LAS float* AT = (LAS float*)wl;
    bf16x8 AF[4][2];
    { bf16x8 Kf[4][4];
#pragma unroll
      for (int it = 0; it < 4; ++it) { float y[4][8];
          float ss = conv_rows(PROJb, cwb, n, h, 1, it, c16, xoff, woff, y); ss += __shfl_xor(ss, 16); ss += __shfl_xor(ss, 32);
          const float r = rsqrtf(ss + L2_EPS);
#pragma unroll
          for (int s = 0; s < 4; ++s) { float z[8];
#pragma unroll
              for (int e = 0; e < 8; ++e) z[e] = y[s][e] * r;
              Kf[it][s] = __builtin_bit_cast(bf16x8, pack8(z)); *(bf16x8*)(OPQ(ub) + (OFF_OF + (it * 4 + s) * 1024) + lane16) = Kf[it][s]; }
          asm volatile("" ::: "memory"); }
      { LOAD_GC(); float betaR[16];
#pragma unroll
        for (int jt = 0; jt < 4; ++jt) *(f32x4*)(&betaR[4 * jt]) = *(const LAS f32x4*)(tbeta + 16 * jt + 4 * g);
#pragma unroll
        for (int ct = 0; ct < 4; ++ct)
#pragma unroll
            for (int jt = ct; jt < 4; ++jt) { f32x4 acc = Z4;
#pragma unroll
                for (int s = 0; s < 4; ++s) acc = mma(Kf[jt][s], Kf[ct][s], acc);
                const int cc = 16 * ct + c16; f32x4 o;
#pragma unroll
                for (int r = 0; r < 4; ++r) { const int j = 16 * jt + 4 * g + r; o[r] = j > cc ? betaR[4 * jt + r] * acc[r] * __expf(gcR[4 * jt + r] - gcC[ct]) : 0.f; }
                *(LAS f32x4*)(AT + cc * 64 + 16 * jt + 4 * g) = o; } }
      asm volatile("" ::: "memory"); }
#pragma unroll
    for (int it = 0; it < 4; ++it) { float y[4][8];
        float ss = conv_rows(PROJb, cwb, n, h, 0, it, c16, xoff, woff, y); ss += __shfl_xor(ss, 16); ss += __shfl_xor(ss, 32);
        const float r = rsqrtf(ss + L2_EPS) * 0.08838834764831845f;
#pragma unroll
        for (int s = 0; s < 4; ++s) { float z[8];
#pragma unroll
            for (int e = 0; e < 8; ++e) z[e] = y[s][e] * r;
            *(bf16x8*)(OPQ(ub) + (OFF_UF + (it * 4 + s) * 1024) + lane16) = __builtin_bit_cast(bf16x8, pack8(z)); }
        asm volatile("" ::: "memory"); }
    asm volatile("s_waitcnt vmcnt(0)" ::: "memory");
    { bf16x8 Kf[4][4];
#pragma unroll
      for (int it = 0; it < 4; ++it)
#pragma unroll
          for (int s = 0; s < 4; ++s) Kf[it][s] = *(const bf16x8*)(OPQ(ub) + (OFF_OF + (it * 4 + s) * 1024) + lane16);
      LOAD_GC();
      bf16x8 Qa[4][4];
#pragma unroll
      for (int it = 0; it < 4; ++it)
#pragma unroll
          for (int s = 0; s < 4; ++s) Qa[it][s] = *(const bf16x8*)(OPQ(ub) + (OFF_UF + (it * 4 + s) * 1024) + lane16);
#pragma unroll
      for (int it = 0; it < 4; ++it) { const bf16x8 (&Qr)[4] = Qa[it];
#pragma unroll
          for (int s = 0; s < 2; ++s) { f32x4 t2[2];
#pragma unroll
              for (int q = 0; q < 2; ++q) { const int jt = 2 * s + q; f32x4 acc = Z4;
                  if (it >= jt) {
#pragma unroll
                      for (int ks = 0; ks < 4; ++ks) acc = mma(Kf[jt][ks], Qr[ks], acc);
                      const int i = 16 * it + c16;
#pragma unroll
                      for (int r = 0; r < 4; ++r) { const int j = 16 * jt + 4 * g + r; acc[r] = i >= j ? acc[r] * __expf(gcC[it] - gcR[4 * jt + r]) : 0.f; } }
                  t2[q] = acc; }
              AF[it][s] = pack2(t2[0], t2[1]); } }
      asm volatile("" ::: "memory"); }
    LDS_WAIT();
    { float T[64];
#pragma unroll
      for (int cc = 63; cc >= 0; --cc) { float a0 = lane == cc ? 1.f : 0.f, a1 = 0.f;
#pragma unroll
          for (int m = (cc + 1) >> 2; m < 16; ++m) { const f32x4 av = *(const LAS f32x4*)(AT + cc * 64 + 4 * m);
#pragma unroll
              for (int q = 0; q < 4; ++q) { const int j = 4 * m + q; if (j > cc) { if (j & 1) a1 -= T[j] * av[q]; else a0 -= T[j] * av[q]; } } }
          T[cc] = a0 + a1; asm volatile("" : "+v"(T[cc])); }
      LDS_WAIT();
#pragma unroll
      for (int m = 0; m < 16; ++m) { u32x2 w; w.x = cvt_pk_bf16(T[4 * m], T[4 * m + 1]); w.y = cvt_pk_bf16(T[4 * m + 2], T[4 * m + 3]); *(LAS u32x2*)(wl + lane * 136 + 8 * m) = w; } }
    LDS_WAIT();
    bf16x8 TF[4][2];
#pragma unroll
    for (int it = 0; it < 4; ++it)
#pragma unroll
        for (int s = 0; s < 2; ++s) { const int i = 16 * it + c16; const u32x2 lo = *(const LAS u32x2*)(wl + i * 136 + (32 * s + 4 * g) * 2), hi2 = *(const LAS u32x2*)(wl + i * 136 + (32 * s + 16 + 4 * g) * 2);
            u32x4 w; w.x = lo.x; w.y = lo.y; w.z = hi2.x; w.w = hi2.y; TF[it][s] = __builtin_bit_cast(bf16x8, w); }
    bf16x8 ID0, ID1;
    { u32x4 w0 = {0u, 0u, 0u, 0u}, w1 = {0u, 0u, 0u, 0u}; const int e0 = c16 - 8 * g, e1 = c16 + 16 - 8 * g;
#pragma unroll
      for (int e = 0; e < 8; ++e) { const unsigned one = (e & 1) ? 0x3F800000u : 0x00003F80u; if (e == e0) w0[e >> 1] |= one; if (e == e1) w1[e >> 1] |= one; }
      ID0 = __builtin_bit_cast(bf16x8, w0); ID1 = __builtin_bit_cast(bf16x8, w1); }
    { asm volatile("" ::: "memory"); LOAD_GC(); float sc1[16], sc2[16];
#pragma unroll
      for (int jt = 0; jt < 4; ++jt)
#pragma unroll
          for (int r = 0; r < 4; ++r) { const float b = tbeta[16 * jt + 4 * g + r]; sc1[4 * jt + r] = b * __expf(gcR[4 * jt + r]); sc2[4 * jt + r] = __expf(gc63 - gcR[4 * jt + r]); }
      float egC[4];
#pragma unroll
      for (int it = 0; it < 4; ++it) egC[it] = __expf(gcC[it]);
      bf16x8 Kfn[4], Qfn[4];
#pragma unroll
      for (int it = 0; it < 4; ++it) { Kfn[it] = *(const bf16x8*)(OPQ(ub) + (OFF_OF + (it * 4) * 1024) + lane16); Qfn[it] = *(const bf16x8*)(OPQ(ub) + (OFF_UF + (it * 4) * 1024) + lane16); }
#pragma unroll
      for (int s4 = 0; s4 < 4; ++s4) { bf16x8 Kfs[4], Qfs[4];
#pragma unroll
          for (int it = 0; it < 4; ++it) { Kfs[it] = Kfn[it]; Qfs[it] = Qfn[it]; }
          if (s4 < 3) {
#pragma unroll
              for (int it = 0; it < 4; ++it) { Kfn[it] = *(const bf16x8*)(OPQ(ub) + (OFF_OF + (it * 4 + s4 + 1) * 1024) + lane16); Qfn[it] = *(const bf16x8*)(OPQ(ub) + (OFF_UF + (it * 4 + s4 + 1) * 1024) + lane16); } }
#pragma unroll
          for (int par = 0; par < 2; ++par) { const int dt = 2 * s4 + par; const bf16x8 ID = par ? ID1 : ID0;
              f32x4 Kc[4];
#pragma unroll
              for (int jt = 0; jt < 4; ++jt) Kc[jt] = mma(Kfs[jt], ID, Z4);
              bf16x8 B1A[2];
#pragma unroll
              for (int s = 0; s < 2; ++s) { f32x4 a, b, a2, b2;
#pragma unroll
                  for (int r = 0; r < 4; ++r) { a[r] = Kc[2 * s][r] * sc1[8 * s + r]; b[r] = Kc[2 * s + 1][r] * sc1[8 * s + 4 + r]; a2[r] = Kc[2 * s][r] * sc2[8 * s + r]; b2[r] = Kc[2 * s + 1][r] * sc2[8 * s + 4 + r]; }
                  B1A[s] = pack2(a, b);
                  *(bf16x8*)(OPQ(ub) + (OFF_KF + (dt * 2 + s) * 1024) + lane16) = pack2(a2, b2); }
#pragma unroll
              for (int it = 0; it < 4; ++it) { f32x4 acc = Z4;
#pragma unroll
                  for (int s = 0; s < 2; ++s) acc = mma(B1A[s], TF[it][s], acc);
                  *(u32x2*)(OPQ(ub) + (OFF_WF + (it * 4 + s4) * 1024 + 8 * par) + lane16) = pack4(acc); }
              f32x4 Wc[4];
#pragma unroll
              for (int jt = 0; jt < 4; ++jt) { f32x4 acc = Z4;
#pragma unroll
                  for (int s = 0; s < 2; ++s) acc = mma(TF[jt][s], B1A[s], acc);
                  Wc[jt] = -acc; }
              bf16x8 WA[2];
#pragma unroll
              for (int s = 0; s < 2; ++s) WA[s] = pack2(Wc[2 * s], Wc[2 * s + 1]);
#pragma unroll
              for (int it = 0; it < 4; ++it) { f32x4 acc = mma(ID, Qfs[it], Z4); acc = acc * egC[it];
#pragma unroll
                  for (int s = 0; s < 2; ++s) acc = mma(WA[s], AF[it][s], acc);
                  *(u32x2*)(OPQ(ub) + (OFF_QF + (it * 4 + s4) * 1024 + 8 * par) + lane16) = pack4(acc); }
              asm volatile("" ::: "memory"); } } }
    asm volatile("s_waitcnt vmcnt(0)" ::: "memory");
    { float betaR[16];
#pragma unroll
      for (int jt = 0; jt < 4; ++jt) *(f32x4*)(&betaR[4 * jt]) = *(const LAS f32x4*)(tbeta + 16 * jt + 4 * g);
#pragma unroll
      for (int s4 = 0; s4 < 4; ++s4) { bf16x8 Vfs[4];
          { float y[4][8]; conv_rows_s4(PROJb, cwb, n, h, 2, s4, c16, xoff, woff, y);
#pragma unroll
            for (int it = 0; it < 4; ++it) Vfs[it] = __builtin_bit_cast(bf16x8, pack8(y[it])); }
#pragma unroll
        for (int par = 0; par < 2; ++par) { const int dvt = 2 * s4 + par; const bf16x8 ID = par ? ID1 : ID0;
          f32x4 Vc[4];
#pragma unroll
          for (int jt = 0; jt < 4; ++jt) { Vc[jt] = mma(Vfs[jt], ID, Z4);
#pragma unroll
              for (int r = 0; r < 4; ++r) Vc[jt][r] *= betaR[4 * jt + r]; }
          bf16x8 B2F[2] = {pack2(Vc[0], Vc[1]), pack2(Vc[2], Vc[3])};
          f32x4 Uc[4];
#pragma unroll
          for (int it = 0; it < 4; ++it) { f32x4 acc = Z4;
#pragma unroll
              for (int s = 0; s < 2; ++s) acc = mma(TF[it][s], B2F[s], acc);
              Uc[it] = acc; *(u32x2*)(OPQ(ub) + (OFF_UF + (dvt * 4 + it) * 512) + lane8) = pack4(acc); }
          bf16x8 UB[2] = {pack2(Uc[0], Uc[1]), pack2(Uc[2], Uc[3])};
#pragma unroll
          for (int it = 0; it < 4; ++it) { f32x4 acc = Z4;
#pragma unroll
              for (int s = 0; s < 2; ++s) acc = mma(AF[it][s], UB[s], acc);
              *(u32x2*)(OPQ(ub) + (OFF_OF + (dvt * 4 + it) * 512) + lane8) = pack4(acc); }
          asm volatile("" ::: "memory"); } } }
    LDS_WAIT();
}
__device__ __forceinline__ void scan_head(const Ctx& c, int h) {
    unsigned char* ws = c.ws; const int lane = c.lane, ns = c.wave; const unsigned lane16 = (unsigned)lane * 16u, lane8 = (unsigned)lane * 8u;
    const float* GL = (const float*)(ws + WS_GL);
    const f32x4 Z4 = {0.f, 0.f, 0.f, 0.f};
    f32x4 Sc[8]; bf16x8 SB[4];
#pragma unroll
    for (int m = 0; m < 8; ++m) Sc[m] = Z4;
#pragma unroll
    for (int s = 0; s < 4; ++s) SB[s] = pack2(Z4, Z4);
    const unsigned char* base = ws + WS_DNF + (size_t)h * UNIT_BYTES;
    LAS unsigned char* lds = c.lds;
#define SCAN_DMA(n_, b_) do { const unsigned char* ug_ = OPQ(base + (size_t)(n_) * (DNH * UNIT_BYTES)); _Pragma("unroll") for (int i_ = 0; i_ < 6; ++i_) \
        __builtin_amdgcn_global_load_lds((const unsigned*)(ug_ + (ns * 6 + i_) * 1024 + lane16), (LAS unsigned*)(lds + (b_) * 49152 + (ns * 6 + i_) * 1024), 16, 0, 0); } while (0)
#define SCAN_UO(n_, U_, O_) do { const unsigned char* ug_ = OPQ(base + (size_t)(n_) * (DNH * UNIT_BYTES)); _Pragma("unroll") for (int it = 0; it < 4; ++it) { \
        U_[it] = *(const u32x2*)(ug_ + (OFF_UF + (ns * 4 + it) * 512) + lane8); O_[it] = *(const u32x2*)(ug_ + (OFF_OF + (ns * 4 + it) * 512) + lane8); } } while (0)
#define SCAN_STEP(n_, b_, U_, O_, GL_, UN_, ON_, GLN_) do { const int nn_ = (n_) + 1 < S / 64 ? (n_) + 1 : (n_); \
        __builtin_amdgcn_s_waitcnt(0x0F70);                         \
        asm volatile("" ::: "memory"); \
        __builtin_amdgcn_s_barrier();                               \
        asm volatile("" ::: "memory"); \
        if ((n_) + 1 < S / 64) SCAN_DMA((n_) + 1, (b_) ^ 1); \
        SCAN_UO(nn_, UN_, ON_); GLN_ = GL[nn_ * DNH + h];           \
        const LAS unsigned char* fb = lds + (b_) * 49152 + lane16; \
        unsigned char* ob = OPQ(ws + WS_ODNRAW2 + ((size_t)(64 * (n_)) * 1024 + h * 128 + 16 * ns) * 4); int ln_ = lane; asm volatile("" : "+v"(ln_)); const unsigned lo_ = (unsigned)(4 * (ln_ >> 4) * 1024 + (ln_ & 15)) * 4u; \
        _Pragma("unroll") for (int it = 0; it < 4; ++it) { f32x4 acc = unpack4(O_[it]);                  \
            _Pragma("unroll") for (int s4 = 0; s4 < 4; ++s4) acc = mma(*(const LAS bf16x8*)(fb + OFF_QF + (it * 4 + s4) * 1024), SB[s4], acc); \
            _Pragma("unroll") for (int r = 0; r < 4; ++r) *(float*)(ob + (size_t)(16 * it + r) * 4096 + lo_) = acc[r]; } \
        f32x4 R[4]; \
        _Pragma("unroll") for (int it = 0; it < 4; ++it) { f32x4 acc = Z4; \
            _Pragma("unroll") for (int s4 = 0; s4 < 4; ++s4) acc = mma(*(const LAS bf16x8*)(fb + OFF_WF + (it * 4 + s4) * 1024), SB[s4], acc); \
            R[it] = unpack4(U_[it]) - acc; } \
        const bf16x8 RB0 = pack2(R[0], R[1]), RB1 = pack2(R[2], R[3]); \
        _Pragma("unroll") for (int m = 0; m < 8; ++m) { f32x4 acc = Sc[m] * GL_; acc = mma(*(const LAS bf16x8*)(fb + OFF_KF + (m * 2) * 1024), RB0, acc); acc = mma(*(const LAS bf16x8*)(fb + OFF_KF + (m * 2 + 1) * 1024), RB1, acc); Sc[m] = acc; } \
        _Pragma("unroll") for (int s = 0; s < 4; ++s) SB[s] = pack2(Sc[2 * s], Sc[2 * s + 1]); } while (0)
    u32x2 Ua[4], Oa[4], Ub[4], Ob[4]; float gla, glb;
    SCAN_DMA(0, 0); SCAN_UO(0, Ua, Oa); gla = GL[h];
    for (int n = 0; n < S / 64; n += 2) {
        SCAN_STEP(n, 0, Ua, Oa, gla, Ub, Ob, glb);
        SCAN_STEP(n + 1, 1, Ub, Ob, glb, Ua, Oa, gla);
    }
    asm volatile("s_waitcnt vmcnt(0)" ::: "memory");
#undef SCAN_STEP
#undef SCAN_DMA
#undef SCAN_UO
}
#undef LOAD_GC
}

__device__ __forceinline__ void p_dn_intra(const Ctx& c, int layer) {
    LAS unsigned char* wl = c.lds + c.wave * 16384;
    for (int u = c.bx * 4 + c.wave; u < (S / 64) * DNH; u += c.G * 4) { Ctx cu = c; asm volatile("" : "+v"(cu.lane)); dn::intra_unit(cu, wl, u >> 3, u & 7, layer); }
}

constexpr int PKN = 32;
__device__ __forceinline__ unsigned fkey(float f) { const unsigned b = __float_as_uint(f); return b ^ ((unsigned)((int)b >> 31) | 0x80000000u); }
__device__ __forceinline__ void p_select(const Ctx& c, const int layer) {
    unsigned char* ws = c.ws;
    const bf16_t* PROJ = (const bf16_t*)(ws + WS_PROJ); const bf16_t* KIX = (const bf16_t*)(ws + WS_KIX); const float* WIX = (const float*)(ws + WS_WIX);
    unsigned* MASK = (unsigned*)(ws + WS_MASK);
    LAS float* SC = (LAS float*)c.lds;
    const int nunits = S / 4;
    unsigned* ctr = (unsigned*)(ws + WS_CTL) + CW_SELQ + layer * 64;
    LAS int* nx = (LAS int*)(c.lds + MISC_OFF + 512);
    const bool scorer = c.wave >= 4;
    auto score_unit = [&](int tk) {
        const int r = c.lane & 31, hi = c.lane >> 5, sw = c.wave - 4;
        const int u = nunits - 1 - tk, t0 = u * 4, ntile = (t0 + 4 + 31) >> 5;
        bf16x8 A[2][4]; h2_t wq[2][8];
#pragma unroll
        for (int m = 0; m < 2; ++m) { const int tq = t0 + 2 * m + ((r >> 2) & 1), hd = (r & 3) + 4 * (r >> 3);
#pragma unroll
            for (int s = 0; s < 4; ++s) A[m][s] = *(const bf16x8*)(PROJ + (size_t)tq * NPB + PC_QIX + hd * 64 + 16 * s + 8 * hi);
            const float* wp = WIX + (size_t)(t0 + 2 * m + hi) * 16;
#pragma unroll
            for (int q4 = 0; q4 < 4; ++q4) { const f32x4 wv = *(const f32x4*)(wp + 4 * q4); wq[m][2 * q4] = __builtin_bit_cast(h2_t, __builtin_amdgcn_cvt_pkrtz(wv[0], wv[1])); wq[m][2 * q4 + 1] = __builtin_bit_cast(h2_t, __builtin_amdgcn_cvt_pkrtz(wv[2], wv[3])); } }
        const bf16_t* kb = KIX + (size_t)r * 64 + 8 * hi;
        bf16x8 B0[4], B1[4], B2[4];
        int tl = sw;
#define LDB(dst, t_) do { const int tt_ = (t_) < ntile ? (t_) : ntile - 1; _Pragma("unroll") for (int s = 0; s < 4; ++s) dst[s] = *(const bf16x8*)(kb + (size_t)tt_ * 2048 + 16 * s); } while (0)
        asm volatile("" ::: "memory"); LDB(B0, tl); asm volatile("" ::: "memory"); LDB(B1, tl + 4); asm volatile("" ::: "memory"); LDB(B2, tl + 8); asm volatile("" ::: "memory");
#define SC_STEP(BX) do { const int key = (tl < ntile ? tl : ntile - 1) * 32 + r;     \
            _Pragma("unroll") for (int m = 0; m < 2; ++m) { f32x16 acc = {}; \
                _Pragma("unroll") for (int s = 0; s < 4; ++s) acc = __builtin_amdgcn_mfma_f32_32x32x16_bf16(A[m][s], BX[s], acc, 0, 0, 0); \
                float sc = 0.f; const h2_t hz = {(_Float16)0, (_Float16)0}; \
                _Pragma("unroll") for (int e = 0; e < 8; ++e) { h2_t x = __builtin_bit_cast(h2_t, __builtin_amdgcn_cvt_pkrtz(acc[2 * e], acc[2 * e + 1])); x = __builtin_elementwise_max(x, hz); sc = __builtin_amdgcn_fdot2(x, wq[m][e], sc, false); } \
                const int tq = t0 + 2 * m + hi; \
                ((LAS unsigned*)SC)[(2 * m + hi) * 8192 + key] = key <= tq ? fkey(sc) : 0u; } \
            __builtin_amdgcn_sched_barrier(0); LDB(BX, tl + 12); __builtin_amdgcn_sched_barrier(0); tl += 4; } while (0)
        while (tl < ntile) { SC_STEP(B0); SC_STEP(B1); SC_STEP(B2); }
        { const int Rz = ntile * 32, Rg = (Rz + 1023) & ~1023;
          for (int kk = Rz + c.lane; kk < Rg; kk += 64) ((LAS unsigned*)SC)[sw * 8192 + kk] = 0u; }
#undef SC_STEP
#undef LDB
    };
    if (c.tid == 0) { nx[0] = (int)__hip_atomic_fetch_add(ctr, 1u, __ATOMIC_RELAXED, __HIP_MEMORY_SCOPE_AGENT); nx[1] = (int)__hip_atomic_fetch_add(ctr, 1u, __ATOMIC_RELAXED, __HIP_MEMORY_SCOPE_AGENT); }
    __syncthreads();
    int tcur = nx[0];
    if (scorer) {
        if (tcur < nunits) score_unit(tcur);
        __syncthreads();
        for (int k = 0; tcur < nunits; ++k) { const int tnext = nx[(k + 1) & 1]; __syncthreads(); if (tnext < nunits) score_unit(tnext); __syncthreads(); tcur = tnext; }
    } else {
        __syncthreads();
        for (int k = 0; tcur < nunits; ++k) {
        const int tnext = nx[(k + 1) & 1];
        const int u = nunits - 1 - tcur, t0 = u * 4, ntile = (t0 + 4 + 31) >> 5;
        int ln = c.lane; asm volatile("" : "+v"(ln));
        const int q = c.wave & 3, tq = t0 + q, n = tq + 1, R = ntile * 32;
        unsigned key[128];
        { const LAS unsigned* sq = (const LAS unsigned*)SC + q * 8192 + ln;
#pragma unroll
            for (int gq = 0; gq < 8; ++gq) {
                if (gq * 1024 < R) {
#pragma unroll
                    for (int jj = 0; jj < 16; ++jj) key[gq * 16 + jj] = sq[(gq * 16 + jj) * 64];
                    __builtin_amdgcn_sched_barrier(0); }
                else {
#pragma unroll
                    for (int jj = 0; jj < 16; ++jj) key[gq * 16 + jj] = 0u; } }
            LDS_WAIT(); }
        __syncthreads();
        unsigned tk2 = 0u; if (c.tid == 0) tk2 = __hip_atomic_fetch_add(ctr, 1u, __ATOMIC_RELAXED, __HIP_MEMORY_SCOPE_AGENT);
        {
#define CNT_ALL(OP, V) ({ int c0_ = 0, c1_ = 0, c2_ = 0, c3_ = 0; _Pragma("unroll") for (int gq_ = 0; gq_ < 8; ++gq_) if (gq_ * 1024 < R) { _Pragma("unroll") for (int jj_ = 0; jj_ < 16; jj_ += 4) { \
    c0_ += (key[gq_ * 16 + jj_] OP (V)) ? 1 : 0; c1_ += (key[gq_ * 16 + jj_ + 1] OP (V)) ? 1 : 0; c2_ += (key[gq_ * 16 + jj_ + 2] OP (V)) ? 1 : 0; c3_ += (key[gq_ * 16 + jj_ + 3] OP (V)) ? 1 : 0; } } wave_isum((c0_ + c1_) + (c2_ + c3_)); })
#define CNT_CK(OP, V) ({ int c0_ = 0, c1_ = 0; _Pragma("unroll") for (int jj_ = 0; jj_ < 8; jj_ += 2) { c0_ += (ck[jj_] OP (V)) ? 1 : 0; c1_ += (ck[jj_ + 1] OP (V)) ? 1 : 0; } wave_isum(c0_ + c1_); })
            unsigned thr = 0u; int need_eq = 0; bool simple = true;
            if (n > TOPK) {
                u16x2_t pk[PKN];
#define PK_OF(i_) __builtin_bit_cast(u16x2_t, __builtin_amdgcn_perm(key[2 * (i_) + 1], key[2 * (i_)], sel_))
#pragma unroll
                for (int i = 0; i < PKN; ++i) { const unsigned sel_ = 0x07060302u; pk[i] = PK_OF(i); }
#define PK_GE(x_) ({ u16x2_t t_; asm("v_pk_sub_u16 %0, %1, %2 clamp\n\tv_pk_min_u16 %0, %0, %3" : "=&v"(t_) : "v"(x_), "s"(cv_), "s"(one_)); t_; })
#define PK_AT(i_) ((i_) < PKN ? pk[(i_) < PKN ? (i_) : 0] : PK_OF(i_))
#define CNT_PK(C16) ({ unsigned sel_ = 0x07060302u; asm volatile("" : "+s"(sel_));     \
    const unsigned cv_ = ((unsigned)(C16) - 1u) * 0x10001u, one_ = 0x10001u; u16x2_t a0_ = {0, 0}, a1_ = {0, 0}; \
    _Pragma("unroll") for (int gq_ = 0; gq_ < 8; ++gq_) if (gq_ * 1024 < R) { _Pragma("unroll") for (int jj_ = 0; jj_ < 8; jj_ += 2) { \
        a0_ += PK_GE(PK_AT(gq_ * 8 + jj_)); a1_ += PK_GE(PK_AT(gq_ * 8 + jj_ + 1)); } } \
    const unsigned s_ = __builtin_bit_cast(unsigned, a0_ + a1_); wave_isum((int)((s_ & 0xffffu) + (s_ >> 16))); })
                for (int bit = 31; bit >= 16; --bit) { const unsigned cand = thr | (1u << bit); if (CNT_PK(cand >> 16) >= TOPK) thr = cand; }
                const unsigned P = thr >> 16; const int c_hi = P == 0xFFFFu ? 0 : CNT_PK(P + 1u);
#undef CNT_PK
#undef PK_AT
#undef PK_OF
#undef PK_GE
                LAS unsigned* cl = (LAS unsigned*)(c.lds + DN_TAB_OFF + q * 2048); int nb = 0;
#pragma unroll
                for (int gq = 0; gq < 8; ++gq) if (gq * 1024 < R) {
#pragma unroll
                    for (int jj = 0; jj < 16; ++jj) { const unsigned kv = key[gq * 16 + jj]; const bool inb = (kv >> 16) == P && kv != 0u; const unsigned long long m = __ballot(inb);
                        if (inb) { const int o = nb + (int)__builtin_amdgcn_mbcnt_hi((unsigned)(m >> 32), __builtin_amdgcn_mbcnt_lo((unsigned)m, 0u)); if (o < 512) cl[o] = kv; } nb += __popcll(m); } }
                LDS_WAIT();
                if (nb <= 512) { unsigned ck[8];
#pragma unroll
                    for (int jj = 0; jj < 8; ++jj) ck[jj] = (jj * 64 + ln) < nb ? cl[jj * 64 + ln] : 0u;
                    for (int bit = 15; bit >= 0; --bit) { const unsigned cand = thr | (1u << bit); if (c_hi + CNT_CK(>=, cand) >= TOPK) thr = cand; }
                    need_eq = TOPK - (c_hi + CNT_CK(>, thr)); simple = CNT_CK(==, thr) == need_eq; }
                else {
                    for (int bit = 15; bit >= 0; --bit) { const unsigned cand = thr | (1u << bit); if (CNT_ALL(>=, cand) >= TOPK) thr = cand; }
                    need_eq = TOPK - CNT_ALL(>, thr); simple = CNT_ALL(==, thr) == need_eq; }
            }
            int tie_seen = 0; int mA0 = 0, mA1 = 0, mB0 = 0, mB1 = 0;
#pragma unroll
            for (int gq = 0; gq < 8; ++gq) if (gq * 1024 < R) {
#pragma unroll
                for (int jj = 0; jj < 16; ++jj) { const int j = gq * 16 + jj, kk = j * 64 + ln; bool sel;
                    if (n <= TOPK) sel = kk < n;
                    else if (simple) sel = key[j] >= thr;
                    else { const unsigned ku = key[j]; const bool inr = true; const bool tie = ku == thr; const unsigned long long tm = __ballot(tie);
                        const int rank = tie_seen + __popcll(tm & ((1ull << ln) - 1ull)); sel = inr && ((ku > thr) || (tie && rank < need_eq)); tie_seen += __popcll(tm); }
                    const unsigned long long bm = __ballot(sel);
                    if (j < 64) { const bool me = ln == j; mA0 = me ? (int)(unsigned)bm : mA0; mA1 = me ? (int)(unsigned)(bm >> 32) : mA1; }
                    else { const bool me = ln == j - 64; mB0 = me ? (int)(unsigned)bm : mB0; mB1 = me ? (int)(unsigned)(bm >> 32) : mB1; } } }
#undef CNT_ALL
#undef CNT_CK
            unsigned* mrow = MASK + ((size_t)(tq >> 5) * 128 * 32 + (tq & 31)) * 2;
            { u32x2 w; w.x = (unsigned)mA0; w.y = (unsigned)mA1; *(u32x2*)(mrow + (size_t)ln * 64) = w; w.x = (unsigned)mB0; w.y = (unsigned)mB1; *(u32x2*)(mrow + (size_t)(64 + ln) * 64) = w; }
        }
        if (c.tid == 0) nx[k & 1] = (int)tk2;
        __syncthreads();
        tcur = tnext;
        }
    }
}

__device__ __forceinline__ void p_attn_naive(const Ctx& c) {
    unsigned char* ws = c.ws;
    const bf16_t* PROJ = (const bf16_t*)(ws + WS_PROJ); const unsigned* MASK = (const unsigned*)(ws + WS_MASK); bf16_t* OSA = (bf16_t*)(ws + WS_OSA);
    LAS int* idx = (LAS int*)c.lds;
    LAS int* wtot = (LAS int*)(c.lds + 4096);
    LAS float* lg = (LAS float*)(c.lds + 8192) + c.wave * 512;
    const int h = c.wave, g4 = c.lane >> 4, li = c.lane & 15;
    for (int t = c.bx; t < S; t += c.G) {
        int cntw = 0; unsigned wbits = 0;
        if (c.tid < 256) { wbits = MASK[(size_t)t * 256 + c.tid]; cntw = __popc(wbits); }
        int incl = cntw;
#pragma unroll
        for (int o = 1; o < 64; o <<= 1) { const int y = __shfl_up(incl, o); if (c.lane >= o) incl += y; }
        if (c.tid < 256 && c.lane == 63) wtot[c.wave] = incl;
        __syncthreads();
        int base = 0, nsel = wtot[0] + wtot[1] + wtot[2] + wtot[3];
        for (int w = 0; w < 4; ++w) if (w < c.wave) base += wtot[w];
        if (c.tid < 256) { int pos = base + incl - cntw; unsigned b = wbits; while (b) { const int bit = __builtin_ctz(b); b &= b - 1; if (pos < 512) idx[pos] = c.tid * 32 + bit; ++pos; } }
        __syncthreads();
        if (nsel > 512) nsel = 512;
        float q[8]; unpack8(*(const u32x4*)(PROJ + (size_t)t * NPB + PC_QSA + h * 128 + li * 8), q);
#pragma unroll
        for (int e = 0; e < 8; ++e) q[e] *= 0.08838834764831845f;
        float mx = -__builtin_inff();
        for (int j0 = 0; j0 < nsel; j0 += 16) {
            float d[4];
#pragma unroll
            for (int uu = 0; uu < 4; ++uu) { const int j = j0 + uu * 4 + g4; d[uu] = 0.f;
                if (j < nsel) { float k[8]; unpack8(*(const u32x4*)(PROJ + (size_t)idx[j] * NPB + PC_KSA + h * 128 + li * 8), k);
#pragma unroll
                    for (int e = 0; e < 8; ++e) d[uu] += q[e] * k[e]; } }
#pragma unroll
            for (int uu = 0; uu < 4; ++uu) { const int j = j0 + uu * 4 + g4; const float dd = row16_sum(d[uu]); if (j < nsel) { if (li == 0) lg[j] = dd; mx = fmaxf(mx, dd); } }
        }
        mx = wave_max(mx);
        LDS_WAIT();
        float o[8], den = 0.f;
#pragma unroll
        for (int e = 0; e < 8; ++e) o[e] = 0.f;
        for (int j0 = 0; j0 < nsel; j0 += 16) {
#pragma unroll
            for (int uu = 0; uu < 4; ++uu) { const int j = j0 + uu * 4 + g4;
                if (j < nsel) { const float pj = __expf(lg[j] - mx); den += pj; float v[8]; unpack8(*(const u32x4*)(PROJ + (size_t)idx[j] * NPB + PC_VSA + h * 128 + li * 8), v);
#pragma unroll
                    for (int e = 0; e < 8; ++e) o[e] += pj * v[e]; } }
        }
        den += __shfl_xor(den, 16); den += __shfl_xor(den, 32);
#pragma unroll
        for (int e = 0; e < 8; ++e) { o[e] += __shfl_xor(o[e], 16); o[e] += __shfl_xor(o[e], 32); }
        const float rd = 1.f / den;
#pragma unroll
        for (int e = 0; e < 8; ++e) o[e] *= rd;
        if (g4 == 0) *(u32x4*)(OSA + (size_t)t * 1024 + h * 128 + li * 8) = pack8(o);
        __syncthreads();
    }
}


namespace att {
constexpr int NW = 8, QBLK = 32, KVBLK = 64, QB = NW * QBLK, D = 128;
constexpr int SHM_V = KVBLK * D * 2, SHM_K = KVBLK * D * 2;
constexpr int LDS_NEED = 2 * SHM_V + 2 * SHM_K + NW * 64 * 4;
constexpr int PITCH = NPB, OPITCH = 128;
constexpr float SCALE = 0.08838834764831845f, THR = 8.f;
typedef short s16x4 __attribute__((ext_vector_type(4)));
#define KSWZ(row, colB) ((row) * 256 + ((colB) ^ (((row) & 7) << 4)))
#define SBAR() __builtin_amdgcn_sched_barrier(0)
__device__ __forceinline__ int v_st(int k, int c) { const int kk = (k & ~0xC) | ((k & 4) << 1) | ((k & 8) >> 1); return ((kk >> 3) * 4 + (c >> 5)) * 512 + ((kk & 7) * 32 + (c & 31)) * 2; }
__device__ __forceinline__ int v_rd_base(int lane) { return ((lane & 3) << 3) | (((lane >> 2) & 3) << 6) | (((lane >> 4) & 1) << 5) | (((lane >> 5) & 1) << 8); }
constexpr int v_rd_off(int d0, int ks, int half) { return d0 * 512 + ks * 4096 + half * 2048; }
__device__ __forceinline__ int crow(int r, int hi) { return (r & 3) + 8 * (r >> 2) + 4 * hi; }
__device__ __forceinline__ void partialSM(f32x16& p0, f32x16& p1, float& m_reg, float& mn, float& alpha) {
    float pmax = p0[0]; for (int r = 1; r < 16; ++r) pmax = fmaxf(pmax, p0[r]); for (int r = 0; r < 16; ++r) pmax = fmaxf(pmax, p1[r]);
    { auto rr = __builtin_amdgcn_permlane32_swap(__float_as_uint(pmax), __float_as_uint(pmax), false, false);
      pmax = fmaxf(__uint_as_float(rr[0]), __uint_as_float(rr[1])); }
    constexpr float C2 = 1.4426950408889634f * SCALE;
    if (__builtin_expect(__all((pmax - m_reg) * SCALE <= THR), 1)) { mn = m_reg; alpha = 1.f; }
    else { mn = fmaxf(m_reg, pmax); alpha = __builtin_amdgcn_exp2f((m_reg - mn) * C2); m_reg = mn; }
    const float mnL = -mn * C2;
    for (int r = 0; r < 16; ++r) p0[r] = fmaf(p0[r], C2, mnL); for (int r = 0; r < 16; ++r) p1[r] = fmaf(p1[r], C2, mnL);
    for (int r = 0; r < 16; ++r) p0[r] = __builtin_amdgcn_exp2f(p0[r]);
}
__device__ __forceinline__ void finishSM(f32x16& p0, f32x16& p1, float alpha, float& l_reg, bf16x8& pa0, bf16x8& pa1, bf16x8& pa2, bf16x8& pa3) {
    for (int r = 0; r < 16; ++r) p1[r] = __builtin_amdgcn_exp2f(p1[r]);
    float ps = 0; for (int r = 0; r < 16; ++r) ps += p0[r]; for (int r = 0; r < 16; ++r) ps += p1[r];
    { auto rr = __builtin_amdgcn_permlane32_swap(__float_as_uint(ps), __float_as_uint(ps), false, false);
      ps = __uint_as_float(rr[0]) + __uint_as_float(rr[1]); }
    l_reg = l_reg * alpha + ps;
#define PK4(P, B_, OUT) do { unsigned a0 = cvt_pk_bf16_asm(P[B_+0], P[B_+1]), a1 = cvt_pk_bf16_asm(P[B_+2], P[B_+3]);                          \
        unsigned b0 = cvt_pk_bf16_asm(P[B_+4], P[B_+5]), b1 = cvt_pk_bf16_asm(P[B_+6], P[B_+7]);                                             \
        auto r0 = __builtin_amdgcn_permlane32_swap(a0, b0, false, false); auto r1 = __builtin_amdgcn_permlane32_swap(a1, b1, false, false); \
        u32x4 w = {r0[0], r1[0], r0[1], r1[1]}; OUT = *reinterpret_cast<bf16x8*>(&w); } while (0)
    PK4(p0, 0, pa0); PK4(p0, 8, pa1); PK4(p1, 0, pa2); PK4(p1, 8, pa3);
#undef PK4
}
__device__ __forceinline__ void mask_init(f32x16& p0, f32x16& p1, u32x2 mw, int hi) {
    const int i0 = (int)~(mw.x >> (4 * hi)), i1 = (int)~(mw.y >> (4 * hi));
#pragma unroll
    for (int r = 0; r < 16; ++r) { const unsigned c = (r & 3) + 8 * (r >> 2);
        p0[r] = __uint_as_float((unsigned)__builtin_amdgcn_sbfe(i0, c, 1u) & 0xFF800000u);
        p1[r] = __uint_as_float((unsigned)__builtin_amdgcn_sbfe(i1, c, 1u) & 0xFF800000u); }
}
template <int KB>
__device__ __forceinline__ void qkt(f32x16& p0, f32x16& p1, const LAS char* K_lds, int r32, int hi, const bf16x8* qr, u32x2 mw) {
    mask_init(p0, p1, mw, hi);
    const LAS char* kb[4];
#pragma unroll
    for (int dd = 0; dd < 4; ++dd) kb[dd] = K_lds + KB * SHM_K + KSWZ(r32, (dd * 16 + hi * 8) * 2);
#pragma unroll
    for (int d0 = 0; d0 < 8; ++d0) { const LAS char* a = kb[d0 & 3] + (d0 >> 2) * 128;
        bf16x8 b0 = *(const LAS bf16x8*)(a);
        bf16x8 b1 = *(const LAS bf16x8*)(a + 32 * 256);
        p0 = __builtin_amdgcn_mfma_f32_32x32x16_bf16(b0, qr[d0], p0, 0, 0, 0);
        p1 = __builtin_amdgcn_mfma_f32_32x32x16_bf16(b1, qr[d0], p1, 0, 0, 0); }
}
template <int VB>
__device__ __forceinline__ void pv_tile(f32x16* o, int vb0, bf16x8 pa0, bf16x8 pa1, bf16x8 pa2, bf16x8 pa3) {
#define TRRD(dst, off) asm volatile("ds_read_b64_tr_b16 %0, %1 offset:%2" : "=&v"(dst) : "v"(vb0), "i"(off) : "memory")
#define PV_D0(d0) do { s16x4 l0, l1, l2, l3, h0, h1, h2, h3; constexpr int b_ = VB * SHM_V + v_rd_off(d0, 0, 0); \
        TRRD(l0, b_); TRRD(h0, b_ + 2048); TRRD(l1, b_ + 4096); TRRD(h1, b_ + 6144); TRRD(l2, b_ + 8192); TRRD(h2, b_ + 10240); TRRD(l3, b_ + 12288); TRRD(h3, b_ + 14336); \
        asm volatile("s_waitcnt lgkmcnt(0)" ::: "memory"); SBAR();   \
        o[d0] = __builtin_amdgcn_mfma_f32_32x32x16_bf16(pa0, (bf16x8){l0[0], l0[1], l0[2], l0[3], h0[0], h0[1], h0[2], h0[3]}, o[d0], 0, 0, 0);   \
        o[d0] = __builtin_amdgcn_mfma_f32_32x32x16_bf16(pa1, (bf16x8){l1[0], l1[1], l1[2], l1[3], h1[0], h1[1], h1[2], h1[3]}, o[d0], 0, 0, 0);   \
        o[d0] = __builtin_amdgcn_mfma_f32_32x32x16_bf16(pa2, (bf16x8){l2[0], l2[1], l2[2], l2[3], h2[0], h2[1], h2[2], h2[3]}, o[d0], 0, 0, 0);   \
        o[d0] = __builtin_amdgcn_mfma_f32_32x32x16_bf16(pa3, (bf16x8){l3[0], l3[1], l3[2], l3[3], h3[0], h3[1], h3[2], h3[3]}, o[d0], 0, 0, 0); } while (0)
    PV_D0(0); PV_D0(1); PV_D0(2); PV_D0(3);
#undef PV_D0
#undef TRRD
}
struct BlockRef { const char* Q; const char* K; bf16_t* O; float* ML; const char* M; int NT; };
struct Seam { bf16x8 qr[8]; bf16x8 st_v0, st_v1, st_k0, st_k1; };
constexpr int VOFFB = (PC_VSA - PC_KSA) * 2;
#define VMW() asm volatile("s_waitcnt vmcnt(0)" ::: "memory")
#define VMWN(n) asm volatile("s_waitcnt vmcnt(%0)" :: "i"(n) : "memory")
#define LD8(p) (*reinterpret_cast<const bf16x8*>(p))
#define KVB(t) (Kh + (size_t)(t) * (KVBLK * PITCH * 2))
#define SLOAD_H(kvb) do { const char* b_ = (kvb); S.st_v0 = LD8(b_ + VOFFB + koff0); S.st_v1 = LD8(b_ + VOFFB + koff1); S.st_k0 = LD8(b_ + koff0); S.st_k1 = LD8(b_ + koff1); } while (0)
#define SWRITE_HK(bf) do { *(LAS bf16x8*)(K_lds + (bf) * SHM_K + kws) = S.st_k0; *(LAS bf16x8*)(K_lds + (bf) * SHM_K + kws + 32 * 256) = S.st_k1; } while (0)
#define SWRITE_HV(bf) do { *(LAS bf16x8*)(V_lds + (bf) * SHM_V + vst0) = S.st_v0; *(LAS bf16x8*)(V_lds + (bf) * SHM_V + vst1) = S.st_v1; } while (0)
#define SWRITE_H(bf) do { SWRITE_HV(bf); SWRITE_HK(bf); } while (0)
#define MLOAD(t) (*(const u32x2*)(cur.M + (size_t)(t) * 256 + moff))
__device__ __forceinline__ void prime(const BlockRef& cur, LAS char* lds, Seam& S, int tid) {
    const int wid = __builtin_amdgcn_readfirstlane(tid >> 6), lane = tid & 63, r32 = lane & 31, hi = lane >> 5;
    const int sr = tid >> 4, sc = (tid & 15) * 8, kws = KSWZ(sr, sc * 2); LAS char* K_lds = lds + 2 * SHM_V;
    const unsigned koff0 = (unsigned)(sr * PITCH + sc) * 2u, koff1 = (unsigned)((32 + sr) * PITCH + sc) * 2u, qoff = (unsigned)((wid * QBLK + r32) * PITCH + hi * 8) * 2u;
    for (int d0 = 0; d0 < 8; ++d0) S.qr[d0] = LD8(cur.Q + qoff + d0 * 32);
    const char* Kh = cur.K;
    SLOAD_H(KVB(0)); VMW(); SWRITE_HK(0);
    __syncthreads();
}
__device__ __forceinline__ void block(const BlockRef& cur, const BlockRef& nxt, LAS char* lds, Seam& S, int tid) {
    const int wid = __builtin_amdgcn_readfirstlane(tid >> 6), lane = tid & 63, r32 = lane & 31, hi = lane >> 5;
    const int NT = cur.NT;
    LAS char* V_lds = lds; LAS char* K_lds = lds + 2 * SHM_V;
    LAS float* wsf = (LAS float*)(lds + 2 * SHM_V + 2 * SHM_K) + wid * 64; LAS float* al_l = wsf + 32;
    float m_reg = -1e30f, l_reg = 0; f32x16 o[4] = {};
    const int sr = tid >> 4, sc = (tid & 15) * 8, vst0 = v_st(sr, sc), vst1 = v_st(32 + sr, sc), kws = KSWZ(sr, sc * 2);
    const unsigned koff0 = (unsigned)(sr * PITCH + sc) * 2u, koff1 = (unsigned)((32 + sr) * PITCH + sc) * 2u, qoff = (unsigned)((wid * QBLK + r32) * PITCH + hi * 8) * 2u;
    const unsigned moff = (unsigned)(wid * (128 * 64 * 4) + r32 * 8);
    const int vb0 = (int)(unsigned)(unsigned long long)V_lds + v_rd_base(lane);
    const char* Kh = cur.K;
#define RESC(a) do { if (__any((a) < 1.f)) { if (hi == 0) al_l[r32] = (a); asm volatile("s_waitcnt lgkmcnt(0)" ::: "memory");              \
                     for (int d_ = 0; d_ < 4; ++d_) for (int r = 0; r < 16; ++r) o[d_][r] *= al_l[crow(r, hi)]; } } while (0)
    constexpr int NQL = 8;
#define SEAM_K0() do { VMWN(NQL); SWRITE_HK(0); SBAR(); } while (0)
    f32x16 pA0, pA1, pB0, pB1; float mnA, mnB, alA, alB; bf16x8 pa0, pa1, pa2, pa3;
    u32x2 mw = MLOAD(0);
    SWRITE_HV(0); SBAR();
    if (NT > 1) SLOAD_H(KVB(1));
    SBAR(); qkt<0>(pA0, pA1, K_lds, r32, hi, S.qr, mw);
    if (NT > 1) mw = MLOAD(1);
    partialSM(pA0, pA1, m_reg, mnA, alA);
    if (NT > 1) { VMWN(1); SWRITE_H(1); }
    __syncthreads();
#define HALF_STEP(PX0, PX1, mnX, alX, PY0, PY1, alY, t, KB, VB, SB) do {                                                      \
        SBAR(); qkt<KB>(PX0, PX1, K_lds, r32, hi, S.qr, mw);                                             \
        finishSM(PY0, PY1, alY, l_reg, pa0, pa1, pa2, pa3); SBAR();                                                           \
        if ((t) + 1 < NT) { SLOAD_H(KVB((t) + 1)); mw = MLOAD((t) + 1); SBAR(); }                                               \
        pv_tile<VB>(o, vb0, pa0, pa1, pa2, pa3); partialSM(PX0, PX1, m_reg, mnX, alX);                                        \
        __syncthreads();                                                                                                      \
        if ((t) + 1 < NT) { VMWN(1); SWRITE_H(SB); }                                                                          \
        RESC(alX); __syncthreads(); } while (0)
    for (int t = 1; t + 1 < NT; t += 2) {
        HALF_STEP(pB0, pB1, mnB, alB, pA0, pA1, alA, t, 1, 0, 0);
        HALF_STEP(pA0, pA1, mnA, alA, pB0, pB1, alB, t + 1, 0, 1, 1);
    }
    const bool even = (NT & 1) == 0;
    if (even) { SBAR(); qkt<1>(pB0, pB1, K_lds, r32, hi, S.qr, mw); SBAR(); }
    { const char* Kh = nxt.K; SLOAD_H(KVB(0)); } SBAR();
#pragma unroll
    for (int d0 = 0; d0 < 8; ++d0) S.qr[d0] = LD8(nxt.Q + qoff + d0 * 32);
    SBAR();
    finishSM(pA0, pA1, alA, l_reg, pa0, pa1, pa2, pa3); SBAR();
    pv_tile<0>(o, vb0, pa0, pa1, pa2, pa3);
    if (even) { partialSM(pB0, pB1, m_reg, mnB, alB); __syncthreads(); RESC(alB);
        finishSM(pB0, pB1, alB, l_reg, pa0, pa1, pa2, pa3); SBAR(); pv_tile<1>(o, vb0, pa0, pa1, pa2, pa3); }
    SBAR(); SEAM_K0();
    int r32e = r32; asm volatile("" : "+v"(r32e));
    if (hi == 0) { f32x2 ml; ml.x = m_reg; ml.y = l_reg; *(f32x2*)((char*)cur.ML + (unsigned)(wid * QBLK + r32e) * 8u) = ml; }
    char* Ow = (char*)cur.O; const unsigned ooff = (unsigned)((wid * QBLK) * OPITCH + r32e) * 2u;
#pragma unroll
    for (int r = 0; r < 16; ++r) { const int orow = crow(r, hi);
#pragma unroll
        for (int d0 = 0; d0 < 4; ++d0) { const float v = o[d0][r];
            const float vn = __shfl_xor(v, 1);
            if ((r32 & 1) == 0) *(unsigned*)(Ow + ooff + (unsigned)(orow * OPITCH + d0 * 32) * 2u) = cvt_pk_bf16_asm(v, vn); } }
    __syncthreads();
#undef RESC
#undef SEAM_K0
#undef HALF_STEP
}
#undef KVB
#undef VMW
#undef VMWN
#undef LD8
#undef SLOAD_H
#undef SWRITE_HK
#undef SWRITE_HV
#undef SWRITE_H
#undef MLOAD
#undef KSWZ
#undef SBAR
}

constexpr int AT_NPARTS = 96;
__constant__ unsigned char AT_SCHED[32][3] = {{159,154,20}, {127,122,47}, {63,58,15}, {121,117,115}, {89,85,83}, {57,53,51}, {25,21,19}, {82,16,78}, {44,79,46}, {12,42,14}, {95,28,41}, {31,155,9}, {158,91,4}, {126,118,77}, {94,86,45}, {62,54,13}, {120,22,40}, {88,80,8}, {56,48,39}, {24,123,10}, {50,59,90}, {18,27,26}, {30,23,7}, {157,81,3}, {125,49,38}, {93,17,6}, {61,43,2}, {29,11,1}, {156,5,0}, {119,124,116}, {87,92,84}, {55,60,52}};
__constant__ unsigned char AT_NPART[32] = {1,1,1,1,1,1,2,2,2,2,2,2,2,3,3,3,3,3,3,4,4,4,4,4,4,4,5,5,5,5,5,5};
__constant__ unsigned char AT_PBASE[32] = {0,1,2,3,4,5,6,8,10,12,14,16,18,20,23,26,29,32,35,38,42,46,50,54,58,62,66,71,76,81,86,91};
constexpr size_t AT_PARTO_BYTES = (size_t)256 * 128 * 2, AT_ML_OFF = (size_t)DNH * AT_NPARTS * AT_PARTO_BYTES;
__device__ __forceinline__ void p_attn(const Ctx& c) {
    unsigned char* ws = c.ws;
    const bf16_t* PROJ = (const bf16_t*)(ws + WS_PROJ); const unsigned* MASKT = (const unsigned*)(ws + WS_MASK);
    const int h = c.bx & 7, slot = c.bx >> 3;
    if (slot >= 32) return;
    auto ref = [&](int j) { const int e = AT_SCHED[slot][j]; const int qb = e & 31, p = e >> 5, np = AT_NPART[qb], nt = 4 * (qb + 1), lo = (p * nt) / np, hi2 = ((p + 1) * nt) / np; att::BlockRef r;
        const size_t pi = (size_t)h * AT_NPARTS + AT_PBASE[qb] + p;
        r.Q = (const char*)(PROJ + (size_t)qb * att::QB * NPB + PC_QSA + h * 128); r.K = (const char*)(PROJ + (size_t)lo * 64 * NPB + PC_KSA + h * 128);
        r.O = (bf16_t*)(ws + WS_DNF + pi * AT_PARTO_BYTES); r.ML = (float*)(ws + WS_DNF + AT_ML_OFF + pi * 2048);
        r.M = (const char*)(MASKT + (size_t)qb * 8 * (128 * 64)) + (size_t)lo * 256; r.NT = hi2 - lo; return r; };
    int nit = 0;
    for (int j = 0; j < 3; ++j) nit += AT_SCHED[slot][j] != 255 ? 1 : 0;
    att::BlockRef cur = ref(0); att::Seam Sm;
    att::prime(cur, (LAS char*)c.lds, Sm, c.tid);
    for (int j = 0; j < nit; ++j) { const bool more = j + 1 < nit; const att::BlockRef nxt = more ? ref(j + 1) : cur;
        att::block(cur, nxt, (LAS char*)c.lds, Sm, c.tid);
        cur = nxt; }
}
__device__ __forceinline__ void p_attn_merge(const Ctx& c) {
    unsigned char* ws = c.ws; bf16_t* OSA = (bf16_t*)(ws + WS_OSA);
    constexpr float C2 = 1.4426950408889634f * att::SCALE;
    for (int u = c.gw; u < DNH * 32 * 32; u += c.NGW) {
        const int rg = u & 31, qb = (u >> 5) & 31, h = u >> 10, np = AT_NPART[qb]; const size_t pi0 = (size_t)h * AT_NPARTS + AT_PBASE[qb];
        const int row = rg * 8 + (c.lane >> 3), cg = (c.lane & 7) * 16;
        float M = -1e30f;
        for (int p = 0; p < np; ++p) M = fmaxf(M, ((const float*)(ws + WS_DNF + AT_ML_OFF + (pi0 + p) * 2048))[2 * row]);
        float acc[16], den = 0.f;
#pragma unroll
        for (int e = 0; e < 16; ++e) acc[e] = 0.f;
        for (int p = 0; p < np; ++p) { const f32x2 ml = *(const f32x2*)(ws + WS_DNF + AT_ML_OFF + (pi0 + p) * 2048 + 8 * row); const float w = __builtin_amdgcn_exp2f((ml.x - M) * C2); den += w * ml.y;
            const bf16_t* op = (const bf16_t*)(ws + WS_DNF + (pi0 + p) * AT_PARTO_BYTES) + row * 128 + cg; float v[16]; unpack8(*(const u32x4*)op, v); unpack8(*(const u32x4*)(op + 8), v + 8);
#pragma unroll
            for (int e = 0; e < 16; ++e) acc[e] += w * v[e]; }
        const float rd = 1.f / den;
#pragma unroll
        for (int e = 0; e < 16; ++e) acc[e] *= rd;
        bf16_t* o = OSA + (size_t)(qb * 256 + row) * 1024 + h * 128 + cg; *(u32x4*)o = pack8(acc); *(u32x4*)(o + 8) = pack8(acc + 8);
    }
}

__device__ __forceinline__ void p_moe_dispatch(const Ctx& c) {
    unsigned char* ws = c.ws;
    const u32x4* SEL = (const u32x4*)(ws + WS_ROUTE + RT_SEL); int* TOKROW = (int*)(ws + WS_ROUTE + RT_TOKROW); float* ROWW = (float*)(ws + WS_ROUTE + RT_ROWW);
    const bf16_t* XN = (const bf16_t*)(ws + WS_XN); bf16_t* AS = (bf16_t*)(ws + WS_AS);
    LAS int* tot = (LAS int*)c.lds;
    LAS int* rowof = (LAS int*)(c.lds + 1024);
    const int ntok_blk = S / c.G;
    const int tb0 = c.bx * ntok_blk;
    if (c.tid < 16) tot[c.tid] = 0;
    __syncthreads();
    { int ct[NEXP], cb[NEXP];
#pragma unroll
        for (int e = 0; e < NEXP; ++e) { ct[e] = 0; cb[e] = 0; }
        for (int t = c.tid; t < S; t += 512) { const u32x4 r = SEL[t]; const bool before = t < tb0;
#pragma unroll
            for (int e = 0; e < NEXP; ++e) { const int hit = ((int)r.x == e) + ((int)r.y == e); ct[e] += hit; cb[e] += before ? hit : 0; } }
#pragma unroll
        for (int e = 0; e < NEXP; ++e) { int a = ct[e], b = cb[e];
#pragma unroll
            for (int o = 1; o < 64; o <<= 1) { a += __shfl_xor(a, o); b += __shfl_xor(b, o); }
            if (c.lane == 0) { __hip_atomic_fetch_add(&tot[e], a, __ATOMIC_RELAXED, __HIP_MEMORY_SCOPE_WORKGROUP); __hip_atomic_fetch_add(&tot[8 + e], b, __ATOMIC_RELAXED, __HIP_MEMORY_SCOPE_WORKGROUP); } } }
    __syncthreads();
    if (c.tid == 0) { int off = 0; for (int e = 0; e < NEXP; ++e) { tot[16 + e] = off; off += ((tot[e] + 255) >> 8) << 8; }
        int fill[NEXP]; for (int e = 0; e < NEXP; ++e) fill[e] = tot[16 + e] + tot[8 + e];
        for (int i = 0; i < ntok_blk; ++i) { const int t = tb0 + i; const u32x4 r = SEL[t]; const int r0 = fill[r.x]++; const int r1 = fill[r.y]++;
            rowof[2 * i] = r0; rowof[2 * i + 1] = r1; TOKROW[2 * t] = r0; TOKROW[2 * t + 1] = r1; ROWW[r0] = __uint_as_float(r.z); ROWW[r1] = __uint_as_float(r.w); } }
    __syncthreads();
    for (int s = c.wave; s < 2 * ntok_blk; s += 8) { const int t = tb0 + (s >> 1); const u32x4* src = (const u32x4*)((const unsigned char*)XN + (size_t)t * DM); u32x4* dst = (u32x4*)((unsigned char*)AS + (size_t)rowof[s] * DM);
#pragma unroll
        for (int j = 0; j < 2; ++j) dst[c.lane + 64 * j] = src[c.lane + 64 * j]; }
    if (c.bx == 0 && c.tid < NEXP) { const int e = c.tid; const int lo = tot[16 + e] + tot[e], hi = tot[16 + e] + (((tot[e] + 255) >> 8) << 8); for (int r = lo; r < hi; ++r) ROWW[r] = 0.f; }
    __syncthreads();
}
__device__ __forceinline__ int moe_tiles(const Ctx& c, LAS int* te) {
    const u32x4* SEL = (const u32x4*)(c.ws + WS_ROUTE + RT_SEL);
    LAS int* tot = te + 128;
    if (c.tid < 8) tot[c.tid] = 0;
    __syncthreads();
    { int ct[NEXP];
#pragma unroll
        for (int e = 0; e < NEXP; ++e) ct[e] = 0;
        for (int t = c.tid; t < S; t += 512) { const u32x4 r = SEL[t];
#pragma unroll
            for (int e = 0; e < NEXP; ++e) ct[e] += ((int)r.x == e) + ((int)r.y == e); }
#pragma unroll
        for (int e = 0; e < NEXP; ++e) { int a = ct[e];
#pragma unroll
            for (int o = 1; o < 64; o <<= 1) a += __shfl_xor(a, o);
            if (c.lane == 0) __hip_atomic_fetch_add(&tot[e], a, __ATOMIC_RELAXED, __HIP_MEMORY_SCOPE_WORKGROUP); } }
    __syncthreads();
    if (c.tid == 0) { int rt = 0; for (int e = 0; e < NEXP; ++e) { const int nt = (tot[e] + 255) >> 8; for (int i = 0; i < nt; ++i) te[rt++] = e; } tot[8] = rt; }
    __syncthreads();
    const int nrt = tot[8];
    return nrt;
}
__device__ __forceinline__ void p_final(const Ctx& c) {
    unsigned char* ws = c.ws;
    const float* X = (const float*)(ws + WS_X); const bf16_t* YS = (const bf16_t*)(ws + WS_YS); const int* TOKROW = (const int*)(ws + WS_ROUTE + RT_TOKROW);
    const float* fng = inptr<const float>(c, IN_FINAL_NORM); float* outp = inptr<float>(c, IN_OUT);
    for (int t = c.gw; t < S; t += c.NGW) {
        const int r0 = TOKROW[2 * t], r1 = TOKROW[2 * t + 1];
        float v[32]; float ss = 0.f;
#pragma unroll
        for (int j = 0; j < 4; ++j) { const int col = 512 * j + c.lane * 8; float a[8], b[8]; unpack8(*(const u32x4*)(YS + (size_t)r0 * DM + col), a); unpack8(*(const u32x4*)(YS + (size_t)r1 * DM + col), b);
            const f32x4 x0 = *(const f32x4*)(X + (size_t)t * DM + col), x1 = *(const f32x4*)(X + (size_t)t * DM + col + 4);
#pragma unroll
            for (int e = 0; e < 4; ++e) { v[8 * j + e] = x0[e] + a[e] + b[e]; v[8 * j + 4 + e] = x1[e] + a[4 + e] + b[4 + e]; }
#pragma unroll
            for (int e = 0; e < 8; ++e) ss += v[8 * j + e] * v[8 * j + e]; }
        const float rstd = rsqrtf(wave_sum(ss) * (1.f / DM) + RMS_EPS);
#pragma unroll
        for (int j = 0; j < 4; ++j) { const int col = 512 * j + c.lane * 8; const f32x4 g0 = *(const f32x4*)(fng + col), g1 = *(const f32x4*)(fng + col + 4); f32x4 o0, o1;
#pragma unroll
            for (int e = 0; e < 4; ++e) { o0[e] = v[8 * j + e] * rstd * g0[e]; o1[e] = v[8 * j + 4 + e] * rstd * g1[e]; }
            *(f32x4*)(outp + (size_t)t * DM + col) = o0; *(f32x4*)(outp + (size_t)t * DM + col + 4) = o1; }
    }
}

constexpr int PH_PER_LAYER = 12;
constexpr int N_PHASES = 1 + (PH_PER_LAYER - 3) + (PH_PER_LAYER - 1) + 1;
__global__ void __launch_bounds__(512, 2) mega_fwd(Params p) {
    extern __shared__ __attribute__((aligned(16))) unsigned char lds_raw[];
    Ctx c0; { Ctx& c = c0; c.lds = (LAS unsigned char*)lds_raw; c.tid = threadIdx.x; c.bx = blockIdx.x; c.lane = c.tid & 63; c.wave = __builtin_amdgcn_readfirstlane(c.tid >> 6);
    c.G = gridDim.x; c.gw = (int)blockIdx.x * 8 + c.wave; c.NGW = c.G * 8; c.ws = p.ws; }
    const Ctx& c = c0;
    for (int u = c.tid; u < (LDS_BYTES - LDSCTL_OFF) / 4; u += 512) ((LAS unsigned*)(c.lds + LDSCTL_OFF))[u] = 0u;
    __syncthreads();
    if (c.tid < IN_COUNT) { const unsigned long long v = (unsigned long long)p.in[c.tid]; LAS unsigned* tab = (LAS unsigned*)(c.lds + PTAB_OFF); tab[2 * c.tid] = (unsigned)v; tab[2 * c.tid + 1] = (unsigned)(v >> 32); }
    __syncthreads();
    XcdBarrier bar = xcd_barrier_post((unsigned*)(c.ws + WS_CTL) + CW_BAR, (volatile LAS unsigned*)(c.lds + MISC_OFF) + 8);
    const int lo = p.ph_lo, hi = p.ph_hi;
    int ph = 0;
#define PHASE_BEGIN if (ph >= lo && ph < hi) { const Ctx c = launder(c0);
#define PHASE_END   if (ph + 1 < hi) { XcdBarrier b2 = bar; unsigned long long bp = (unsigned long long)b2.bar; asm volatile("" : "+s"(bp), "+s"(b2.x)); b2.bar = (unsigned*)(GAS unsigned*)bp; xcd_barrier(b2); } } ++ph;
#define WSP(T, off) ((T*)(c.ws + (off)))

    PHASE_BEGIN p_prologue(c); { const Ctx c8 = launder(c0); p_norm<false, false, true>(c8, inptr<const float>(c8, IN_X), nullptr); } PHASE_END

#define LAYER_BODY(l) {\
        PHASE_BEGIN { pg8::StaticOrder so; so.init(WSP(const bf16_t, WS_XN), WSP(const bf16_t, WS_WIN) + (size_t)l * NPW * DM, S, NPH, DM, c.G, c.bx); \
            pg8::EpiProj E{WSP(bf16_t, WS_PROJ), 0, l == 0 ? nullptr : WSP(const unsigned long long, WS_ROUTE + RT_SS) + S}; pg8::gemm_phase<pg8::EpiProj, pg8::StaticOrder>(c.lds, c.tid, DM, so, E); } \
          { pg8::StaticOrder so; so.init(WSP(const bf16_t, WS_XN8), (const bf16_t*)(c.ws + WS_WIN + (size_t)l * NPW * DM * 2 + WIN8_OFF), S, NPB - NPH, DM / 2, c.G, c.bx); \
            pg8::EpiProj E{WSP(bf16_t, WS_PROJ), NPH, l == 0 ? nullptr : WSP(const unsigned long long, WS_ROUTE + RT_SS) + S}; pg8::gemm_phase<pg8::EpiProj, pg8::StaticOrder, true, true, true>(c.lds, c.tid, DM / 2, so, E, F8_SC_WIN, 127); } \
          { pg8::SplitKOrder so; so.nM = S / 256; so.nks = SMALL_KS; so.G = c.G; so.c = c.bx; so.A = (const char*)WSP(const bf16_t, WS_XN); so.Bt = (const char*)(WSP(const bf16_t, WS_WIN) + ((size_t)l * NPW + NPH) * DM); so.tstep = (size_t)256 * DM * 2; so.ksb = (DM / SMALL_KS) * 2; \
            pg8::EpiSmallPart E{WSP(float, WS_MERGED), l == 0 ? nullptr : WSP(const unsigned long long, WS_ROUTE + RT_SS) + S}; pg8::gemm_phase<pg8::EpiSmallPart, pg8::SplitKOrder>(c.lds, c.tid, DM / SMALL_KS, so, E, 127, 127, DM); } PHASE_END \
        PHASE_BEGIN if (c.wave >= 4) { const Ctx c5 = launder(c0); p_prep(c5, l, c5.bx * 4 + c5.wave - 4, c5.G * 4); } else { const Ctx c6 = launder(c0); p_dn_intra(c6, l); } PHASE_END \
        PHASE_BEGIN if (c.bx < 8) dn::scan_head(c, c.bx); else if (c.bx < 64) { const Ctx c7 = launder(c0); p_convert(c7, l == 0 ? 4 : 17, l == 0 ? 17 : 35, (c7.bx - 8) * 8 + c7.wave, 56 * 8); } { const Ctx c8 = launder(c0); p_select(c8, l); } PHASE_END \
        PHASE_BEGIN p_dn_post(c, l); { const Ctx c2 = launder(c0); p_attn(c2); } PHASE_END \
        PHASE_BEGIN p_attn_merge(c); PHASE_END \
        PHASE_BEGIN { pg8::StaticOrder so; so.init(WSP(const bf16_t, WS_ODN), WSP(const bf16_t, WS_WDN) + (size_t)l * DM * DNW, S, DM, DNW, c.G, c.bx); \
            pg8::EpiGate<false> E{WSP(bf16_t, WS_MERGED), WSP(const bf16_t, WS_PROJ) + PC_GDN}; pg8::gemm_phase<pg8::EpiGate<false>, pg8::StaticOrder>(c.lds, c.tid, DNW, so, E); } \
          { pg8::StaticOrder so; so.init(WSP(const bf16_t, WS_OSA), WSP(const bf16_t, WS_WSA) + (size_t)l * DM * DNW, S, DM, DNW, c.G, c.bx); \
            pg8::EpiGate<true> E{WSP(bf16_t, WS_MERGED), WSP(const bf16_t, WS_PROJ) + PC_GSA}; pg8::gemm_phase<pg8::EpiGate<true>, pg8::StaticOrder>(c.lds, c.tid, DNW, so, E); } PHASE_END \
        PHASE_BEGIN { pg8::StaticOrder so; so.init(WSP(const bf16_t, WS_MERGED), WSP(const bf16_t, WS_WO) + (size_t)l * DM * DM, S, DM, DM, c.G, c.bx); \
            if (l == 0) { pg8::EpiResidN<true> E{inptr<const float>(c, IN_X), WSP(float, WS_X), WSP(void, WS_XN), WSP(unsigned long long, WS_ROUTE + RT_SS), nullptr}; pg8::gemm_phase<pg8::EpiResidN<true>, pg8::StaticOrder>(c.lds, c.tid, DM, so, E); } \
            else { pg8::EpiResid E{WSP(const float, WS_X), WSP(float, WS_X)}; pg8::gemm_phase<pg8::EpiResid, pg8::StaticOrder>(c.lds, c.tid, DM, so, E); } } PHASE_END \
        if (l == 1) { PHASE_BEGIN p_norm<true, true>(c, WSP(const float, WS_X), inptr<const float>(c, IN_NORM_FFN) + DM); PHASE_END } \
        if (l == 1) { PHASE_BEGIN p_moe_dispatch(c); PHASE_END } \
        PHASE_BEGIN if (l == 0) { pg8::StaticOrder so; so.init(WSP(const bf16_t, WS_XN), WSP(const bf16_t, WS_WGU0), S, 2 * DFF, DM / 2, c.G, c.bx); \
                pg8::EpiSwiglu8 E{WSP(unsigned char, WS_HID), DFF, F8_HID, WSP(const unsigned long long, WS_ROUTE + RT_SS)}; pg8::gemm_phase<pg8::EpiSwiglu8, pg8::StaticOrder, true, true, true>(c.lds, c.tid, DM / 2, so, E, F8_SC_WGU, 127); } \
            else { LAS int* te = (LAS int*)(c.lds + MISC_OFF + 1024); const int nrt = moe_tiles(c, te); \
                pg8::GroupOrder go; go.so.init(WSP(const bf16_t, WS_AS), WSP(const bf16_t, WS_WGU1), nrt * 256, 2 * DFE, DM / 2, c.G, c.bx); go.te = te; go.estride = (size_t)2 * DFE * DM; \
                pg8::EpiSwiglu8 E{WSP(unsigned char, WS_HIDM), DFE, F8_HID, nullptr}; pg8::gemm_phase<pg8::EpiSwiglu8, pg8::GroupOrder, true, true, true>(c.lds, c.tid, DM / 2, go, E, F8_SC_WGU, 127); } PHASE_END \
        PHASE_BEGIN if (l == 0) { pg8::StaticOrder so; so.init(WSP(const bf16_t, WS_HID), WSP(const bf16_t, WS_WD0), S, DM, DFF / 2, c.G, c.bx); \
                pg8::EpiResidN<false> E{WSP(const float, WS_X), WSP(float, WS_X), WSP(void, WS_XN), WSP(unsigned long long, WS_ROUTE + RT_SS) + S, WSP(unsigned char, WS_XN8)}; pg8::gemm_phase<pg8::EpiResidN<false>, pg8::StaticOrder, true, true, true>(c.lds, c.tid, DFF / 2, so, E, F8_SC_WD, F8_SC_HID); } \
            else { LAS int* te = (LAS int*)(c.lds + MISC_OFF + 1024); const int nrt = moe_tiles(c, te); \
                pg8::GroupOrder go; go.so.init(WSP(const bf16_t, WS_HIDM), WSP(const bf16_t, WS_WD1), nrt * 256, DM, DFE / 2, c.G, c.bx); go.te = te; go.estride = (size_t)DM * DFE; \
                pg8::EpiMoeDown E{WSP(bf16_t, WS_YS), WSP(const float, WS_ROUTE + RT_ROWW)}; pg8::gemm_phase<pg8::EpiMoeDown, pg8::GroupOrder, true, true, true>(c.lds, c.tid, DFE / 2, go, E, F8_SC_WD, F8_SC_HID); } PHASE_END \
    }
    LAYER_BODY(0)
    LAYER_BODY(1)
#undef LAYER_BODY
    PHASE_BEGIN p_final(c); PHASE_END
#undef PHASE_BEGIN
#undef PHASE_END
#undef WSP
}

extern "C" void kernel_launch(void* const* d_in, const int* in_sizes, int n_in, void* d_out, int out_size, void* d_ws, size_t ws_size, hipStream_t stream) {
    static int grid = 0;
    if (grid == 0) {
        if (n_in != 20 || in_sizes[0] != S * DM || out_size != S * DM || ws_size < WS_END) { fprintf(stderr, "kernel_launch: unexpected shapes (n_in %d, in0 %d, out %d, ws %zu < %zu)\n", n_in, n_in > 0 ? in_sizes[0] : -1, out_size, ws_size, (size_t)WS_END); grid = -1; return; }
        int dev = 0, cus = 0, per_cu = 0;
        if (hipGetDevice(&dev) != hipSuccess || hipDeviceGetAttribute(&cus, hipDeviceAttributeMultiprocessorCount, dev) != hipSuccess) { grid = -1; return; }
        if (hipFuncSetAttribute((const void*)mega_fwd, hipFuncAttributeMaxDynamicSharedMemorySize, LDS_BYTES) != hipSuccess) { fprintf(stderr, "kernel_launch: hipFuncSetAttribute failed\n"); grid = -1; return; }
        if (hipOccupancyMaxActiveBlocksPerMultiprocessor(&per_cu, (const void*)mega_fwd, 512, LDS_BYTES) != hipSuccess || per_cu < 1) fprintf(stderr, "kernel_launch: occupancy query reports %d blocks per CU\n", per_cu);
        (void)hipGetLastError();
        grid = cus;
        if (grid != 256) { fprintf(stderr, "kernel_launch: %d CUs (this kernel is laid out for 256)\n", grid); grid = -1; return; }
    }
    if (grid < 0) return;
    (void)hipMemsetAsync((char*)d_ws + WS_CTL, 0, CTL_ZERO_BYTES, stream);
    Params p{};
    for (int i = 0; i < 20; ++i) p.in[i] = d_in[i];
    p.in[IN_OUT] = d_out; p.ws = (unsigned char*)d_ws; p.ph_lo = 0; p.ph_hi = N_PHASES;
    hipLaunchKernelGGL(mega_fwd, dim3(grid), dim3(512), LDS_BYTES, stream, p);
}
```

```cpp
#include <hip/hip_runtime.h>
#include <cstdio>
#include <cstdint>

#define GAS __attribute__((address_space(1)))
#define LAS __attribute__((address_space(3)))
typedef unsigned short bf16_t;
typedef short bf16x8 __attribute__((ext_vector_type(8)));
typedef float f32x2 __attribute__((ext_vector_type(2)));
typedef float f32x4 __attribute__((ext_vector_type(4)));
typedef float f32x16 __attribute__((ext_vector_type(16)));
typedef unsigned u32x2 __attribute__((ext_vector_type(2)));
typedef _Float16 h2_t __attribute__((ext_vector_type(2)));
typedef unsigned short u16x2_t __attribute__((ext_vector_type(2)));
typedef unsigned u32x4 __attribute__((ext_vector_type(4)));

constexpr int S = 8192, DM = 2048, NLAYER = 2;
constexpr int DNH = 8, HD = 128, DNW = 1024;
constexpr int IXH = 16, IXD = 64, TOPK = 256;
constexpr int DFF = 5632, NEXP = 8, DFE = 2816;
constexpr int NIN = 12384;
constexpr int NPB = 12288;
constexpr int NPW = 12544;
constexpr int NPH = 6144;
constexpr int PC_QKV = 0, PC_QSA = 3072, PC_KSA = 4096, PC_QIX = 5120, PC_Z = 6144, PC_VSA = 7168, PC_GDN = 8192, PC_GSA = 10240;
constexpr float F8_WIN = 32.f; constexpr int F8_SC_WIN = 127 - 5;
constexpr int SC_KIX = 0, SC_WIX = 64, SC_A = 80, SC_B = 88;
constexpr float RMS_EPS = 1e-6f, L2_EPS = 1e-6f;
constexpr float F8_WGU = 32.f, F8_WD = 64.f, F8_HID = 8.f; constexpr int F8_SC_WGU = 127 - 5, F8_SC_WD = 127 - 6, F8_SC_HID = 127 - 3;
constexpr int SMALL_KS = 4;
constexpr int MOE_ROWS = 2 * S + NEXP * 256;
constexpr int MOE_MAXT = MOE_ROWS / 256;

constexpr size_t MiB = 1u << 20;
constexpr size_t WS_CTL = 0, CTL_ZERO_BYTES = 1 * MiB;
constexpr size_t WS_WIN = 1 * MiB;
constexpr size_t WS_WDN = WS_WIN + 98 * MiB;
constexpr size_t WS_WSA = WS_WDN + 8 * MiB;
constexpr size_t WS_WO = WS_WSA + 8 * MiB;
constexpr size_t WS_WGU0 = WS_WO + 16 * MiB;
constexpr size_t WS_WD0 = WS_WGU0 + 44 * MiB;
constexpr size_t WS_WGU1 = WS_WD0 + 22 * MiB;
constexpr size_t WS_WD1 = WS_WGU1 + 176 * MiB;
constexpr size_t WS_X = WS_WD1 + 88 * MiB;
constexpr size_t WS_XN = WS_X + 64 * MiB;
constexpr size_t WS_PROJ = WS_XN + 32 * MiB;
constexpr size_t WS_SMALL = WS_PROJ + 192 * MiB;
constexpr size_t WS_DNQKV = WS_SMALL + 8 * MiB;
constexpr size_t WS_ODNRAW = WS_DNQKV + 48 * MiB;
constexpr size_t WS_ODN = WS_ODNRAW + 32 * MiB;
constexpr size_t WS_OSA = WS_ODN + 16 * MiB;
constexpr size_t WS_MASK = WS_OSA + 16 * MiB;
constexpr size_t WS_MERGED = WS_MASK + 8 * MiB;
constexpr size_t WS_KIX = WS_MERGED + 32 * MiB;
constexpr size_t WS_WIX = WS_KIX + 1 * MiB;
constexpr size_t WS_GB = WS_WIX + MiB / 2;
constexpr size_t WS_ROPE = WS_GB + MiB / 2;
constexpr size_t WS_ROUTE = WS_ROPE + 6 * MiB;
constexpr size_t WS_ODNRAW2 = WS_ROUTE + 1 * MiB;
constexpr size_t WS_GL = WS_ODNRAW2 + 32 * MiB;
constexpr size_t WS_XN8 = WS_GL + 1 * MiB;
constexpr size_t WS_END = WS_XN8 + 16 * MiB;
constexpr size_t WS_DNF = WS_DNQKV;
static_assert(1024 * 81920 == 80 * MiB, "DNF");
constexpr size_t WS_HID = WS_PROJ;
constexpr size_t WS_AS = WS_PROJ;
constexpr size_t WS_HIDM = WS_PROJ + 72 * MiB;
constexpr size_t WS_YS = WS_DNQKV;
static_assert(72 + 99 <= 192 && 72 <= 48 + 32, "overlays");
constexpr size_t RT_SEL = 0;
constexpr size_t RT_CNTB = 128 * 1024;
constexpr size_t RT_TOKROW = 160 * 1024;
constexpr size_t RT_ROWW = 256 * 1024;
constexpr size_t RT_SS = 512 * 1024;
constexpr int CW_BAR = 4096, CW_SELQ = 64;

constexpr int RING_BYTES = 131072;
constexpr int LDSCTL_OFF = RING_BYTES, MISC_OFF = LDSCTL_OFF + 320;
constexpr int LDS_BYTES = 147456;
constexpr int DN_TAB_OFF = LDSCTL_OFF + 4096;

__device__ __forceinline__ float bf2f(unsigned b) { return __uint_as_float(b << 16); }
typedef __bf16 bf16x2_t __attribute__((ext_vector_type(2)));
__device__ __forceinline__ unsigned cvt_pk_bf16_asm(float lo, float hi) { unsigned r; asm volatile("v_cvt_pk_bf16_f32 %0, %1, %2" : "=v"(r) : "v"(lo), "v"(hi)); return r; }
__device__ __forceinline__ unsigned cvt_pk_bf16(float lo, float hi) { const f32x2 v = {lo, hi}; const bf16x2_t b = __builtin_convertvector(v, bf16x2_t); return __builtin_bit_cast(unsigned, b); }
__device__ __forceinline__ unsigned cvt4_fp8(float a, float b, float c2, float d) { int w = 0; w = __builtin_amdgcn_cvt_pk_fp8_f32(a, b, w, false); w = __builtin_amdgcn_cvt_pk_fp8_f32(c2, d, w, true); return (unsigned)w; }
__device__ __forceinline__ float clamp448(float x) { return __builtin_amdgcn_fmed3f(x, -448.f, 448.f); }
__device__ __forceinline__ unsigned cvt4_fp8c(float a, float b, float c2, float d) { return cvt4_fp8(clamp448(a), clamp448(b), clamp448(c2), clamp448(d)); }
__device__ __forceinline__ bf16_t f2bf(float f) { return (bf16_t)(cvt_pk_bf16(f, 0.f) & 0xffffu); }
__device__ __forceinline__ void unpack8(const u32x4 w, float* f) {
    f[0] = __uint_as_float(w.x << 16); f[1] = __uint_as_float(w.x & 0xffff0000u); f[2] = __uint_as_float(w.y << 16); f[3] = __uint_as_float(w.y & 0xffff0000u);
    f[4] = __uint_as_float(w.z << 16); f[5] = __uint_as_float(w.z & 0xffff0000u); f[6] = __uint_as_float(w.w << 16); f[7] = __uint_as_float(w.w & 0xffff0000u); }
__device__ __forceinline__ u32x4 pack8(const float* f) { u32x4 w; w.x = cvt_pk_bf16(f[0], f[1]); w.y = cvt_pk_bf16(f[2], f[3]); w.z = cvt_pk_bf16(f[4], f[5]); w.w = cvt_pk_bf16(f[6], f[7]); return w; }
__device__ __forceinline__ float wave_sum(float v) {
#pragma unroll
    for (int o = 1; o < 64; o <<= 1) v += __shfl_xor(v, o);
    return v; }
__device__ __forceinline__ float wave_max(float v) {
#pragma unroll
    for (int o = 1; o < 64; o <<= 1) v = fmaxf(v, __shfl_xor(v, o));
    return v; }
template <int CTRL> __device__ __forceinline__ float dpp_f(float v) { return __builtin_bit_cast(float, __builtin_amdgcn_update_dpp(0, __builtin_bit_cast(int, v), CTRL, 0xF, 0xF, true)); }
__device__ __forceinline__ float row16_sum(float v) {
    v += dpp_f<0xB1>(v);
    v += dpp_f<0x4E>(v);
    v += dpp_f<0x141>(v);
    v += dpp_f<0x140>(v);
    return v; }
template <int CTRL, int RM> __device__ __forceinline__ int dpp_i(int v) { return __builtin_amdgcn_update_dpp(0, v, CTRL, RM, 0xF, false); }
__device__ __forceinline__ int wave_isum(int v) {
    v += dpp_i<0xB1, 0xF>(v); v += dpp_i<0x4E, 0xF>(v); v += dpp_i<0x141, 0xF>(v); v += dpp_i<0x140, 0xF>(v);
    v += dpp_i<0x142, 0xA>(v); v += dpp_i<0x143, 0xC>(v);
    return __builtin_amdgcn_readlane(v, 63); }
__device__ __forceinline__ float sigmoidf_(float x) { return __builtin_amdgcn_rcpf(1.f + __expf(-x)); }
__device__ __forceinline__ float siluf_(float x) { return x * sigmoidf_(x); }
#define LDS_WAIT() asm volatile("s_waitcnt lgkmcnt(0)" ::: "memory")
#define VM_WAIT() asm volatile("s_waitcnt vmcnt(0)" ::: "memory")

__constant__ double RF_SA[64] = {1.59154943091895346e-01, 1.37822502603982849e-01, 1.19349370211248862e-01, 1.03352296618434064e-01, 8.94994016088910133e-02, 7.75032887553740585e-02, 6.71150830052272551e-02, 5.81192674418762462e-02, 5.03292121044870353e-02, 4.35833021053073297e-02, 3.77415847174197711e-02, 3.26828658723569976e-02, 2.83021958306233987e-02, 2.45086918620698521e-02, 2.12236527647776604e-02, 1.83789261056796667e-02, 1.59154943091895339e-02, 1.37822502603982839e-02, 1.19349370211248862e-02, 1.03352296618434061e-02, 8.94994016088910063e-03, 7.75032887553740550e-03, 6.71150830052272534e-03, 5.81192674418762410e-03, 5.03292121044870370e-03, 4.35833021053073227e-03, 3.77415847174197719e-03, 3.26828658723569932e-03, 2.83021958306233987e-03, 2.45086918620698565e-03, 2.12236527647776578e-03, 1.83789261056796667e-03, 1.59154943091895356e-03, 1.37822502603982878e-03, 1.19349370211248871e-03, 1.03352296618434048e-03, 8.94994016088910237e-04, 7.75032887553740507e-04, 6.71150830052272490e-04, 5.81192674418762388e-04, 5.03292121044870326e-04, 4.35833021053073292e-04, 3.77415847174197687e-04, 3.26828658723569922e-04, 2.83021958306233954e-04, 2.45086918620698489e-04, 2.12236527647776578e-04, 1.83789261056796662e-04, 1.59154943091895351e-04, 1.37822502603982856e-04, 1.19349370211248862e-04, 1.03352296618434061e-04, 8.94994016088910047e-05, 7.75032887553740561e-05, 6.71150830052272545e-05, 5.81192674418762388e-05, 5.03292121044870354e-05, 4.35833021053073292e-05, 3.77415847174197768e-05, 3.26828658723569989e-05, 2.83021958306233995e-05, 2.45086918620698523e-05, 2.12236527647776592e-05, 1.83789261056796682e-05};

namespace pg8 {
constexpr int BM = 256, BK = 64, HALF = 128, HTB = HALF * BK * 2, STAGE_BYTES = 8 * HTB, NXCD = 8, WGM = 8;
__host__ __device__ __forceinline__ int lds_byte(int r, int c) { const int st = (r >> 4) * 2 + (c >> 5), rr = r & 15, cc = c & 31, ob = rr * 64 + cc * 2; return st * 1024 + (ob ^ (((ob >> 9) & 1) << 5)); }
__host__ __device__ __forceinline__ void stage_rc(int b, int& R, int& C) { const int st = b / 1024, sb = b % 1024, swz = sb ^ (((sb >> 9) & 1) << 5); R = (st >> 1) * 16 + swz / 64; C = (st & 1) * 32 + (swz % 64) / 2; }
__host__ __device__ __forceinline__ int perm32(int rho) { const int n = rho >> 4, i = rho & 15; return 8 * (i >> 2) + 4 * n + (i & 3); }

struct Unit { int pm, pn; const char* a; const char* b; };

struct StaticOrder {
    int nM, nN, nwg, G, c; const char* A; const char* Bt; size_t tstep;
    __device__ void init(const bf16_t* A_, const bf16_t* Bt_, int M, int N, int K, int G_, int c_) { nM = M / BM; nN = N / BM; nwg = nM * nN; G = G_; c = c_; A = (const char*)A_; Bt = (const char*)Bt_; tstep = (size_t)BM * K * 2; }
    __device__ bool tile(int i, int& pm, int& pn) const {
        const long L = (long)i * G + c; if (L >= nwg) return false;
        int wgid = (int)L; { const int q = nwg / NXCD, r = nwg % NXCD, xcd = wgid % NXCD, off = wgid / NXCD; wgid = (xcd < r ? xcd * (q + 1) : r * (q + 1) + (xcd - r) * q) + off; }
        const int nig = WGM * nN, gid = wgid / nig, fm = gid * WGM, gsz = (nM - fm) < WGM ? (nM - fm) : WGM;
        pm = fm + ((wgid % nig) % gsz); pn = (wgid % nig) / gsz; return true;
    }
    __device__ bool next(int i, Unit& u) const { if (!tile(i, u.pm, u.pn)) return false; u.a = A + (size_t)u.pm * tstep; u.b = Bt + (size_t)u.pn * tstep; return true; }
};
struct SplitKOrder {
    int nM, nks, G, c; const char* A; const char* Bt; size_t tstep; int ksb;
    __device__ bool next(int i, Unit& u) const { const long L = (long)i * G + c; if (L >= (long)nM * nks) return false; u.pm = (int)(L % nM); u.pn = (int)(L / nM);
        u.a = A + (size_t)u.pm * tstep + (size_t)u.pn * ksb; u.b = Bt + (size_t)u.pn * ksb; return true; }
};
struct GroupOrder {
    StaticOrder so; const LAS int* te; size_t estride;
    __device__ bool next(int i, Unit& u) const { if (!so.tile(i, u.pm, u.pn)) return false; u.a = so.A + (size_t)u.pm * so.tstep; u.b = so.Bt + (size_t)te[u.pm] * estride + (size_t)u.pn * so.tstep; return true; }
};

typedef int i32x4_t __attribute__((ext_vector_type(4)));
typedef int i32x8_t __attribute__((ext_vector_type(8)));
template <class Epi, class Sched, bool ALIGN_EPI = true, bool SP2 = true, bool F8 = false>
__device__ __forceinline__ void gemm_phase(LAS unsigned char* lds, const int tid, const int K, const Sched& S, const Epi& E, const int sW = 127, const int sX = 127, const int KP_ = 0) {
    const int wid = __builtin_amdgcn_readfirstlane(tid >> 6), lane = tid & 63, wr = wid >> 2, wc = wid & 3, fr = lane & 15, fq = lane >> 4;
    const int nt = K / BK, KP = KP_ ? KP_ : K;
    unsigned voffA[2], voffB[2];
#pragma unroll
    for (int i = 0; i < 2; ++i) { int R, C; stage_rc(tid * 16 + i * 8192, R, C); const int Rb = Epi::PERM ? ((R & ~31) + perm32(R & 31)) : R;
        voffA[i] = (unsigned)(R * KP + C) * 2u; voffB[i] = (unsigned)(Rb * KP + C) * 2u; }
    const size_t kstep = (size_t)(BK * 2);
    const size_t hstep = (size_t)HALF * KP * 2;
    const unsigned ldsw = (unsigned)wid * 1024u;
    const int aoff = lds_byte(wr * 64 + fr, fq * 8), boff = lds_byte(wc * 32 + fr, fq * 8);
#define PG8_SA(b, h) (((b) * 2 + (h)) * HTB)
#define PG8_SB(b, h) ((4 + (b) * 2 + (h)) * HTB)
#define PG8_STAGE(bufoff, gbase, voff) do { _Pragma("unroll") for (int _i = 0; _i < 2; ++_i) \
        __builtin_amdgcn_global_load_lds((const unsigned*)((const char*)(gbase) + (voff)[_i]), (LAS unsigned*)(lds + (bufoff) + ldsw + _i * 8192), 16, 0, 0); } while (0)
#define PG8_LD32(p_) PG8_CAT(*(const LAS i32x4_t*)(p_), *(const LAS i32x4_t*)((p_) + 1024))
#define PG8_LDA(dst, b, h) do { _Pragma("unroll") for (int m = 0; m < 4; ++m) dst[m] = PG8_LD32(lds + PG8_SA(b, h) + aoff + m * 2048); } while (0)
#define PG8_LDB(dst, b, h) do { _Pragma("unroll") for (int n = 0; n < 2; ++n) dst[n] = PG8_LD32(lds + PG8_SB(b, h) + boff + n * 2048); } while (0)
#define PG8_CAT(x0, x1) __builtin_shufflevector(x0, x1, 0, 1, 2, 3, 4, 5, 6, 7)
#define PG8_LO(x) __builtin_bit_cast(bf16x8, __builtin_shufflevector(x, x, 0, 1, 2, 3))
#define PG8_HI(x) __builtin_bit_cast(bf16x8, __builtin_shufflevector(x, x, 4, 5, 6, 7))
#define PG8_MMA(ai, bj, At, Bt) do { __builtin_amdgcn_s_setprio(1); _Pragma("unroll") for (int m = 0; m < 4; ++m) _Pragma("unroll") for (int n = 0; n < 2; ++n) { \
        if constexpr (F8) asm("v_mfma_scale_f32_16x16x128_f8f6f4 %0, %1, %2, %0, %3, %4 op_sel_hi:[0,0,0]" : "+v"(acc[ai][bj][m][n]) : "v"(Bt[n]), "v"(At[m]), "v"(sW), "v"(sX));   \
        else { acc[ai][bj][m][n] = __builtin_amdgcn_mfma_f32_16x16x32_bf16(PG8_LO(Bt[n]), PG8_LO(At[m]), acc[ai][bj][m][n], 0, 0, 0); acc[ai][bj][m][n] = __builtin_amdgcn_mfma_f32_16x16x32_bf16(PG8_HI(Bt[n]), PG8_HI(At[m]), acc[ai][bj][m][n], 0, 0, 0); } } __builtin_amdgcn_s_setprio(0); } while (0)
#define PG8_WAIT_V(n) asm volatile("s_waitcnt vmcnt(" #n ")" ::: "memory")
#define PG8_WAIT_L(n) asm volatile("s_waitcnt lgkmcnt(" #n ")" ::: "memory")
#define PG8_BAR __builtin_amdgcn_s_barrier()
#define PG8_SCHED __builtin_amdgcn_sched_barrier(0)
    Unit cur, nxt; int ui = 0;
    if (!S.next(0, cur)) return;
    f32x4 acc[2][2][4][2];
#pragma unroll
    for (int a = 0; a < 2; ++a)
#pragma unroll
        for (int b = 0; b < 2; ++b)
#pragma unroll
            for (int m = 0; m < 4; ++m)
#pragma unroll
                for (int n = 0; n < 2; ++n) acc[a][b][m][n] = (f32x4){0.f, 0.f, 0.f, 0.f};
    i32x8_t At[4], B0[2], B1[2];
    const char* cA = cur.a; const char* cB = cur.b;
    if constexpr (SP2) {
        PG8_STAGE(PG8_SB(0, 0), cB, voffB); PG8_STAGE(PG8_SB(0, 1), cB + hstep, voffB); PG8_STAGE(PG8_SA(0, 0), cA, voffA); PG8_STAGE(PG8_SA(0, 1), cA + hstep, voffA);
        if (wr == 1) PG8_BAR;
        PG8_WAIT_V(2); PG8_BAR;
        PG8_STAGE(PG8_SB(1, 0), cB + kstep, voffB); PG8_STAGE(PG8_SA(1, 0), cA + kstep, voffA); PG8_STAGE(PG8_SB(1, 1), cB + hstep + kstep, voffB);
        PG8_WAIT_V(6); PG8_BAR;
    } else {
        PG8_STAGE(PG8_SB(0, 0), cB, voffB); PG8_STAGE(PG8_SA(0, 0), cA, voffA); PG8_STAGE(PG8_SB(0, 1), cB + hstep, voffB); PG8_STAGE(PG8_SA(0, 1), cA + hstep, voffA);
        if (wr == 1) PG8_BAR;
        PG8_WAIT_V(4); PG8_BAR;
        PG8_STAGE(PG8_SB(1, 0), cB + kstep, voffB); PG8_STAGE(PG8_SA(1, 0), cA + kstep, voffA); PG8_STAGE(PG8_SB(1, 1), cB + hstep + kstep, voffB);
        PG8_WAIT_V(6); PG8_BAR;
    }
    for (;;) {
        const bool has_next = S.next(ui + 1, nxt);
        const char* nA = has_next ? nxt.a : cA; const char* nB = has_next ? nxt.b : cB;
        for (int t = 0; t < nt; t += 2) {
            const bool last = (t == nt - 2);
            const char* a1 = cA + (size_t)(t + 1) * kstep;
            const char* a2 = last ? nA : cA + (size_t)(t + 2) * kstep; const char* b2 = last ? nB : cB + (size_t)(t + 2) * kstep;
            const char* a3 = a2 + kstep; const char* b3 = b2 + kstep;
            if constexpr (SP2) {
            PG8_LDB(B0, 0, 0); PG8_LDB(B1, 0, 1); PG8_SCHED; PG8_LDA(At, 0, 0); PG8_STAGE(PG8_SA(1, 1), a1 + hstep, voffA);
            PG8_WAIT_V(8); PG8_WAIT_L(0); PG8_BAR; PG8_MMA(0, 0, At, B0); PG8_MMA(0, 1, At, B1); PG8_BAR; PG8_SCHED;
            PG8_LDA(At, 0, 1); PG8_STAGE(PG8_SB(0, 0), b2, voffB); PG8_STAGE(PG8_SB(0, 1), b2 + hstep, voffB); PG8_STAGE(PG8_SA(0, 0), a2, voffA);
            PG8_WAIT_V(8); PG8_WAIT_L(0); PG8_BAR; PG8_MMA(1, 0, At, B0); PG8_MMA(1, 1, At, B1); PG8_BAR; PG8_SCHED;
            PG8_LDB(B0, 1, 0); PG8_LDB(B1, 1, 1); PG8_SCHED; PG8_LDA(At, 1, 0); PG8_STAGE(PG8_SA(0, 1), a2 + hstep, voffA);
            PG8_WAIT_V(8); PG8_WAIT_L(0); PG8_BAR; PG8_MMA(0, 0, At, B0); PG8_MMA(0, 1, At, B1); PG8_BAR; PG8_SCHED;
            PG8_LDA(At, 1, 1); PG8_STAGE(PG8_SB(1, 0), b3, voffB); PG8_STAGE(PG8_SB(1, 1), b3 + hstep, voffB); PG8_STAGE(PG8_SA(1, 0), a3, voffA);
            PG8_WAIT_V(8); PG8_WAIT_L(0); PG8_BAR; PG8_MMA(1, 0, At, B0); PG8_MMA(1, 1, At, B1); PG8_BAR; PG8_SCHED;
            } else {
            PG8_LDB(B0, 0, 0); PG8_SCHED; PG8_LDA(At, 0, 0); PG8_STAGE(PG8_SA(1, 1), a1 + hstep, voffA);
            PG8_WAIT_L(8); PG8_BAR; PG8_WAIT_L(0); PG8_MMA(0, 0, At, B0); PG8_BAR; PG8_SCHED;
            PG8_LDB(B1, 0, 1); PG8_STAGE(PG8_SB(0, 0), b2, voffB);
            PG8_BAR; PG8_WAIT_L(0); PG8_MMA(0, 1, At, B1); PG8_BAR;
            PG8_LDA(At, 0, 1); PG8_STAGE(PG8_SA(0, 0), a2, voffA);
            PG8_BAR; PG8_WAIT_L(0); PG8_MMA(1, 0, At, B0); PG8_BAR; PG8_SCHED;
            PG8_STAGE(PG8_SB(0, 1), b2 + hstep, voffB);
            PG8_WAIT_V(6); PG8_BAR; PG8_MMA(1, 1, At, B1); PG8_BAR;
            PG8_LDB(B0, 1, 0); PG8_SCHED; PG8_LDA(At, 1, 0); PG8_STAGE(PG8_SA(0, 1), a2 + hstep, voffA);
            PG8_WAIT_L(8); PG8_BAR; PG8_WAIT_L(0); PG8_MMA(0, 0, At, B0); PG8_BAR; PG8_SCHED;
            PG8_LDB(B1, 1, 1); PG8_STAGE(PG8_SB(1, 0), b3, voffB);
            PG8_BAR; PG8_WAIT_L(0); PG8_MMA(0, 1, At, B1); PG8_BAR;
            PG8_LDA(At, 1, 1); PG8_STAGE(PG8_SA(1, 0), a3, voffA);
            PG8_BAR; PG8_WAIT_L(0); PG8_MMA(1, 0, At, B0); PG8_BAR; PG8_SCHED;
            PG8_STAGE(PG8_SB(1, 1), b3 + hstep, voffB);
            PG8_WAIT_V(6); PG8_BAR; PG8_MMA(1, 1, At, B1); PG8_BAR;
            }
        }
        if constexpr (ALIGN_EPI) { if (wr == 0) PG8_BAR; }
        if constexpr (F8) asm volatile("s_nop 15\n\ts_nop 15" ::: "memory");
        E(acc, cur, wr, wc, fr, fq);
        if (!has_next) break;
#pragma unroll
        for (int a = 0; a < 2; ++a)
#pragma unroll
            for (int b = 0; b < 2; ++b)
#pragma unroll
                for (int m = 0; m < 4; ++m)
#pragma unroll
                    for (int n = 0; n < 2; ++n) acc[a][b][m][n] = (f32x4){0.f, 0.f, 0.f, 0.f};
        cur = nxt; cA = nA; cB = nB; ++ui;
        if constexpr (ALIGN_EPI) { if (wr == 1) PG8_BAR; }
    }
    PG8_WAIT_V(0);
    if constexpr (!ALIGN_EPI) { if (wr == 0) PG8_BAR; }
    PG8_BAR;
#undef PG8_SA
#undef PG8_SB
#undef PG8_STAGE
#undef PG8_LDA
#undef PG8_LDB
#undef PG8_MMA
#undef PG8_CAT
#undef PG8_LO
#undef PG8_HI
#undef PG8_LD32
#undef PG8_WAIT_V
#undef PG8_WAIT_L
#undef PG8_BAR
#undef PG8_SCHED
}

typedef const f32x4 (&AccRef)[2][2][4][2];
struct EpiProj {
    static constexpr bool PERM = true;
    bf16_t* P; int coff; const unsigned long long* SS;
    __device__ __forceinline__ void operator()(AccRef acc, const Unit& u, int wr, int wc, int fr, int fq) const {
        asm volatile("" : "+v"(fr), "+v"(fq));
        const int row0 = u.pm * BM + wr * 64 + fr, cl = wc * 32 + 8 * fq;
#pragma unroll
        for (int ai = 0; ai < 2; ++ai)
#pragma unroll
            for (int m = 0; m < 4; ++m) { const int rr = row0 + ai * HALF + m * 16; const float rs = SS ? rsqrtf((float)SS[rr] * (1.f / (1048576.f * DM)) + RMS_EPS) : 1.f; bf16_t* rowp = P + (size_t)rr * NPB + coff + u.pn * BM + cl;
#pragma unroll
                for (int bj = 0; bj < 2; ++bj) { const f32x4 v0 = acc[ai][bj][m][0] * rs, v1 = acc[ai][bj][m][1] * rs;
                    u32x4 w; w.x = cvt_pk_bf16(v0[0], v0[1]); w.y = cvt_pk_bf16(v0[2], v0[3]); w.z = cvt_pk_bf16(v1[0], v1[1]); w.w = cvt_pk_bf16(v1[2], v1[3]);
                    *(u32x4*)(rowp + bj * HALF) = w; } }
    }
};
struct EpiSmallPart {
    static constexpr bool PERM = true;
    float* SP; const unsigned long long* SS;
    __device__ __forceinline__ void operator()(AccRef acc, const Unit& u, int wr, int wc, int fr, int fq) const {
        asm volatile("" : "+v"(fr), "+v"(fq));
        const int row0 = u.pm * BM + wr * 64 + fr, cl = wc * 32 + 8 * fq;
#pragma unroll
        for (int ai = 0; ai < 2; ++ai)
#pragma unroll
            for (int m = 0; m < 4; ++m) { const int rr = row0 + ai * HALF + m * 16; const float rs = SS ? rsqrtf((float)SS[rr] * (1.f / (1048576.f * DM)) + RMS_EPS) : 1.f;
                float* rowp = SP + ((size_t)u.pn * S + rr) * 128 + cl; *(f32x4*)rowp = acc[ai][0][m][0] * rs; *(f32x4*)(rowp + 4) = acc[ai][0][m][1] * rs; }
    }
};
template <bool ADD> struct EpiGate {
    static constexpr bool PERM = true;
    bf16_t* O; const bf16_t* Gt;
    __device__ __forceinline__ void operator()(AccRef acc, const Unit& u, int wr, int wc, int fr, int fq) const {
        asm volatile("" : "+v"(fr), "+v"(fq));
        const int row0 = u.pm * BM + wr * 64 + fr, col0 = u.pn * BM + wc * 32 + 8 * fq;
#pragma unroll
        for (int ai = 0; ai < 2; ++ai)
#pragma unroll
            for (int m = 0; m < 4; ++m) { const size_t r = (size_t)(row0 + ai * HALF + m * 16);
#pragma unroll
                for (int bj = 0; bj < 2; ++bj) {
                    float g[8], o[8]; unpack8(*(const u32x4*)(Gt + r * NPB + col0 + bj * HALF), g);
                    const f32x4 v0 = acc[ai][bj][m][0], v1 = acc[ai][bj][m][1];
                    bf16_t* op = O + r * DM + col0 + bj * HALF;
                    if (ADD) unpack8(*(const u32x4*)op, o); else { for (int j = 0; j < 8; ++j) o[j] = 0.f; }
#pragma unroll
                    for (int j = 0; j < 4; ++j) { o[j] += sigmoidf_(g[j]) * v0[j]; o[4 + j] += sigmoidf_(g[4 + j]) * v1[j]; }
                    *(u32x4*)op = pack8(o); } }
    }
};
struct EpiResid {
    static constexpr bool PERM = false;
    const float* Xin; float* Xout;
    __device__ __forceinline__ void operator()(AccRef acc, const Unit& u, int wr, int wc, int fr, int fq) const {
        asm volatile("" : "+v"(fr), "+v"(fq));
        const int row0 = u.pm * BM + wr * 64 + fr, col0 = u.pn * BM + wc * 32 + 4 * fq;
#pragma unroll
        for (int ai = 0; ai < 2; ++ai)
#pragma unroll
            for (int m = 0; m < 4; ++m) { const size_t off = (size_t)(row0 + ai * HALF + m * 16) * DM + col0;
#pragma unroll
                for (int bj = 0; bj < 2; ++bj)
#pragma unroll
                    for (int n = 0; n < 2; ++n) { const f32x4 b = *(const f32x4*)(Xin + off + bj * HALF + n * 16); *(f32x4*)(Xout + off + bj * HALF + n * 16) = b + acc[ai][bj][m][n]; } }
    }
};
template <bool F8OUT> struct EpiResidN {
    static constexpr bool PERM = false;
    const float* Xin; float* Xout; void* XL; unsigned long long* SS; unsigned char* XL8;
    __device__ __forceinline__ void operator()(AccRef acc, const Unit& u, int wr, int wc, int fr, int fq) const {
        asm volatile("" : "+v"(fr), "+v"(fq));
        const int row0 = u.pm * BM + wr * 64 + fr, col0 = u.pn * BM + wc * 32 + 4 * fq;
#pragma unroll
        for (int ai = 0; ai < 2; ++ai)
#pragma unroll
            for (int m = 0; m < 4; ++m) { const int rr = row0 + ai * HALF + m * 16; const size_t off = (size_t)rr * DM + col0; float ss = 0.f;
#pragma unroll
                for (int bj = 0; bj < 2; ++bj)
#pragma unroll
                    for (int n = 0; n < 2; ++n) { const f32x4 b = *(const f32x4*)(Xin + off + bj * HALF + n * 16); const f32x4 v = b + acc[ai][bj][m][n]; *(f32x4*)(Xout + off + bj * HALF + n * 16) = v;
                        ss += (v[0] * v[0] + v[1] * v[1]) + (v[2] * v[2] + v[3] * v[3]);
                        if (F8OUT) *(unsigned*)((unsigned char*)XL + off + bj * HALF + n * 16) = cvt4_fp8c(v[0], v[1], v[2], v[3]);
                        else { u32x2 w; w.x = cvt_pk_bf16(v[0], v[1]); w.y = cvt_pk_bf16(v[2], v[3]); *(u32x2*)((bf16_t*)XL + off + bj * HALF + n * 16) = w; if (XL8) *(unsigned*)(XL8 + off + bj * HALF + n * 16) = cvt4_fp8c(v[0], v[1], v[2], v[3]); } }
                ss += __shfl_xor(ss, 16); ss += __shfl_xor(ss, 32);
                if (fq == 0) atomicAdd(SS + rr, (unsigned long long)(ss * 1048576.f)); }
    }
};
struct EpiSwiglu {
    static constexpr bool PERM = true;
    bf16_t* H; int ldh;
    __device__ __forceinline__ void operator()(AccRef acc, const Unit& u, int wr, int wc, int fr, int fq) const {
        asm volatile("" : "+v"(fr), "+v"(fq));
        const int row0 = u.pm * BM + wr * 64 + fr, col0 = u.pn * HALF + wc * 32 + 8 * fq;
#pragma unroll
        for (int ai = 0; ai < 2; ++ai)
#pragma unroll
            for (int m = 0; m < 4; ++m) { float o[8];
#pragma unroll
                for (int n = 0; n < 2; ++n)
#pragma unroll
                    for (int j = 0; j < 4; ++j) o[4 * n + j] = siluf_(acc[ai][0][m][n][j]) * acc[ai][1][m][n][j];
                *(u32x4*)(H + (size_t)(row0 + ai * HALF + m * 16) * ldh + col0) = pack8(o); }
    }
};
struct EpiSwiglu8 {
    static constexpr bool PERM = true;
    unsigned char* H; int ldh; float hs; const unsigned long long* SS;
    __device__ __forceinline__ void operator()(AccRef acc, const Unit& u, int wr, int wc, int fr, int fq) const {
        asm volatile("" : "+v"(fr), "+v"(fq));
        const int row0 = u.pm * BM + wr * 64 + fr, col0 = u.pn * HALF + wc * 32 + 8 * fq;
#pragma unroll
        for (int ai = 0; ai < 2; ++ai)
#pragma unroll
            for (int m = 0; m < 4; ++m) { float o[8]; const float rs = SS ? rsqrtf((float)SS[row0 + ai * HALF + m * 16] * (1.f / (1048576.f * DM)) + RMS_EPS) : 1.f;
#pragma unroll
                for (int n = 0; n < 2; ++n)
#pragma unroll
                    for (int j = 0; j < 4; ++j) o[4 * n + j] = hs * siluf_(acc[ai][0][m][n][j] * rs) * (acc[ai][1][m][n][j] * rs);
                u32x2 w; w.x = cvt4_fp8c(o[0], o[1], o[2], o[3]); w.y = cvt4_fp8c(o[4], o[5], o[6], o[7]);
                *(u32x2*)(H + (size_t)(row0 + ai * HALF + m * 16) * ldh + col0) = w; }
    }
};
struct EpiMoeDown {
    static constexpr bool PERM = true;
    bf16_t* Y; const float* roww;
    __device__ __forceinline__ void operator()(AccRef acc, const Unit& u, int wr, int wc, int fr, int fq) const {
        asm volatile("" : "+v"(fr), "+v"(fq));
        const int row0 = u.pm * BM + wr * 64 + fr, col0 = u.pn * BM + wc * 32 + 8 * fq;
#pragma unroll
        for (int ai = 0; ai < 2; ++ai)
#pragma unroll
            for (int m = 0; m < 4; ++m) { const size_t r = (size_t)(row0 + ai * HALF + m * 16); const float w = roww[r];
#pragma unroll
                for (int bj = 0; bj < 2; ++bj) { float o[8];
#pragma unroll
                    for (int j = 0; j < 4; ++j) { o[j] = w * acc[ai][bj][m][0][j]; o[4 + j] = w * acc[ai][bj][m][1][j]; }
                    *(u32x4*)(Y + r * DM + col0 + bj * HALF) = pack8(o); } }
    }
};
}

#define XB_TMO      128
#define XB_XCNT(j)  (256  + 64 * (j))
#define XB_XSUB(j)  (1280 + 64 * (j))
#define XB_XGEN(j)  (2304 + 64 * (j))
#define XB_TOP      3328
#define XB_TOPGEN   3392
#define XCD_BAR_WORDS 3456
#define XB_SPIN_CAP (1u << 22)
__device__ __forceinline__ unsigned xb_ld(unsigned* p)              { return __hip_atomic_load(p, __ATOMIC_RELAXED, __HIP_MEMORY_SCOPE_AGENT); }
__device__ __forceinline__ unsigned xb_add(unsigned* p, unsigned v) { return __hip_atomic_fetch_add(p, v, __ATOMIC_RELAXED, __HIP_MEMORY_SCOPE_AGENT); }
__device__ __forceinline__ unsigned xb_xcc_id() { return (unsigned)__builtin_amdgcn_s_getreg((3 << 11) | 20) & 0xFu; }
#define XB_SPIN(cond, bar) do { unsigned _sp = 0; while (cond) { __builtin_amdgcn_s_sleep(1); \
    if ((++_sp & 255u) == 0u) { if (xb_ld(&(bar)[XB_TMO])) break; if (_sp > XB_SPIN_CAP) { atomicAdd(&(bar)[XB_TMO], 1u); break; } } } } while (0)
struct XcdBarrier { unsigned* bar; unsigned x; volatile LAS unsigned* st; };
__device__ __forceinline__ XcdBarrier xcd_barrier_post(unsigned* bar, volatile LAS unsigned* st) {
    XcdBarrier b; b.bar = bar; b.x = xb_xcc_id(); b.st = st;
    if (threadIdx.x == 0) (void)xb_add(&bar[XB_XCNT(b.x)], 1u);
    return b;
}
__device__ __forceinline__ void xcd_barrier_complete(unsigned* bar, unsigned x, unsigned& nloc, unsigned& nx) {
    const unsigned G = gridDim.x * gridDim.y * gridDim.z;
    unsigned sum, cnt, mine, sp = 0u;
    for (;;) {
        sum = 0u; cnt = 0u; mine = 0u;
#pragma unroll
        for (unsigned j = 0; j < 16; ++j) { const unsigned c = xb_ld(&bar[XB_XCNT(j)]); sum += c; cnt += (c > 0u) ? 1u : 0u; mine = (j == x) ? c : mine; }
        if (sum == G) break;
        __builtin_amdgcn_s_sleep(1);
        if ((++sp & 255u) == 0u) { if (xb_ld(&bar[XB_TMO])) break; if (sp > XB_SPIN_CAP) { atomicAdd(&bar[XB_TMO], 1u); break; } }
    }
    nloc = mine > 0u ? mine : 1u; nx = cnt > 0u ? cnt : 1u;
}
__device__ __forceinline__ void xcd_barrier(const XcdBarrier& b) {
    asm volatile("s_waitcnt vmcnt(0)" ::: "memory");
    __syncthreads();
    if (threadIdx.x == 0) {
        unsigned* bar = b.bar;
        __builtin_amdgcn_s_waitcnt(0);
        unsigned nloc = b.st[0], nx = b.st[1];
        if (nloc == 0u) { xcd_barrier_complete(bar, b.x, nloc, nx); b.st[0] = nloc; b.st[1] = nx; }
        const unsigned old = xb_add(&bar[XB_XSUB(b.x)], 1u);
        const unsigned gen = old / nloc;
        if (old + 1u == (gen + 1u) * nloc) {
            __builtin_amdgcn_fence(__ATOMIC_RELEASE, "agent");
            asm volatile("s_waitcnt vmcnt(0)" ::: "memory");
            const unsigned og = xb_add(&bar[XB_TOP], 1u);
            const unsigned tg = og / nx;
            if (og + 1u == (tg + 1u) * nx) xb_add(&bar[XB_TOPGEN], 1u);
            else XB_SPIN(xb_ld(&bar[XB_TOPGEN]) == tg, bar);
            __builtin_amdgcn_fence(__ATOMIC_ACQUIRE, "agent");
            xb_add(&bar[XB_XGEN(b.x)], 1u);
            asm volatile("s_waitcnt vmcnt(0)" ::: "memory");
        } else {
            XB_SPIN(xb_ld(&bar[XB_XGEN(b.x)]) == gen, bar);
            __builtin_amdgcn_fence(__ATOMIC_ACQUIRE, "agent");
            asm volatile("s_waitcnt vmcnt(0)" ::: "memory");
        }
    }
    __syncthreads();
}

struct Ctx { LAS unsigned char* lds; unsigned char* ws; int tid, lane, wave, G, gw, NGW, bx; };
enum { IN_X = 0, IN_POS, IN_NORM_MIX, IN_W_IN, IN_CONV_W, IN_A_LOG, IN_DT_BIAS, IN_DN_NORM, IN_W_DN_OUT, IN_W_SA_OUT, IN_W_O, IN_NORM_FFN, IN_DW_GATE, IN_DW_UP, IN_DW_DOWN,
       IN_ROUTER, IN_MW_GATE, IN_MW_UP, IN_MW_DOWN, IN_FINAL_NORM, IN_OUT, IN_COUNT };
constexpr int PTAB_OFF = 131072 + 512;
__device__ __forceinline__ Ctx launder(const Ctx& c0) { Ctx c = c0; int wv = c0.wave; asm volatile("" : "+s"(wv)); c.wave = wv;
    c.lane = (int)__builtin_amdgcn_mbcnt_hi(~0u, __builtin_amdgcn_mbcnt_lo(~0u, 0u)); asm volatile("" : "+v"(c.lane)); c.tid = c.wave * 64 + c.lane;
    asm volatile("" : "+s"(c.G)); { unsigned la = (unsigned)(unsigned long long)c.lds; asm volatile("" : "+s"(la)); c.lds = (LAS unsigned char*)(unsigned long long)la; } unsigned long long w = (unsigned long long)c.ws; asm volatile("" : "+s"(w)); c.ws = (unsigned char*)(GAS unsigned char*)w; int bx = c0.bx; asm volatile("" : "+s"(bx)); c.bx = bx; c.gw = bx * 8 + c.wave; c.NGW = c.G * 8; return c; }
template <class T> __device__ __forceinline__ T* inptr(const Ctx& c, int i) {
    const LAS unsigned* tab = (const LAS unsigned*)(c.lds + PTAB_OFF); unsigned lo = tab[2 * i], hi = tab[2 * i + 1];
    lo = __builtin_amdgcn_readfirstlane(lo); hi = __builtin_amdgcn_readfirstlane(hi); return (T*)(GAS T*)(((unsigned long long)hi << 32) | lo); }
struct Params { const void* in[IN_COUNT]; unsigned char* ws; int ph_lo, ph_hi; };

__device__ __forceinline__ int map_win(int n) {
    if (n < 3072) return PC_QKV + n;
    if (n < 4096) return PC_Z + (n - 3072);
    if (n < 4104) return NPB + SC_A + (n - 4096);
    if (n < 4112) return NPB + SC_B + (n - 4104);
    if (n < 5136) return PC_QSA + (n - 4112);
    if (n < 6160) return PC_KSA + (n - 5136);
    if (n < 7184) return PC_VSA + (n - 6160);
    if (n < 8208) return PC_QIX + (n - 7184);
    if (n < 8272) return NPB + SC_KIX + (n - 8208);
    if (n < 8288) return NPB + SC_WIX + (n - 8272);
    return PC_GDN + (n - 8288);
}
constexpr size_t WIN8_OFF = (size_t)(NPH + 256) * DM * 2;
__device__ __forceinline__ void ti_load(const float* W, int N, const float* gain, int nblk, int item, int lane, float (&v_)[32], f32x4 (&gv)[2]) {
    const int kb = item / nblk, nb = item % nblk, k0 = 64 * kb, n0 = 32 * nb;
#pragma unroll
    for (int i = 0; i < 32; ++i) v_[i] = __builtin_nontemporal_load(W + (size_t)(k0 + 2 * i + (lane >> 5)) * N + n0 + (lane & 31));
    if (gain) { const float* g = gain + k0 + 8 * (lane & 7); gv[0] = *(const f32x4*)g; gv[1] = *(const f32x4*)(g + 4); }
    else { const f32x4 o1 = {1.f, 1.f, 1.f, 1.f}; gv[0] = o1; gv[1] = o1; }
}
__device__ __forceinline__ void ti_store(const float (&v_)[32], const f32x4 (&gv)[2], int K, bf16_t* WT, int mode, LAS float* scr, int nblk, int item, int lane, const float f8s) {
    const int kb = item / nblk, nb = item % nblk, k0 = 64 * kb, n0 = 32 * nb;
#pragma unroll
    for (int i = 0; i < 32; ++i) scr[(2 * i + (lane >> 5)) * 33 + (lane & 31)] = v_[i];
    LDS_WAIT(); asm volatile("" ::: "memory");
    const int c = lane & 7;
#pragma unroll
    for (int j = 0; j < 4; ++j) { const int nl = (lane >> 3) + 8 * j, n = n0 + nl; const LAS float* s0_ = scr + (8 * c) * 33 + nl;
        float e[8];
#pragma unroll
        for (int q = 0; q < 8; ++q) e[q] = s0_[q * 33] * (q < 4 ? gv[0][q & 3] : gv[1][q & 3]);
        int row = n; float f8r = f8s; unsigned char* W8 = (unsigned char*)WT;
        if (mode == 1) { const int R = map_win(n); if (R >= NPH && R < NPB) { row = R - NPH; f8r = F8_WIN; W8 = (unsigned char*)WT + WIN8_OFF; } else row = R < NPH ? R : NPH + (R - NPB); }
        else if (mode == 2) row = (n >> 7) * 256 + (n & 127); else if (mode == 3) row = (n >> 7) * 256 + 128 + (n & 127);
        if (f8r != 0.f) { const float f8s = f8r; unsigned char* WTb = W8; u32x2 o; o.x = cvt4_fp8(f8s * e[0], f8s * e[1], f8s * e[2], f8s * e[3]); o.y = cvt4_fp8(f8s * e[4], f8s * e[5], f8s * e[6], f8s * e[7]);
            *(u32x2*)(WTb + (size_t)row * K + k0 + 8 * c) = o; }
        else { u32x4 o; o.x = cvt_pk_bf16(e[0], e[1]); o.y = cvt_pk_bf16(e[2], e[3]); o.z = cvt_pk_bf16(e[4], e[5]); o.w = cvt_pk_bf16(e[6], e[7]);
            *(u32x4*)(WT + (size_t)row * K + k0 + 8 * c) = o; } }
    LDS_WAIT(); asm volatile("" ::: "memory");
}
__device__ __forceinline__ void p_convert(const Ctx& c, const int j0, const int j1, const int wk, const int nwk) {
    unsigned char* ws = c.ws;
    LAS float* scr = (LAS float*)(c.lds + c.wave * 16384);
    for (int j = j0; j < j1; ++j) {
        const float* src; bf16_t* dst; const float* gain = nullptr; int K, N, mode = 0; float f8s = 0.f;
        if (j < 8) { const int l = j >> 2, k = j & 3;
            if (k == 0) { src = inptr<const float>(c, IN_W_IN) + (size_t)l * DM * NIN; dst = (bf16_t*)(ws + WS_WIN) + (size_t)l * NPW * DM; gain = inptr<const float>(c, IN_NORM_MIX) + l * DM; K = DM; N = NIN; mode = 1; }
            else if (k == 1) { src = inptr<const float>(c, IN_W_DN_OUT) + (size_t)l * DNW * DM; dst = (bf16_t*)(ws + WS_WDN) + (size_t)l * DM * DNW; K = DNW; N = DM; }
            else if (k == 2) { src = inptr<const float>(c, IN_W_SA_OUT) + (size_t)l * DNW * DM; dst = (bf16_t*)(ws + WS_WSA) + (size_t)l * DM * DNW; K = DNW; N = DM; }
            else { src = inptr<const float>(c, IN_W_O) + (size_t)l * DM * DM; dst = (bf16_t*)(ws + WS_WO) + (size_t)l * DM * DM; K = DM; N = DM; }
        } else if (j < 11) { const int k = j - 8;
            if (k == 0) { src = inptr<const float>(c, IN_DW_GATE); dst = (bf16_t*)(ws + WS_WGU0); gain = inptr<const float>(c, IN_NORM_FFN); K = DM; N = DFF; mode = 2; f8s = F8_WGU; }
            else if (k == 1) { src = inptr<const float>(c, IN_DW_UP); dst = (bf16_t*)(ws + WS_WGU0); gain = inptr<const float>(c, IN_NORM_FFN); K = DM; N = DFF; mode = 3; f8s = F8_WGU; }
            else { src = inptr<const float>(c, IN_DW_DOWN); dst = (bf16_t*)(ws + WS_WD0); K = DFF; N = DM; f8s = F8_WD; }
        } else { const int e = (j - 11) / 3, k = (j - 11) % 3;
            if (k == 0) { src = inptr<const float>(c, IN_MW_GATE) + (size_t)e * DM * DFE; dst = (bf16_t*)(ws + WS_WGU1 + (size_t)e * 2 * DFE * DM); gain = inptr<const float>(c, IN_NORM_FFN) + DM; K = DM; N = DFE; mode = 2; f8s = F8_WGU; }
            else if (k == 1) { src = inptr<const float>(c, IN_MW_UP) + (size_t)e * DM * DFE; dst = (bf16_t*)(ws + WS_WGU1 + (size_t)e * 2 * DFE * DM); gain = inptr<const float>(c, IN_NORM_FFN) + DM; K = DM; N = DFE; mode = 3; f8s = F8_WGU; }
            else { src = inptr<const float>(c, IN_MW_DOWN) + (size_t)e * DFE * DM; dst = (bf16_t*)(ws + WS_WD1 + (size_t)e * DM * DFE); K = DFE; N = DM; f8s = F8_WD; }
        }
        const int nitems = (K / 64) * (N / 32), nblk = N / 32;
        for (int it = wk; it < nitems; it += 2 * nwk) { float va[32], vb[32]; f32x4 ga[2], gb[2]; const int itb = it + nwk;
            ti_load(src, N, gain, nblk, it, c.lane, va, ga); if (itb < nitems) ti_load(src, N, gain, nblk, itb, c.lane, vb, gb);
            ti_store(va, ga, K, dst, mode, scr, nblk, it, c.lane, f8s); if (itb < nitems) ti_store(vb, gb, K, dst, mode, scr, nblk, itb, c.lane, f8s); }
    }
}
__device__ __forceinline__ void p_prologue(const Ctx& c) {
    unsigned char* ws = c.ws;
    p_convert(c, 0, 4, c.gw, c.NGW);
    for (int l = 0; l < NLAYER; ++l) { u32x4* z = (u32x4*)((bf16_t*)(ws + WS_WIN) + ((size_t)l * NPW + NPH + 96) * DM); const int n16 = (256 - 96) * DM / 8;
        for (int i = c.gw * 64 + c.lane; i < n16; i += c.NGW * 64) z[i] = (u32x4){0u, 0u, 0u, 0u}; }
    { unsigned long long* ss = (unsigned long long*)(ws + WS_ROUTE + RT_SS); for (int i = c.gw * 64 + c.lane; i < 2 * S; i += c.NGW * 64) ss[i] = 0ull; }
    float* rope = (float*)(ws + WS_ROPE); const int* posp = inptr<const int>(c, IN_POS);
    for (int i = c.gw * 64 + c.lane; i < S * 96; i += c.NGW * 64) { const int t = i / 96, k = i % 96;
        const double rf = k < 64 ? RF_SA[k] : RF_SA[2 * (k - 64)];
        double fr = (double)posp[t] * rf; fr -= __builtin_rint(fr); const float ff = (float)fr;
        const float cs = __builtin_amdgcn_cosf(ff), sn = __builtin_amdgcn_sinf(ff);
        if (k < 64) { rope[(size_t)t * 192 + k] = cs; rope[(size_t)t * 192 + 64 + k] = sn; } else { rope[(size_t)t * 192 + 128 + (k - 64)] = cs; rope[(size_t)t * 192 + 160 + (k - 64)] = sn; } }
}

template <bool ROUTER, bool F8OUT, bool BOTH = false>
__device__ __forceinline__ void p_norm(const Ctx& c, const float* X, const float* gain_r) {
    bf16_t* XN = (bf16_t*)(c.ws + WS_XN); const float* router = ROUTER ? inptr<const float>(c, IN_ROUTER) : nullptr;
    LAS int* lsel = (LAS int*)(c.lds);
    for (int it = 0; it < S / (8 * c.G) + 1; ++it) {
        const int t = (it * c.G + c.bx) * 8 + c.wave;
        if (t >= S) break;
        const f32x4* xr = (const f32x4*)(X + (size_t)t * DM) + c.lane;
        f32x4 v[8]; float ss = 0.f;
#pragma unroll
        for (int j = 0; j < 8; ++j) { v[j] = xr[64 * j]; ss += (v[j].x * v[j].x + v[j].y * v[j].y) + (v[j].z * v[j].z + v[j].w * v[j].w); }
        const float rstd = rsqrtf(wave_sum(ss) * (1.f / DM) + RMS_EPS);
        if constexpr (F8OUT) { unsigned* o4 = (unsigned*)((unsigned char*)XN + (size_t)t * DM) + c.lane;
#pragma unroll
            for (int j = 0; j < 8; ++j) o4[64 * j] = cvt4_fp8c(v[j].x * rstd, v[j].y * rstd, v[j].z * rstd, v[j].w * rstd); }
        else { u32x2* o8 = (u32x2*)(XN + (size_t)t * DM) + c.lane;
#pragma unroll
            for (int j = 0; j < 8; ++j) { u32x2 w; w.x = cvt_pk_bf16(v[j].x * rstd, v[j].y * rstd); w.y = cvt_pk_bf16(v[j].z * rstd, v[j].w * rstd); o8[64 * j] = w; }
            if constexpr (BOTH) { unsigned* o4 = (unsigned*)(c.ws + WS_XN8 + (size_t)t * DM) + c.lane;
#pragma unroll
                for (int j = 0; j < 8; ++j) o4[64 * j] = cvt4_fp8c(v[j].x * rstd, v[j].y * rstd, v[j].z * rstd, v[j].w * rstd); } }
        if constexpr (ROUTER) {
            float lg[NEXP];
#pragma unroll
            for (int e = 0; e < NEXP; ++e) lg[e] = 0.f;
#pragma unroll
            for (int j = 0; j < 8; ++j)
#pragma unroll
                for (int q = 0; q < 4; ++q) { const int k = 256 * j + 4 * c.lane + q; const float xv = v[j][q] * gain_r[k]; const f32x4* wr = (const f32x4*)(router + (size_t)k * NEXP); const f32x4 w0 = wr[0], w1 = wr[1];
                    lg[0] += xv * w0.x; lg[1] += xv * w0.y; lg[2] += xv * w0.z; lg[3] += xv * w0.w; lg[4] += xv * w1.x; lg[5] += xv * w1.y; lg[6] += xv * w1.z; lg[7] += xv * w1.w; }
#pragma unroll
            for (int e = 0; e < NEXP; ++e) lg[e] = wave_sum(lg[e]) * rstd;
            int e0 = 0; float v0 = lg[0];
#pragma unroll
            for (int e = 1; e < NEXP; ++e) if (lg[e] > v0) { v0 = lg[e]; e0 = e; }
            int e1 = -1; float v1 = -__builtin_inff();
#pragma unroll
            for (int e = 0; e < NEXP; ++e) if (e != e0 && lg[e] > v1) { v1 = lg[e]; e1 = e; }
            const float w0 = 1.f / (1.f + __expf(v1 - v0)), w1 = 1.f - w0;
            if (c.lane == 0) { u32x4 r; r.x = (unsigned)e0; r.y = (unsigned)e1; r.z = __float_as_uint(w0); r.w = __float_as_uint(w1); *(u32x4*)(c.ws + WS_ROUTE + RT_SEL + (size_t)t * 16) = r; }
        }
    }
}

__device__ __forceinline__ void p_prep(const Ctx& c, int layer, const int w0, const int nw) {
    unsigned char* ws = c.ws;
    const bf16_t* PROJ = (const bf16_t*)(ws + WS_PROJ); bf16_t* PROJw = (bf16_t*)(ws + WS_PROJ);
    const float* SM = (const float*)(ws + WS_MERGED);
    const float* rope = (const float*)(ws + WS_ROPE);
    bf16_t* KIX = (bf16_t*)(ws + WS_KIX); float* WIX = (float*)(ws + WS_WIX);
    for (int t = w0; t < S; t += nw) {
        const float* rt = rope + (size_t)t * 192;
        { const int hh = c.lane >> 3, i8 = (c.lane & 7) * 8;
            float cs[8], sn[8]; *(f32x4*)cs = *(const f32x4*)(rt + i8); *(f32x4*)(cs + 4) = *(const f32x4*)(rt + i8 + 4); *(f32x4*)sn = *(const f32x4*)(rt + 64 + i8); *(f32x4*)(sn + 4) = *(const f32x4*)(rt + 64 + i8 + 4);
#pragma unroll
            for (int qk = 0; qk < 2; ++qk) { bf16_t* b = PROJw + (size_t)t * NPB + (qk ? PC_KSA : PC_QSA) + hh * 128 + i8; float a1[8], a2[8], o1[8], o2[8]; unpack8(*(const u32x4*)b, a1); unpack8(*(const u32x4*)(b + 64), a2);
#pragma unroll
                for (int e = 0; e < 8; ++e) { o1[e] = a1[e] * cs[e] - a2[e] * sn[e]; o2[e] = a2[e] * cs[e] + a1[e] * sn[e]; }
                *(u32x4*)b = pack8(o1); *(u32x4*)(b + 64) = pack8(o2); } }
        { const int hh = c.lane >> 2, i8 = (c.lane & 3) * 8;
            float cs[8], sn[8]; *(f32x4*)cs = *(const f32x4*)(rt + 128 + i8); *(f32x4*)(cs + 4) = *(const f32x4*)(rt + 128 + i8 + 4); *(f32x4*)sn = *(const f32x4*)(rt + 160 + i8); *(f32x4*)(sn + 4) = *(const f32x4*)(rt + 160 + i8 + 4);
            bf16_t* b = PROJw + (size_t)t * NPB + PC_QIX + hh * 64 + i8; float a1[8], a2[8], o1[8], o2[8]; unpack8(*(const u32x4*)b, a1); unpack8(*(const u32x4*)(b + 32), a2);
#pragma unroll
            for (int e = 0; e < 8; ++e) { o1[e] = a1[e] * cs[e] - a2[e] * sn[e]; o2[e] = a2[e] * cs[e] + a1[e] * sn[e]; }
            *(u32x4*)b = pack8(o1); *(u32x4*)(b + 32) = pack8(o2); }
        const float* sm = SM + (size_t)t * 128;
#define SMSUM(col) ({ float a_ = 0.f; _Pragma("unroll") for (int ks_ = 0; ks_ < SMALL_KS; ++ks_) a_ += sm[(size_t)ks_ * S * 128 + (col)]; a_; })
        if (c.lane < 32) { const float a1 = SMSUM(SC_KIX + c.lane), a2 = SMSUM(SC_KIX + 32 + c.lane), cs = rt[128 + c.lane], sn = rt[160 + c.lane];
            KIX[(size_t)t * 64 + c.lane] = f2bf(a1 * cs - a2 * sn); KIX[(size_t)t * 64 + 32 + c.lane] = f2bf(a2 * cs + a1 * sn); }
        else if (c.lane < 48) { const int i = c.lane - 32; WIX[(size_t)t * 16 + i] = SMSUM(SC_WIX + i) * 0.03125f; }
#undef SMSUM
    }
}

__device__ __forceinline__ void p_dn_scan(const Ctx& c) {
    unsigned char* ws = c.ws;
    const bf16_t* DQ = (const bf16_t*)(ws + WS_DNQKV); const float* GB = (const float*)(ws + WS_GB); float* OR = (float*)(ws + WS_ODNRAW);
    if (c.wave != 0) return;
    for (int u = c.bx; u < 256; u += c.G) {
        const int h = u >> 5, j = (u & 31) * 4 + (c.lane >> 4), li = c.lane & 15;
        float s[8];
#pragma unroll
        for (int e = 0; e < 8; ++e) s[e] = 0.f;
        const bf16_t* qp = DQ + h * 128 + li * 8; const bf16_t* kp = DQ + 1024 + h * 128 + li * 8; const bf16_t* vp = DQ + 2048 + h * 128 + j;
#pragma unroll 2
        for (int t = 0; t < S; ++t) {
            float k[8], q[8]; unpack8(*(const u32x4*)(kp + (size_t)t * 3072), k); unpack8(*(const u32x4*)(qp + (size_t)t * 3072), q);
            const float v = bf2f(vp[(size_t)t * 3072]); const float a = __expf(GB[(size_t)t * 8 + h]), beta = GB[(size_t)S * 8 + (size_t)t * 8 + h];
            float d = 0.f;
#pragma unroll
            for (int e = 0; e < 8; ++e) { s[e] *= a; d += k[e] * s[e]; }
            d = row16_sum(d);
            const float dl = beta * (v - d); float o = 0.f;
#pragma unroll
            for (int e = 0; e < 8; ++e) { s[e] += dl * k[e]; o += q[e] * s[e]; }
            o = row16_sum(o);
            if (li == 0) OR[(size_t)t * 1024 + h * 128 + j] = o;
        }
    }
}
__device__ __forceinline__ void p_dn_post(const Ctx& c, int layer) {
    unsigned char* ws = c.ws;
    const float* OR = (const float*)(ws + WS_ODNRAW2); const bf16_t* PROJ = (const bf16_t*)(ws + WS_PROJ); bf16_t* ODN = (bf16_t*)(ws + WS_ODN);
    const float* gn = inptr<const float>(c, IN_DN_NORM) + layer * HD;
    for (int u = c.gw; u < S * 2; u += c.NGW) { const int t = u >> 1, col = (u & 1) * 512 + c.lane * 8, d0 = (c.lane & 15) * 8;
        float o[8], z[8]; *(f32x4*)o = *(const f32x4*)(OR + (size_t)t * 1024 + col); *(f32x4*)(o + 4) = *(const f32x4*)(OR + (size_t)t * 1024 + col + 4);
        unpack8(*(const u32x4*)(PROJ + (size_t)t * NPB + PC_Z + col), z);
        float ss = 0.f;
#pragma unroll
        for (int e = 0; e < 8; ++e) ss += o[e] * o[e];
        ss = row16_sum(ss); const float r = rsqrtf(ss * (1.f / HD) + RMS_EPS);
#pragma unroll
        for (int e = 0; e < 8; ++e) o[e] = o[e] * r * gn[d0 + e] * siluf_(z[e]);
        *(u32x4*)(ODN + (size_t)t * 1024 + col) = pack8(o); }
}


namespace dn {
typedef const f32x4 cf4;
#define OPQ(p) ({ unsigned long long t_ = (unsigned long long)(p); asm volatile("" : "+s"(t_)); (unsigned char*)(GAS unsigned char*)t_; })
constexpr int UNIT_BYTES = 81920, OFF_WF = 0, OFF_KF = 16384, OFF_QF = 32768, OFF_UF = 49152, OFF_OF = 65536;
__device__ __forceinline__ f32x4 mma(bf16x8 a, bf16x8 b, f32x4 c) { return __builtin_amdgcn_mfma_f32_16x16x32_bf16(a, b, c, 0, 0, 0); }
__device__ __forceinline__ bf16x8 pack2(f32x4 a, f32x4 b) { u32x4 w; w.x = cvt_pk_bf16(a[0], a[1]); w.y = cvt_pk_bf16(a[2], a[3]); w.z = cvt_pk_bf16(b[0], b[1]); w.w = cvt_pk_bf16(b[2], b[3]); return __builtin_bit_cast(bf16x8, w); }
__device__ __forceinline__ u32x2 pack4(f32x4 a) { u32x2 w; w.x = cvt_pk_bf16(a[0], a[1]); w.y = cvt_pk_bf16(a[2], a[3]); return w; }
__device__ __forceinline__ f32x4 unpack4(u32x2 w) { f32x4 r; r[0] = __uint_as_float(w.x << 16); r[1] = __uint_as_float(w.x & 0xffff0000u); r[2] = __uint_as_float(w.y << 16); r[3] = __uint_as_float(w.y & 0xffff0000u); return r; }
__device__ __forceinline__ float conv_rows(const char* PROJb, const char* cwb, int n, int h, int tsel, int it, int c16, unsigned xoff, unsigned woff, float (&y)[4][8]) {
    const int t = 64 * n + 16 * it + c16; float ss = 0.f;
    const char* Pb = (const char*)OPQ(PROJb) - 3 * NPB * 2; const char* Cb = (const char*)OPQ(cwb);
    u32x4 xr[4][4];
#pragma unroll
    for (int s = 0; s < 4; ++s)
#pragma unroll
        for (int j = 0; j < 4; ++j) xr[s][j] = *(const u32x4*)(Pb + (xoff + (unsigned)((64 * n + 16 * it + j) * NPB + tsel * 1024 + h * 128 + 32 * s) * 2u));
#pragma unroll
    for (int s = 0; s < 4; ++s) { const int chu = tsel * 1024 + h * 128 + 32 * s;
        float acc[8];
#pragma unroll
        for (int e = 0; e < 8; ++e) acc[e] = 0.f;
#pragma unroll
        for (int j = 0; j < 4; ++j) { float x[8]; unpack8(xr[s][j], x);
            const bool ok = t - 3 + j >= 0;
            const unsigned wo = (unsigned)(j * 3072 + chu) * 4u;
            const f32x4 w0 = *(const f32x4*)(Cb + (woff + wo)), w1 = *(const f32x4*)(Cb + (woff + wo) + 16);
#pragma unroll
            for (int e = 0; e < 4; ++e) { acc[e] += w0[e] * (ok ? x[e] : 0.f); acc[4 + e] += w1[e] * (ok ? x[4 + e] : 0.f); } }
#pragma unroll
        for (int e = 0; e < 8; ++e) { const float v = siluf_(acc[e]); y[s][e] = v; ss += v * v; } }
    asm volatile("" ::: "memory");
    return ss;
}
__device__ __forceinline__ void conv_rows_s4(const char* PROJb, const char* cwb, int n, int h, int tsel, int s, int c16, unsigned xoff, unsigned woff, float (&y)[4][8]) {
    const int chu = tsel * 1024 + h * 128 + 32 * s; const char* Pb = (const char*)OPQ(PROJb) - 3 * NPB * 2; const char* Cb = (const char*)OPQ(cwb);
    u32x4 xr[4][4]; f32x4 w0[4], w1[4];
#pragma unroll
    for (int it = 0; it < 4; ++it)
#pragma unroll
        for (int j = 0; j < 4; ++j) xr[it][j] = *(const u32x4*)(Pb + (xoff + (unsigned)((64 * n + 16 * it + j) * NPB + chu) * 2u));
#pragma unroll
    for (int j = 0; j < 4; ++j) { const unsigned wo = (unsigned)(j * 3072 + chu) * 4u; w0[j] = *(const f32x4*)(Cb + (woff + wo)); w1[j] = *(const f32x4*)(Cb + (woff + wo) + 16); }
#pragma unroll
    for (int it = 0; it < 4; ++it) { const int t = 64 * n + 16 * it + c16; float acc[8];
#pragma unroll
        for (int e = 0; e < 8; ++e) acc[e] = 0.f;
#pragma unroll
        for (int j = 0; j < 4; ++j) { float x[8]; unpack8(xr[it][j], x); const bool ok = t - 3 + j >= 0;
#pragma unroll
            for (int e = 0; e < 4; ++e) { acc[e] += w0[j][e] * (ok ? x[e] : 0.f); acc[4 + e] += w1[j][e] * (ok ? x[4 + e] : 0.f); } }
#pragma unroll
        for (int e = 0; e < 8; ++e) y[it][e] = siluf_(acc[e]); }
}
__device__ __forceinline__ void intra_unit(const Ctx& c, LAS unsigned char* wl, LAS unsigned char* afp, volatile LAS unsigned* flag, int n, int h, int layer) {
    unsigned char* ws = c.ws;
    const char* PROJb = (const char*)(ws + WS_PROJ); const float* SM = (const float*)(ws + WS_MERGED);
    const char* cwb = (const char*)(inptr<const float>(c, IN_CONV_W) + (size_t)layer * 4 * 3072);
    const int lane = c.lane, c16 = lane & 15, g = lane >> 4;
    const unsigned xoff = (unsigned)(c16 * NPB + 8 * g) * 2u, woff = (unsigned)(8 * g) * 4u, lane16 = (unsigned)lane * 16u, lane8 = (unsigned)lane * 8u;
    unsigned char* ub = ws + WS_DNF + (size_t)(n * DNH + h) * UNIT_BYTES;
    float gtok, beta;
    { const float* sm = SM + (size_t)(64 * n + lane) * 128; float av = 0.f, bv = 0.f;
#pragma unroll
      for (int ks = 0; ks < SMALL_KS; ++ks) { av += sm[(size_t)ks * S * 128 + SC_A + h]; bv += sm[(size_t)ks * S * 128 + SC_B + h]; }
      const float xx = av + inptr<const float>(c, IN_DT_BIAS)[layer * DNH + h];
      const float sp = xx > 20.f ? xx : log1pf(__expf(xx)); gtok = -__expf(inptr<const float>(c, IN_A_LOG)[layer * DNH + h]) * sp; beta = sigmoidf_(bv); }
    LAS float* tgc = (LAS float*)(c.lds + DN_TAB_OFF + c.wave * 1024); LAS float* tbeta = tgc + 64; LAS float* tg = tgc + 128;
    tg[lane] = gtok; tbeta[lane] = beta; LDS_WAIT();
    float gc = 0.f;
#pragma unroll
    for (int m = 0; m < 16; ++m) { const f32x4 v = *(const LAS f32x4*)(tg + 4 * m);
#pragma unroll
        for (int q = 0; q < 4; ++q) gc += (4 * m + q <= lane) ? v[q] : 0.f; }
    tgc[lane] = gc; LDS_WAIT();
    const float gc63 = tgc[63];
    if (lane == 0) ((float*)(ws + WS_GL))[n * DNH + h] = __expf(gc63);
#define LOAD_GC() float gcR[16], gcC[4]; _Pragma("unroll") for (int jt_ = 0; jt_ < 4; ++jt_) { gcC[jt_] = tgc[16 * jt_ + c16]; *(f32x4*)(&gcR[4 * jt_]) = *(const LAS f32x4*)(tgc + 16 * jt_ + 4 * g); }
    const f32x4 Z4 = {0.f, 0.f, 0.f, 0.f};
    LAS float* AT = (LAS float*)wl;
    bf16x8 AF[4][2];
    { bf16x8 Kf[4][4];
#pragma unroll
      for (int it = 0; it < 4; ++it) { float y[4][8];
          float ss = conv_rows(PROJb, cwb, n, h, 1, it, c16, xoff, woff, y); ss += __shfl_xor(ss, 16); ss += __shfl_xor(ss, 32);
          const float r = rsqrtf(ss + L2_EPS);
#pragma unroll
          for (int s = 0; s < 4; ++s) { float z[8];
#pragma unroll
              for (int e = 0; e < 8; ++e) z[e] = y[s][e] * r;
              Kf[it][s] = __builtin_bit_cast(bf16x8, pack8(z)); *(bf16x8*)(OPQ(ub) + (OFF_WF + (it * 4 + s) * 1024) + lane16) = Kf[it][s]; }
          asm volatile("" ::: "memory"); }
      { LOAD_GC(); float betaR[16];
#pragma unroll
        for (int jt = 0; jt < 4; ++jt) *(f32x4*)(&betaR[4 * jt]) = *(const LAS f32x4*)(tbeta + 16 * jt + 4 * g);
#pragma unroll
        for (int ct = 0; ct < 4; ++ct)
#pragma unroll
            for (int jt = ct; jt < 4; ++jt) { f32x4 acc = Z4;
#pragma unroll
                for (int s = 0; s < 4; ++s) acc = mma(Kf[jt][s], Kf[ct][s], acc);
                const int cc = 16 * ct + c16; f32x4 o;
#pragma unroll
                for (int r = 0; r < 4; ++r) { const int j = 16 * jt + 4 * g + r; o[r] = j > cc ? betaR[4 * jt + r] * acc[r] * __expf(gcR[4 * jt + r] - gcC[ct]) : 0.f; }
                *(LAS f32x4*)(AT + cc * 64 + 16 * jt + 4 * g) = o; } }
      asm volatile("" ::: "memory"); }
#pragma unroll
    for (int it = 0; it < 4; ++it) { float y[4][8];
        float ss = conv_rows(PROJb, cwb, n, h, 0, it, c16, xoff, woff, y); ss += __shfl_xor(ss, 16); ss += __shfl_xor(ss, 32);
        const float r = rsqrtf(ss + L2_EPS) * 0.08838834764831845f;
#pragma unroll
        for (int s = 0; s < 4; ++s) { float z[8];
#pragma unroll
            for (int e = 0; e < 8; ++e) z[e] = y[s][e] * r;
            *(bf16x8*)(OPQ(ub) + (OFF_QF + (it * 4 + s) * 1024) + lane16) = __builtin_bit_cast(bf16x8, pack8(z)); }
        asm volatile("" ::: "memory"); }
    asm volatile("s_waitcnt vmcnt(0)" ::: "memory");
    { bf16x8 Kf[4][4];
#pragma unroll
      for (int it = 0; it < 4; ++it)
#pragma unroll
          for (int s = 0; s < 4; ++s) Kf[it][s] = *(const bf16x8*)(OPQ(ub) + (OFF_WF + (it * 4 + s) * 1024) + lane16);
      LOAD_GC();
      bf16x8 Qa[4][4];
#pragma unroll
      for (int it = 0; it < 4; ++it)
#pragma unroll
          for (int s = 0; s < 4; ++s) Qa[it][s] = *(const bf16x8*)(OPQ(ub) + (OFF_QF + (it * 4 + s) * 1024) + lane16);
#pragma unroll
      for (int it = 0; it < 4; ++it) { const bf16x8 (&Qr)[4] = Qa[it];
#pragma unroll
          for (int s = 0; s < 2; ++s) { f32x4 t2[2];
#pragma unroll
              for (int q = 0; q < 2; ++q) { const int jt = 2 * s + q; f32x4 acc = Z4;
                  if (it >= jt) {
#pragma unroll
                      for (int ks = 0; ks < 4; ++ks) acc = mma(Kf[jt][ks], Qr[ks], acc);
                      const int i = 16 * it + c16;
#pragma unroll
                      for (int r = 0; r < 4; ++r) { const int j = 16 * jt + 4 * g + r; acc[r] = i >= j ? acc[r] * __expf(gcC[it] - gcR[4 * jt + r]) : 0.f; } }
                  t2[q] = acc; }
              AF[it][s] = pack2(t2[0], t2[1]); } }
      asm volatile("" ::: "memory"); }
#pragma unroll
    for (int it = 0; it < 4; ++it)
#pragma unroll
        for (int s = 0; s < 2; ++s) *(LAS bf16x8*)(afp + (it * 2 + s) * 1024 + lane16) = AF[it][s];
    LDS_WAIT();
    { float T[64];
#pragma unroll
      for (int cc = 63; cc >= 0; --cc) { float a0 = lane == cc ? 1.f : 0.f, a1 = 0.f;
#pragma unroll
          for (int m = (cc + 1) >> 2; m < 16; ++m) { const f32x4 av = *(const LAS f32x4*)(AT + cc * 64 + 4 * m);
#pragma unroll
              for (int q = 0; q < 4; ++q) { const int j = 4 * m + q; if (j > cc) { if (j & 1) a1 -= T[j] * av[q]; else a0 -= T[j] * av[q]; } } }
          T[cc] = a0 + a1; asm volatile("" : "+v"(T[cc])); }
      LDS_WAIT();
#pragma unroll
      for (int m = 0; m < 16; ++m) { u32x2 w; w.x = cvt_pk_bf16(T[4 * m], T[4 * m + 1]); w.y = cvt_pk_bf16(T[4 * m + 2], T[4 * m + 3]); *(LAS u32x2*)(wl + lane * 136 + 8 * m) = w; } }
    LDS_WAIT();
    *flag = 1u;
    bf16x8 TF[4][2];
#pragma unroll
    for (int it = 0; it < 4; ++it)
#pragma unroll
        for (int s = 0; s < 2; ++s) { const int i = 16 * it + c16; const u32x2 lo = *(const LAS u32x2*)(wl + i * 136 + (32 * s + 4 * g) * 2), hi2 = *(const LAS u32x2*)(wl + i * 136 + (32 * s + 16 + 4 * g) * 2);
            u32x4 w; w.x = lo.x; w.y = lo.y; w.z = hi2.x; w.w = hi2.y; TF[it][s] = __builtin_bit_cast(bf16x8, w); }
    bf16x8 ID0, ID1;
    { u32x4 w0 = {0u, 0u, 0u, 0u}, w1 = {0u, 0u, 0u, 0u}; const int e0 = c16 - 8 * g, e1 = c16 + 16 - 8 * g;
#pragma unroll
      for (int e = 0; e < 8; ++e) { const unsigned one = (e & 1) ? 0x3F800000u : 0x00003F80u; if (e == e0) w0[e >> 1] |= one; if (e == e1) w1[e >> 1] |= one; }
      ID0 = __builtin_bit_cast(bf16x8, w0); ID1 = __builtin_bit_cast(bf16x8, w1); }
    { asm volatile("" ::: "memory"); LOAD_GC(); float sc1[16], sc2[16];
#pragma unroll
      for (int jt = 0; jt < 4; ++jt)
#pragma unroll
          for (int r = 0; r < 4; ++r) { const float b = tbeta[16 * jt + 4 * g + r]; sc1[4 * jt + r] = b * __expf(gcR[4 * jt + r]); sc2[4 * jt + r] = __expf(gc63 - gcR[4 * jt + r]); }
      float egC[4];
#pragma unroll
      for (int it = 0; it < 4; ++it) egC[it] = __expf(gcC[it]);
      bf16x8 Kfn[4], Qfn[4];
#pragma unroll
      for (int it = 0; it < 4; ++it) { Kfn[it] = *(const bf16x8*)(OPQ(ub) + (OFF_WF + (it * 4) * 1024) + lane16); Qfn[it] = *(const bf16x8*)(OPQ(ub) + (OFF_QF + (it * 4) * 1024) + lane16); }
#pragma unroll
      for (int s4 = 0; s4 < 4; ++s4) { bf16x8 Kfs[4], Qfs[4];
#pragma unroll
          for (int it = 0; it < 4; ++it) { Kfs[it] = Kfn[it]; Qfs[it] = Qfn[it]; }
          if (s4 < 3) {
#pragma unroll
              for (int it = 0; it < 4; ++it) { Kfn[it] = *(const bf16x8*)(OPQ(ub) + (OFF_WF + (it * 4 + s4 + 1) * 1024) + lane16); Qfn[it] = *(const bf16x8*)(OPQ(ub) + (OFF_QF + (it * 4 + s4 + 1) * 1024) + lane16); } }
#pragma unroll
          for (int par = 0; par < 2; ++par) { const int dt = 2 * s4 + par; const bf16x8 ID = par ? ID1 : ID0;
              f32x4 Kc[4];
#pragma unroll
              for (int jt = 0; jt < 4; ++jt) Kc[jt] = mma(Kfs[jt], ID, Z4);
              bf16x8 B1A[2];
#pragma unroll
              for (int s = 0; s < 2; ++s) { f32x4 a, b, a2, b2;
#pragma unroll
                  for (int r = 0; r < 4; ++r) { a[r] = Kc[2 * s][r] * sc1[8 * s + r]; b[r] = Kc[2 * s + 1][r] * sc1[8 * s + 4 + r]; a2[r] = Kc[2 * s][r] * sc2[8 * s + r]; b2[r] = Kc[2 * s + 1][r] * sc2[8 * s + 4 + r]; }
                  B1A[s] = pack2(a, b);
                  *(bf16x8*)(OPQ(ub) + (OFF_KF + (dt * 2 + s) * 1024) + lane16) = pack2(a2, b2); }
#pragma unroll
              for (int it = 0; it < 4; ++it) { f32x4 acc = Z4;
#pragma unroll
                  for (int s = 0; s < 2; ++s) acc = mma(B1A[s], TF[it][s], acc);
                  *(u32x2*)(OPQ(ub) + (OFF_WF + (it * 4 + s4) * 1024 + 8 * par) + lane16) = pack4(acc); }
              f32x4 Wc[4];
#pragma unroll
              for (int jt = 0; jt < 4; ++jt) { f32x4 acc = Z4;
#pragma unroll
                  for (int s = 0; s < 2; ++s) acc = mma(TF[jt][s], B1A[s], acc);
                  Wc[jt] = -acc; }
              bf16x8 WA[2];
#pragma unroll
              for (int s = 0; s < 2; ++s) WA[s] = pack2(Wc[2 * s], Wc[2 * s + 1]);
#pragma unroll
              for (int it = 0; it < 4; ++it) { f32x4 acc = mma(ID, Qfs[it], Z4); acc = acc * egC[it];
#pragma unroll
                  for (int s = 0; s < 2; ++s) acc = mma(WA[s], AF[it][s], acc);
                  *(u32x2*)(OPQ(ub) + (OFF_QF + (it * 4 + s4) * 1024 + 8 * par) + lane16) = pack4(acc); }
              asm volatile("" ::: "memory"); } } }
    LDS_WAIT();
}
__device__ __forceinline__ void v_side(const Ctx& c, const LAS unsigned char* wlp, const LAS unsigned char* afp, volatile LAS unsigned* flag, int n, int h, int layer) {
    unsigned char* ws = c.ws;
    const char* PROJb = (const char*)(ws + WS_PROJ);
    const char* cwb = (const char*)(inptr<const float>(c, IN_CONV_W) + (size_t)layer * 4 * 3072);
    const int lane = c.lane, c16 = lane & 15, g = lane >> 4;
    const unsigned xoff = (unsigned)(c16 * NPB + 8 * g) * 2u, woff = (unsigned)(8 * g) * 4u, lane16 = (unsigned)lane * 16u, lane8 = (unsigned)lane * 8u;
    unsigned char* ub = ws + WS_DNF + (size_t)(n * DNH + h) * UNIT_BYTES;
    const LAS float* tbeta = (const LAS float*)(c.lds + DN_TAB_OFF + (c.wave - 4) * 1024) + 64;
    const f32x4 Z4 = {0.f, 0.f, 0.f, 0.f};
    for (int spin = 0; spin < (1 << 22); ++spin) { if (*flag != 0u) break; __builtin_amdgcn_s_sleep(16); }
    asm volatile("s_waitcnt lgkmcnt(0)" ::: "memory");
    const LAS unsigned char* wl = wlp;
    bf16x8 TF[4][2], AF[4][2];
#pragma unroll
    for (int it = 0; it < 4; ++it)
#pragma unroll
        for (int s = 0; s < 2; ++s) { const int i = 16 * it + c16; const u32x2 lo = *(const LAS u32x2*)(wl + i * 136 + (32 * s + 4 * g) * 2), hi2 = *(const LAS u32x2*)(wl + i * 136 + (32 * s + 16 + 4 * g) * 2);
            u32x4 w; w.x = lo.x; w.y = lo.y; w.z = hi2.x; w.w = hi2.y; TF[it][s] = __builtin_bit_cast(bf16x8, w); AF[it][s] = *(const LAS bf16x8*)(afp + (it * 2 + s) * 1024 + lane16); }
    bf16x8 ID0, ID1;
    { u32x4 w0 = {0u, 0u, 0u, 0u}, w1 = {0u, 0u, 0u, 0u}; const int e0 = c16 - 8 * g, e1 = c16 + 16 - 8 * g;
#pragma unroll
      for (int e = 0; e < 8; ++e) { const unsigned one = (e & 1) ? 0x3F800000u : 0x00003F80u; if (e == e0) w0[e >> 1] |= one; if (e == e1) w1[e >> 1] |= one; }
      ID0 = __builtin_bit_cast(bf16x8, w0); ID1 = __builtin_bit_cast(bf16x8, w1); }
    { float betaR[16];
#pragma unroll
      for (int jt = 0; jt < 4; ++jt) *(f32x4*)(&betaR[4 * jt]) = *(const LAS f32x4*)(tbeta + 16 * jt + 4 * g);
#pragma unroll
      for (int s4 = 0; s4 < 4; ++s4) { bf16x8 Vfs[4];
          { float y[4][8]; conv_rows_s4(PROJb, cwb, n, h, 2, s4, c16, xoff, woff, y);
#pragma unroll
            for (int it = 0; it < 4; ++it) Vfs[it] = __builtin_bit_cast(bf16x8, pack8(y[it])); }
#pragma unroll
        for (int par = 0; par < 2; ++par) { const int dvt = 2 * s4 + par; const bf16x8 ID = par ? ID1 : ID0;
          f32x4 Vc[4];
#pragma unroll
          for (int jt = 0; jt < 4; ++jt) { Vc[jt] = mma(Vfs[jt], ID, Z4);
#pragma unroll
              for (int r = 0; r < 4; ++r) Vc[jt][r] *= betaR[4 * jt + r]; }
          bf16x8 B2F[2] = {pack2(Vc[0], Vc[1]), pack2(Vc[2], Vc[3])};
          f32x4 Uc[4];
#pragma unroll
          for (int it = 0; it < 4; ++it) { f32x4 acc = Z4;
#pragma unroll
              for (int s = 0; s < 2; ++s) acc = mma(TF[it][s], B2F[s], acc);
              Uc[it] = acc; *(u32x2*)(OPQ(ub) + (OFF_UF + (dvt * 4 + it) * 512) + lane8) = pack4(acc); }
          bf16x8 UB[2] = {pack2(Uc[0], Uc[1]), pack2(Uc[2], Uc[3])};
#pragma unroll
          for (int it = 0; it < 4; ++it) { f32x4 acc = Z4;
#pragma unroll
              for (int s = 0; s < 2; ++s) acc = mma(AF[it][s], UB[s], acc);
              *(u32x2*)(OPQ(ub) + (OFF_OF + (dvt * 4 + it) * 512) + lane8) = pack4(acc); }
          asm volatile("" ::: "memory"); } } }
    LDS_WAIT();
    *flag = 0u;
}
__device__ __forceinline__ void scan_head(const Ctx& c, int h) {
    unsigned char* ws = c.ws; const int lane = c.lane, ns = c.wave; const unsigned lane16 = (unsigned)lane * 16u, lane8 = (unsigned)lane * 8u;
    const float* GL = (const float*)(ws + WS_GL);
    const f32x4 Z4 = {0.f, 0.f, 0.f, 0.f};
    f32x4 Sc[8]; bf16x8 SB[4];
#pragma unroll
    for (int m = 0; m < 8; ++m) Sc[m] = Z4;
#pragma unroll
    for (int s = 0; s < 4; ++s) SB[s] = pack2(Z4, Z4);
    const unsigned char* base = ws + WS_DNF + (size_t)h * UNIT_BYTES;
    LAS unsigned char* lds = c.lds;
#define SCAN_DMA(n_, b_) do { const unsigned char* ug_ = OPQ(base + (size_t)(n_) * (DNH * UNIT_BYTES)); _Pragma("unroll") for (int i_ = 0; i_ < 6; ++i_) \
        __builtin_amdgcn_global_load_lds((const unsigned*)(ug_ + (ns * 6 + i_) * 1024 + lane16), (LAS unsigned*)(lds + (b_) * 49152 + (ns * 6 + i_) * 1024), 16, 0, 0); } while (0)
#define SCAN_UO(n_, U_, O_) do { const unsigned char* ug_ = OPQ(base + (size_t)(n_) * (DNH * UNIT_BYTES)); _Pragma("unroll") for (int it = 0; it < 4; ++it) { \
        U_[it] = *(const u32x2*)(ug_ + (OFF_UF + (ns * 4 + it) * 512) + lane8); O_[it] = *(const u32x2*)(ug_ + (OFF_OF + (ns * 4 + it) * 512) + lane8); } } while (0)
#define SCAN_STEP(n_, b_, U_, O_, GL_, UN_, ON_, GLN_) do { const int nn_ = (n_) + 1 < S / 64 ? (n_) + 1 : (n_); \
        __builtin_amdgcn_s_waitcnt(0x0F70);                         \
        asm volatile("" ::: "memory"); \
        __builtin_amdgcn_s_barrier();                               \
        asm volatile("" ::: "memory"); \
        if ((n_) + 1 < S / 64) SCAN_DMA((n_) + 1, (b_) ^ 1); \
        SCAN_UO(nn_, UN_, ON_); GLN_ = GL[nn_ * DNH + h];           \
        const LAS unsigned char* fb = lds + (b_) * 49152 + lane16; \
        unsigned char* ob = OPQ(ws + WS_ODNRAW2 + ((size_t)(64 * (n_)) * 1024 + h * 128 + 16 * ns) * 4); int ln_ = lane; asm volatile("" : "+v"(ln_)); const unsigned lo_ = (unsigned)(4 * (ln_ >> 4) * 1024 + (ln_ & 15)) * 4u; \
        _Pragma("unroll") for (int it = 0; it < 4; ++it) { f32x4 acc = unpack4(O_[it]);                  \
            _Pragma("unroll") for (int s4 = 0; s4 < 4; ++s4) acc = mma(*(const LAS bf16x8*)(fb + OFF_QF + (it * 4 + s4) * 1024), SB[s4], acc); \
            _Pragma("unroll") for (int r = 0; r < 4; ++r) *(float*)(ob + (size_t)(16 * it + r) * 4096 + lo_) = acc[r]; } \
        f32x4 R[4]; \
        _Pragma("unroll") for (int it = 0; it < 4; ++it) { f32x4 acc = Z4; \
            _Pragma("unroll") for (int s4 = 0; s4 < 4; ++s4) acc = mma(*(const LAS bf16x8*)(fb + OFF_WF + (it * 4 + s4) * 1024), SB[s4], acc); \
            R[it] = unpack4(U_[it]) - acc; } \
        const bf16x8 RB0 = pack2(R[0], R[1]), RB1 = pack2(R[2], R[3]); \
        _Pragma("unroll") for (int m = 0; m < 8; ++m) { f32x4 acc = Sc[m] * GL_; acc = mma(*(const LAS bf16x8*)(fb + OFF_KF + (m * 2) * 1024), RB0, acc); acc = mma(*(const LAS bf16x8*)(fb + OFF_KF + (m * 2 + 1) * 1024), RB1, acc); Sc[m] = acc; } \
        _Pragma("unroll") for (int s = 0; s < 4; ++s) SB[s] = pack2(Sc[2 * s], Sc[2 * s + 1]); } while (0)
    u32x2 Ua[4], Oa[4], Ub[4], Ob[4]; float gla, glb;
    SCAN_DMA(0, 0); SCAN_UO(0, Ua, Oa); gla = GL[h];
    for (int n = 0; n < S / 64; n += 2) {
        SCAN_STEP(n, 0, Ua, Oa, gla, Ub, Ob, glb);
        SCAN_STEP(n + 1, 1, Ub, Ob, glb, Ua, Oa, gla);
    }
    asm volatile("s_waitcnt vmcnt(0)" ::: "memory");
#undef SCAN_STEP
#undef SCAN_DMA
#undef SCAN_UO
}
#undef LOAD_GC
}

__device__ __forceinline__ void p_dn_vside(const Ctx& c, int layer) {
    for (int u = c.bx * 4 + c.wave - 4; u < (S / 64) * DNH; u += c.G * 4) { Ctx cu = c; asm volatile("" : "+v"(cu.lane)); dn::v_side(cu, c.lds + (c.wave - 4) * 16384, c.lds + c.wave * 16384, (volatile LAS unsigned*)(c.lds + MISC_OFF + 640) + (c.wave - 4), u >> 3, u & 7, layer); }
}
__device__ __forceinline__ void p_dn_intra(const Ctx& c, int layer) {
    LAS unsigned char* wl = c.lds + c.wave * 16384;
    for (int u = c.bx * 4 + c.wave; u < (S / 64) * DNH; u += c.G * 4) { Ctx cu = c; asm volatile("" : "+v"(cu.lane)); dn::intra_unit(cu, wl, c.lds + (c.wave + 4) * 16384, (volatile LAS unsigned*)(c.lds + MISC_OFF + 640) + c.wave, u >> 3, u & 7, layer); }
}

constexpr int PKN = 32;
__device__ __forceinline__ unsigned fkey(float f) { const unsigned b = __float_as_uint(f); return b ^ ((unsigned)((int)b >> 31) | 0x80000000u); }
__device__ __forceinline__ void p_select(const Ctx& c, const int layer) {
    unsigned char* ws = c.ws;
    const bf16_t* PROJ = (const bf16_t*)(ws + WS_PROJ); const bf16_t* KIX = (const bf16_t*)(ws + WS_KIX); const float* WIX = (const float*)(ws + WS_WIX);
    unsigned* MASK = (unsigned*)(ws + WS_MASK);
    LAS float* SC = (LAS float*)c.lds;
    const int nunits = S / 4;
    unsigned* ctr = (unsigned*)(ws + WS_CTL) + CW_SELQ + layer * 64;
    LAS int* nx = (LAS int*)(c.lds + MISC_OFF + 512);
    const bool scorer = c.wave >= 4;
    auto score_unit = [&](int tk) {
        const int r = c.lane & 31, hi = c.lane >> 5, sw = c.wave - 4;
        const int u = nunits - 1 - tk, t0 = u * 4, ntile = (t0 + 4 + 31) >> 5;
        bf16x8 A[2][4]; h2_t wq[2][8];
#pragma unroll
        for (int m = 0; m < 2; ++m) { const int tq = t0 + 2 * m + ((r >> 2) & 1), hd = (r & 3) + 4 * (r >> 3);
#pragma unroll
            for (int s = 0; s < 4; ++s) A[m][s] = *(const bf16x8*)(PROJ + (size_t)tq * NPB + PC_QIX + hd * 64 + 16 * s + 8 * hi);
            const float* wp = WIX + (size_t)(t0 + 2 * m + hi) * 16;
#pragma unroll
            for (int q4 = 0; q4 < 4; ++q4) { const f32x4 wv = *(const f32x4*)(wp + 4 * q4); wq[m][2 * q4] = __builtin_bit_cast(h2_t, __builtin_amdgcn_cvt_pkrtz(wv[0], wv[1])); wq[m][2 * q4 + 1] = __builtin_bit_cast(h2_t, __builtin_amdgcn_cvt_pkrtz(wv[2], wv[3])); } }
        const bf16_t* kb = KIX + (size_t)r * 64 + 8 * hi;
        bf16x8 B0[4], B1[4], B2[4];
        int tl = sw;
#define LDB(dst, t_) do { const int tt_ = (t_) < ntile ? (t_) : ntile - 1; _Pragma("unroll") for (int s = 0; s < 4; ++s) dst[s] = *(const bf16x8*)(kb + (size_t)tt_ * 2048 + 16 * s); } while (0)
        asm volatile("" ::: "memory"); LDB(B0, tl); asm volatile("" ::: "memory"); LDB(B1, tl + 4); asm volatile("" ::: "memory"); LDB(B2, tl + 8); asm volatile("" ::: "memory");
#define SC_STEP(BX) do { const int key = (tl < ntile ? tl : ntile - 1) * 32 + r;     \
            _Pragma("unroll") for (int m = 0; m < 2; ++m) { f32x16 acc = {}; \
                _Pragma("unroll") for (int s = 0; s < 4; ++s) acc = __builtin_amdgcn_mfma_f32_32x32x16_bf16(A[m][s], BX[s], acc, 0, 0, 0); \
                float sc = 0.f; const h2_t hz = {(_Float16)0, (_Float16)0}; \
                _Pragma("unroll") for (int e = 0; e < 8; ++e) { h2_t x = __builtin_bit_cast(h2_t, __builtin_amdgcn_cvt_pkrtz(acc[2 * e], acc[2 * e + 1])); x = __builtin_elementwise_max(x, hz); sc = __builtin_amdgcn_fdot2(x, wq[m][e], sc, false); } \
                const int tq = t0 + 2 * m + hi; \
                ((LAS unsigned*)SC)[(2 * m + hi) * 8192 + key] = key <= tq ? fkey(sc) : 0u; } \
            __builtin_amdgcn_sched_barrier(0); LDB(BX, tl + 12); __builtin_amdgcn_sched_barrier(0); tl += 4; } while (0)
        while (tl < ntile) { SC_STEP(B0); SC_STEP(B1); SC_STEP(B2); }
        { const int Rz = ntile * 32, Rg = (Rz + 1023) & ~1023;
          for (int kk = Rz + c.lane; kk < Rg; kk += 64) ((LAS unsigned*)SC)[sw * 8192 + kk] = 0u; }
#undef SC_STEP
#undef LDB
    };
    if (c.tid == 0) { nx[0] = (int)__hip_atomic_fetch_add(ctr, 1u, __ATOMIC_RELAXED, __HIP_MEMORY_SCOPE_AGENT); nx[1] = (int)__hip_atomic_fetch_add(ctr, 1u, __ATOMIC_RELAXED, __HIP_MEMORY_SCOPE_AGENT); }
    __syncthreads();
    int tcur = nx[0];
    if (scorer) {
        if (tcur < nunits) score_unit(tcur);
        __syncthreads();
        for (int k = 0; tcur < nunits; ++k) { const int tnext = nx[(k + 1) & 1]; __syncthreads(); if (tnext < nunits) score_unit(tnext); __syncthreads(); tcur = tnext; }
    } else {
        __syncthreads();
        for (int k = 0; tcur < nunits; ++k) {
        const int tnext = nx[(k + 1) & 1];
        const int u = nunits - 1 - tcur, t0 = u * 4, ntile = (t0 + 4 + 31) >> 5;
        int ln = c.lane; asm volatile("" : "+v"(ln));
        const int q = c.wave & 3, tq = t0 + q, n = tq + 1, R = ntile * 32;
        unsigned key[128];
        { const LAS unsigned* sq = (const LAS unsigned*)SC + q * 8192 + ln;
#pragma unroll
            for (int gq = 0; gq < 8; ++gq) {
                if (gq * 1024 < R) {
#pragma unroll
                    for (int jj = 0; jj < 16; ++jj) key[gq * 16 + jj] = sq[(gq * 16 + jj) * 64];
                    __builtin_amdgcn_sched_barrier(0); }
                else {
#pragma unroll
                    for (int jj = 0; jj < 16; ++jj) key[gq * 16 + jj] = 0u; } }
            LDS_WAIT(); }
        __syncthreads();
        unsigned tk2 = 0u; if (c.tid == 0) tk2 = __hip_atomic_fetch_add(ctr, 1u, __ATOMIC_RELAXED, __HIP_MEMORY_SCOPE_AGENT);
        {
#define CNT_ALL(OP, V) ({ int c0_ = 0, c1_ = 0, c2_ = 0, c3_ = 0; _Pragma("unroll") for (int gq_ = 0; gq_ < 8; ++gq_) if (gq_ * 1024 < R) { _Pragma("unroll") for (int jj_ = 0; jj_ < 16; jj_ += 4) { \
    c0_ += (key[gq_ * 16 + jj_] OP (V)) ? 1 : 0; c1_ += (key[gq_ * 16 + jj_ + 1] OP (V)) ? 1 : 0; c2_ += (key[gq_ * 16 + jj_ + 2] OP (V)) ? 1 : 0; c3_ += (key[gq_ * 16 + jj_ + 3] OP (V)) ? 1 : 0; } } wave_isum((c0_ + c1_) + (c2_ + c3_)); })
#define CNT_CK(OP, V) ({ int c0_ = 0, c1_ = 0; _Pragma("unroll") for (int jj_ = 0; jj_ < 8; jj_ += 2) { c0_ += (ck[jj_] OP (V)) ? 1 : 0; c1_ += (ck[jj_ + 1] OP (V)) ? 1 : 0; } wave_isum(c0_ + c1_); })
            unsigned thr = 0u; int need_eq = 0; bool simple = true;
            if (n > TOPK) {
                u16x2_t pk[PKN];
#define PK_OF(i_) __builtin_bit_cast(u16x2_t, __builtin_amdgcn_perm(key[2 * (i_) + 1], key[2 * (i_)], sel_))
#pragma unroll
                for (int i = 0; i < PKN; ++i) { const unsigned sel_ = 0x07060302u; pk[i] = PK_OF(i); }
#define PK_GE(x_) ({ u16x2_t t_; asm("v_pk_sub_u16 %0, %1, %2 clamp\n\tv_pk_min_u16 %0, %0, %3" : "=&v"(t_) : "v"(x_), "s"(cv_), "s"(one_)); t_; })
#define PK_AT(i_) ((i_) < PKN ? pk[(i_) < PKN ? (i_) : 0] : PK_OF(i_))
#define CNT_PK(C16) ({ unsigned sel_ = 0x07060302u; asm volatile("" : "+s"(sel_));     \
    const unsigned cv_ = ((unsigned)(C16) - 1u) * 0x10001u, one_ = 0x10001u; u16x2_t a0_ = {0, 0}, a1_ = {0, 0}; \
    _Pragma("unroll") for (int gq_ = 0; gq_ < 8; ++gq_) if (gq_ * 1024 < R) { _Pragma("unroll") for (int jj_ = 0; jj_ < 8; jj_ += 2) { \
        a0_ += PK_GE(PK_AT(gq_ * 8 + jj_)); a1_ += PK_GE(PK_AT(gq_ * 8 + jj_ + 1)); } } \
    const unsigned s_ = __builtin_bit_cast(unsigned, a0_ + a1_); wave_isum((int)((s_ & 0xffffu) + (s_ >> 16))); })
                for (int bit = 31; bit >= 16; --bit) { const unsigned cand = thr | (1u << bit); if (CNT_PK(cand >> 16) >= TOPK) thr = cand; }
                const unsigned P = thr >> 16; const int c_hi = P == 0xFFFFu ? 0 : CNT_PK(P + 1u);
#undef CNT_PK
#undef PK_AT
#undef PK_OF
#undef PK_GE
                LAS unsigned* cl = (LAS unsigned*)(c.lds + DN_TAB_OFF + q * 2048); int nb = 0;
#pragma unroll
                for (int gq = 0; gq < 8; ++gq) if (gq * 1024 < R) {
#pragma unroll
                    for (int jj = 0; jj < 16; ++jj) { const unsigned kv = key[gq * 16 + jj]; const bool inb = (kv >> 16) == P && kv != 0u; const unsigned long long m = __ballot(inb);
                        if (inb) { const int o = nb + (int)__builtin_amdgcn_mbcnt_hi((unsigned)(m >> 32), __builtin_amdgcn_mbcnt_lo((unsigned)m, 0u)); if (o < 512) cl[o] = kv; } nb += __popcll(m); } }
                LDS_WAIT();
                if (nb <= 512) { unsigned ck[8];
#pragma unroll
                    for (int jj = 0; jj < 8; ++jj) ck[jj] = (jj * 64 + ln) < nb ? cl[jj * 64 + ln] : 0u;
                    for (int bit = 15; bit >= 0; --bit) { const unsigned cand = thr | (1u << bit); if (c_hi + CNT_CK(>=, cand) >= TOPK) thr = cand; }
                    need_eq = TOPK - (c_hi + CNT_CK(>, thr)); simple = CNT_CK(==, thr) == need_eq; }
                else {
                    for (int bit = 15; bit >= 0; --bit) { const unsigned cand = thr | (1u << bit); if (CNT_ALL(>=, cand) >= TOPK) thr = cand; }
                    need_eq = TOPK - CNT_ALL(>, thr); simple = CNT_ALL(==, thr) == need_eq; }
            }
            int tie_seen = 0; int mA0 = 0, mA1 = 0, mB0 = 0, mB1 = 0;
#pragma unroll
            for (int gq = 0; gq < 8; ++gq) if (gq * 1024 < R) {
#pragma unroll
                for (int jj = 0; jj < 16; ++jj) { const int j = gq * 16 + jj, kk = j * 64 + ln; bool sel;
                    if (n <= TOPK) sel = kk < n;
                    else if (simple) sel = key[j] >= thr;
                    else { const unsigned ku = key[j]; const bool inr = true; const bool tie = ku == thr; const unsigned long long tm = __ballot(tie);
                        const int rank = tie_seen + __popcll(tm & ((1ull << ln) - 1ull)); sel = inr && ((ku > thr) || (tie && rank < need_eq)); tie_seen += __popcll(tm); }
                    const unsigned long long bm = __ballot(sel);
                    if (j < 64) { const bool me = ln == j; mA0 = me ? (int)(unsigned)bm : mA0; mA1 = me ? (int)(unsigned)(bm >> 32) : mA1; }
                    else { const bool me = ln == j - 64; mB0 = me ? (int)(unsigned)bm : mB0; mB1 = me ? (int)(unsigned)(bm >> 32) : mB1; } } }
#undef CNT_ALL
#undef CNT_CK
            unsigned* mrow = MASK + ((size_t)(tq >> 5) * 128 * 32 + (tq & 31)) * 2;
            { u32x2 w; w.x = (unsigned)mA0; w.y = (unsigned)mA1; *(u32x2*)(mrow + (size_t)ln * 64) = w; w.x = (unsigned)mB0; w.y = (unsigned)mB1; *(u32x2*)(mrow + (size_t)(64 + ln) * 64) = w; }
        }
        if (c.tid == 0) nx[k & 1] = (int)tk2;
        __syncthreads();
        tcur = tnext;
        }
    }
}

__device__ __forceinline__ void p_attn_naive(const Ctx& c) {
    unsigned char* ws = c.ws;
    const bf16_t* PROJ = (const bf16_t*)(ws + WS_PROJ); const unsigned* MASK = (const unsigned*)(ws + WS_MASK); bf16_t* OSA = (bf16_t*)(ws + WS_OSA);
    LAS int* idx = (LAS int*)c.lds;
    LAS int* wtot = (LAS int*)(c.lds + 4096);
    LAS float* lg = (LAS float*)(c.lds + 8192) + c.wave * 512;
    const int h = c.wave, g4 = c.lane >> 4, li = c.lane & 15;
    for (int t = c.bx; t < S; t += c.G) {
        int cntw = 0; unsigned wbits = 0;
        if (c.tid < 256) { wbits = MASK[(size_t)t * 256 + c.tid]; cntw = __popc(wbits); }
        int incl = cntw;
#pragma unroll
        for (int o = 1; o < 64; o <<= 1) { const int y = __shfl_up(incl, o); if (c.lane >= o) incl += y; }
        if (c.tid < 256 && c.lane == 63) wtot[c.wave] = incl;
        __syncthreads();
        int base = 0, nsel = wtot[0] + wtot[1] + wtot[2] + wtot[3];
        for (int w = 0; w < 4; ++w) if (w < c.wave) base += wtot[w];
        if (c.tid < 256) { int pos = base + incl - cntw; unsigned b = wbits; while (b) { const int bit = __builtin_ctz(b); b &= b - 1; if (pos < 512) idx[pos] = c.tid * 32 + bit; ++pos; } }
        __syncthreads();
        if (nsel > 512) nsel = 512;
        float q[8]; unpack8(*(const u32x4*)(PROJ + (size_t)t * NPB + PC_QSA + h * 128 + li * 8), q);
#pragma unroll
        for (int e = 0; e < 8; ++e) q[e] *= 0.08838834764831845f;
        float mx = -__builtin_inff();
        for (int j0 = 0; j0 < nsel; j0 += 16) {
            float d[4];
#pragma unroll
            for (int uu = 0; uu < 4; ++uu) { const int j = j0 + uu * 4 + g4; d[uu] = 0.f;
                if (j < nsel) { float k[8]; unpack8(*(const u32x4*)(PROJ + (size_t)idx[j] * NPB + PC_KSA + h * 128 + li * 8), k);
#pragma unroll
                    for (int e = 0; e < 8; ++e) d[uu] += q[e] * k[e]; } }
#pragma unroll
            for (int uu = 0; uu < 4; ++uu) { const int j = j0 + uu * 4 + g4; const float dd = row16_sum(d[uu]); if (j < nsel) { if (li == 0) lg[j] = dd; mx = fmaxf(mx, dd); } }
        }
        mx = wave_max(mx);
        LDS_WAIT();
        float o[8], den = 0.f;
#pragma unroll
        for (int e = 0; e < 8; ++e) o[e] = 0.f;
        for (int j0 = 0; j0 < nsel; j0 += 16) {
#pragma unroll
            for (int uu = 0; uu < 4; ++uu) { const int j = j0 + uu * 4 + g4;
                if (j < nsel) { const float pj = __expf(lg[j] - mx); den += pj; float v[8]; unpack8(*(const u32x4*)(PROJ + (size_t)idx[j] * NPB + PC_VSA + h * 128 + li * 8), v);
#pragma unroll
                    for (int e = 0; e < 8; ++e) o[e] += pj * v[e]; } }
        }
        den += __shfl_xor(den, 16); den += __shfl_xor(den, 32);
#pragma unroll
        for (int e = 0; e < 8; ++e) { o[e] += __shfl_xor(o[e], 16); o[e] += __shfl_xor(o[e], 32); }
        const float rd = 1.f / den;
#pragma unroll
        for (int e = 0; e < 8; ++e) o[e] *= rd;
        if (g4 == 0) *(u32x4*)(OSA + (size_t)t * 1024 + h * 128 + li * 8) = pack8(o);
        __syncthreads();
    }
}


namespace att {
constexpr int NW = 8, QBLK = 32, KVBLK = 64, QB = NW * QBLK, D = 128;
constexpr int SHM_V = KVBLK * D * 2, SHM_K = KVBLK * D * 2;
constexpr int LDS_NEED = 2 * SHM_V + 2 * SHM_K + NW * 64 * 4;
constexpr int PITCH = NPB, OPITCH = 128;
constexpr float SCALE = 0.08838834764831845f, THR = 8.f;
typedef short s16x4 __attribute__((ext_vector_type(4)));
#define KSWZ(row, colB) ((row) * 256 + ((colB) ^ (((row) & 7) << 4)))
#define SBAR() __builtin_amdgcn_sched_barrier(0)
__device__ __forceinline__ int v_st(int k, int c) { const int kk = (k & ~0xC) | ((k & 4) << 1) | ((k & 8) >> 1); return ((kk >> 3) * 4 + (c >> 5)) * 512 + ((kk & 7) * 32 + (c & 31)) * 2; }
__device__ __forceinline__ int v_rd_base(int lane) { return ((lane & 3) << 3) | (((lane >> 2) & 3) << 6) | (((lane >> 4) & 1) << 5) | (((lane >> 5) & 1) << 8); }
constexpr int v_rd_off(int d0, int ks, int half) { return d0 * 512 + ks * 4096 + half * 2048; }
__device__ __forceinline__ int crow(int r, int hi) { return (r & 3) + 8 * (r >> 2) + 4 * hi; }
__device__ __forceinline__ void partialSM(f32x16& p0, f32x16& p1, float& m_reg, float& mn, float& alpha) {
    float pmax = p0[0]; for (int r = 1; r < 16; ++r) pmax = fmaxf(pmax, p0[r]); for (int r = 0; r < 16; ++r) pmax = fmaxf(pmax, p1[r]);
    { auto rr = __builtin_amdgcn_permlane32_swap(__float_as_uint(pmax), __float_as_uint(pmax), false, false);
      pmax = fmaxf(__uint_as_float(rr[0]), __uint_as_float(rr[1])); }
    constexpr float C2 = 1.4426950408889634f * SCALE;
    if (__builtin_expect(__all((pmax - m_reg) * SCALE <= THR), 1)) { mn = m_reg; alpha = 1.f; }
    else { mn = fmaxf(m_reg, pmax); alpha = __builtin_amdgcn_exp2f((m_reg - mn) * C2); m_reg = mn; }
    const float mnL = -mn * C2;
    for (int r = 0; r < 16; ++r) p0[r] = fmaf(p0[r], C2, mnL); for (int r = 0; r < 16; ++r) p1[r] = fmaf(p1[r], C2, mnL);
    for (int r = 0; r < 16; ++r) p0[r] = __builtin_amdgcn_exp2f(p0[r]);
}
__device__ __forceinline__ void finishSM(f32x16& p0, f32x16& p1, float alpha, float& l_reg, bf16x8& pa0, bf16x8& pa1, bf16x8& pa2, bf16x8& pa3) {
    for (int r = 0; r < 16; ++r) p1[r] = __builtin_amdgcn_exp2f(p1[r]);
    float ps = 0; for (int r = 0; r < 16; ++r) ps += p0[r]; for (int r = 0; r < 16; ++r) ps += p1[r];
    { auto rr = __builtin_amdgcn_permlane32_swap(__float_as_uint(ps), __float_as_uint(ps), false, false);
      ps = __uint_as_float(rr[0]) + __uint_as_float(rr[1]); }
    l_reg = l_reg * alpha + ps;
#define PK4(P, B_, OUT) do { unsigned a0 = cvt_pk_bf16_asm(P[B_+0], P[B_+1]), a1 = cvt_pk_bf16_asm(P[B_+2], P[B_+3]);                          \
        unsigned b0 = cvt_pk_bf16_asm(P[B_+4], P[B_+5]), b1 = cvt_pk_bf16_asm(P[B_+6], P[B_+7]);                                             \
        auto r0 = __builtin_amdgcn_permlane32_swap(a0, b0, false, false); auto r1 = __builtin_amdgcn_permlane32_swap(a1, b1, false, false); \
        u32x4 w = {r0[0], r1[0], r0[1], r1[1]}; OUT = *reinterpret_cast<bf16x8*>(&w); } while (0)
    PK4(p0, 0, pa0); PK4(p0, 8, pa1); PK4(p1, 0, pa2); PK4(p1, 8, pa3);
#undef PK4
}
__device__ __forceinline__ void mask_init(f32x16& p0, f32x16& p1, u32x2 mw, int hi) {
    const int i0 = (int)~(mw.x >> (4 * hi)), i1 = (int)~(mw.y >> (4 * hi));
#pragma unroll
    for (int r = 0; r < 16; ++r) { const unsigned c = (r & 3) + 8 * (r >> 2);
        p0[r] = __uint_as_float((unsigned)__builtin_amdgcn_sbfe(i0, c, 1u) & 0xFF800000u);
        p1[r] = __uint_as_float((unsigned)__builtin_amdgcn_sbfe(i1, c, 1u) & 0xFF800000u); }
}
template <int KB>
__device__ __forceinline__ void qkt(f32x16& p0, f32x16& p1, const LAS char* K_lds, int r32, int hi, const bf16x8* qr, u32x2 mw) {
    mask_init(p0, p1, mw, hi);
    const LAS char* kb[4];
#pragma unroll
    for (int dd = 0; dd < 4; ++dd) kb[dd] = K_lds + KB * SHM_K + KSWZ(r32, (dd * 16 + hi * 8) * 2);
#pragma unroll
    for (int d0 = 0; d0 < 8; ++d0) { const LAS char* a = kb[d0 & 3] + (d0 >> 2) * 128;
        bf16x8 b0 = *(const LAS bf16x8*)(a);
        bf16x8 b1 = *(const LAS bf16x8*)(a + 32 * 256);
        p0 = __builtin_amdgcn_mfma_f32_32x32x16_bf16(b0, qr[d0], p0, 0, 0, 0);
        p1 = __builtin_amdgcn_mfma_f32_32x32x16_bf16(b1, qr[d0], p1, 0, 0, 0); }
}
template <int VB>
__device__ __forceinline__ void pv_tile(f32x16* o, int vb0, bf16x8 pa0, bf16x8 pa1, bf16x8 pa2, bf16x8 pa3) {
#define TRRD(dst, off) asm volatile("ds_read_b64_tr_b16 %0, %1 offset:%2" : "=&v"(dst) : "v"(vb0), "i"(off) : "memory")
#define PV_D0(d0) do { s16x4 l0, l1, l2, l3, h0, h1, h2, h3; constexpr int b_ = VB * SHM_V + v_rd_off(d0, 0, 0); \
        TRRD(l0, b_); TRRD(h0, b_ + 2048); TRRD(l1, b_ + 4096); TRRD(h1, b_ + 6144); TRRD(l2, b_ + 8192); TRRD(h2, b_ + 10240); TRRD(l3, b_ + 12288); TRRD(h3, b_ + 14336); \
        asm volatile("s_waitcnt lgkmcnt(0)" ::: "memory"); SBAR();   \
        o[d0] = __builtin_amdgcn_mfma_f32_32x32x16_bf16(pa0, (bf16x8){l0[0], l0[1], l0[2], l0[3], h0[0], h0[1], h0[2], h0[3]}, o[d0], 0, 0, 0);   \
        o[d0] = __builtin_amdgcn_mfma_f32_32x32x16_bf16(pa1, (bf16x8){l1[0], l1[1], l1[2], l1[3], h1[0], h1[1], h1[2], h1[3]}, o[d0], 0, 0, 0);   \
        o[d0] = __builtin_amdgcn_mfma_f32_32x32x16_bf16(pa2, (bf16x8){l2[0], l2[1], l2[2], l2[3], h2[0], h2[1], h2[2], h2[3]}, o[d0], 0, 0, 0);   \
        o[d0] = __builtin_amdgcn_mfma_f32_32x32x16_bf16(pa3, (bf16x8){l3[0], l3[1], l3[2], l3[3], h3[0], h3[1], h3[2], h3[3]}, o[d0], 0, 0, 0); } while (0)
    PV_D0(0); PV_D0(1); PV_D0(2); PV_D0(3);
#undef PV_D0
#undef TRRD
}
struct BlockRef { const char* Q; const char* K; bf16_t* O; float* ML; const char* M; int NT; };
struct Seam { bf16x8 qr[8]; bf16x8 st_v0, st_v1, st_k0, st_k1; };
constexpr int VOFFB = (PC_VSA - PC_KSA) * 2;
#define VMW() asm volatile("s_waitcnt vmcnt(0)" ::: "memory")
#define VMWN(n) asm volatile("s_waitcnt vmcnt(%0)" :: "i"(n) : "memory")
#define LD8(p) (*reinterpret_cast<const bf16x8*>(p))
#define KVB(t) (Kh + (size_t)(t) * (KVBLK * PITCH * 2))
#define SLOAD_H(kvb) do { const char* b_ = (kvb); S.st_v0 = LD8(b_ + VOFFB + koff0); S.st_v1 = LD8(b_ + VOFFB + koff1); S.st_k0 = LD8(b_ + koff0); S.st_k1 = LD8(b_ + koff1); } while (0)
#define SWRITE_HK(bf) do { *(LAS bf16x8*)(K_lds + (bf) * SHM_K + kws) = S.st_k0; *(LAS bf16x8*)(K_lds + (bf) * SHM_K + kws + 32 * 256) = S.st_k1; } while (0)
#define SWRITE_HV(bf) do { *(LAS bf16x8*)(V_lds + (bf) * SHM_V + vst0) = S.st_v0; *(LAS bf16x8*)(V_lds + (bf) * SHM_V + vst1) = S.st_v1; } while (0)
#define SWRITE_H(bf) do { SWRITE_HV(bf); SWRITE_HK(bf); } while (0)
#define MLOAD(t) (*(const u32x2*)(cur.M + (size_t)(t) * 256 + moff))
__device__ __forceinline__ void prime(const BlockRef& cur, LAS char* lds, Seam& S, int tid) {
    const int wid = __builtin_amdgcn_readfirstlane(tid >> 6), lane = tid & 63, r32 = lane & 31, hi = lane >> 5;
    const int sr = tid >> 4, sc = (tid & 15) * 8, kws = KSWZ(sr, sc * 2); LAS char* K_lds = lds + 2 * SHM_V;
    const unsigned koff0 = (unsigned)(sr * PITCH + sc) * 2u, koff1 = (unsigned)((32 + sr) * PITCH + sc) * 2u, qoff = (unsigned)((wid * QBLK + r32) * PITCH + hi * 8) * 2u;
    for (int d0 = 0; d0 < 8; ++d0) S.qr[d0] = LD8(cur.Q + qoff + d0 * 32);
    const char* Kh = cur.K;
    SLOAD_H(KVB(0)); VMW(); SWRITE_HK(0);
    __syncthreads();
}
__device__ __forceinline__ void block(const BlockRef& cur, const BlockRef& nxt, LAS char* lds, Seam& S, int tid) {
    const int wid = __builtin_amdgcn_readfirstlane(tid >> 6), lane = tid & 63, r32 = lane & 31, hi = lane >> 5;
    const int NT = cur.NT;
    LAS char* V_lds = lds; LAS char* K_lds = lds + 2 * SHM_V;
    LAS float* wsf = (LAS float*)(lds + 2 * SHM_V + 2 * SHM_K) + wid * 64; LAS float* al_l = wsf + 32;
    float m_reg = -1e30f, l_reg = 0; f32x16 o[4] = {};
    const int sr = tid >> 4, sc = (tid & 15) * 8, vst0 = v_st(sr, sc), vst1 = v_st(32 + sr, sc), kws = KSWZ(sr, sc * 2);
    const unsigned koff0 = (unsigned)(sr * PITCH + sc) * 2u, koff1 = (unsigned)((32 + sr) * PITCH + sc) * 2u, qoff = (unsigned)((wid * QBLK + r32) * PITCH + hi * 8) * 2u;
    const unsigned moff = (unsigned)(wid * (128 * 64 * 4) + r32 * 8);
    const int vb0 = (int)(unsigned)(unsigned long long)V_lds + v_rd_base(lane);
    const char* Kh = cur.K;
#define RESC(a) do { if (__any((a) < 1.f)) { if (hi == 0) al_l[r32] = (a); asm volatile("s_waitcnt lgkmcnt(0)" ::: "memory");              \
                     for (int d_ = 0; d_ < 4; ++d_) for (int r = 0; r < 16; ++r) o[d_][r] *= al_l[crow(r, hi)]; } } while (0)
    constexpr int NQL = 8;
#define SEAM_K0() do { VMWN(NQL); SWRITE_HK(0); SBAR(); } while (0)
    f32x16 pA0, pA1, pB0, pB1; float mnA, mnB, alA, alB; bf16x8 pa0, pa1, pa2, pa3;
    u32x2 mw = MLOAD(0);
    SWRITE_HV(0); SBAR();
    if (NT > 1) SLOAD_H(KVB(1));
    SBAR(); qkt<0>(pA0, pA1, K_lds, r32, hi, S.qr, mw);
    if (NT > 1) mw = MLOAD(1);
    partialSM(pA0, pA1, m_reg, mnA, alA);
    if (NT > 1) { VMWN(1); SWRITE_H(1); }
    __syncthreads();
#define HALF_STEP(PX0, PX1, mnX, alX, PY0, PY1, alY, t, KB, VB, SB) do {                                                      \
        SBAR(); qkt<KB>(PX0, PX1, K_lds, r32, hi, S.qr, mw);                                             \
        finishSM(PY0, PY1, alY, l_reg, pa0, pa1, pa2, pa3); SBAR();                                                           \
        if ((t) + 1 < NT) { SLOAD_H(KVB((t) + 1)); mw = MLOAD((t) + 1); SBAR(); }                                               \
        pv_tile<VB>(o, vb0, pa0, pa1, pa2, pa3); partialSM(PX0, PX1, m_reg, mnX, alX);                                        \
        __syncthreads();                                                                                                      \
        if ((t) + 1 < NT) { VMWN(1); SWRITE_H(SB); }                                                                          \
        RESC(alX); __syncthreads(); } while (0)
    for (int t = 1; t + 1 < NT; t += 2) {
        HALF_STEP(pB0, pB1, mnB, alB, pA0, pA1, alA, t, 1, 0, 0);
        HALF_STEP(pA0, pA1, mnA, alA, pB0, pB1, alB, t + 1, 0, 1, 1);
    }
    const bool even = (NT & 1) == 0;
    if (even) { SBAR(); qkt<1>(pB0, pB1, K_lds, r32, hi, S.qr, mw); SBAR(); }
    { const char* Kh = nxt.K; SLOAD_H(KVB(0)); } SBAR();
#pragma unroll
    for (int d0 = 0; d0 < 8; ++d0) S.qr[d0] = LD8(nxt.Q + qoff + d0 * 32);
    SBAR();
    finishSM(pA0, pA1, alA, l_reg, pa0, pa1, pa2, pa3); SBAR();
    pv_tile<0>(o, vb0, pa0, pa1, pa2, pa3);
    if (even) { partialSM(pB0, pB1, m_reg, mnB, alB); __syncthreads(); RESC(alB);
        finishSM(pB0, pB1, alB, l_reg, pa0, pa1, pa2, pa3); SBAR(); pv_tile<1>(o, vb0, pa0, pa1, pa2, pa3); }
    SBAR(); SEAM_K0();
    int r32e = r32; asm volatile("" : "+v"(r32e));
    if (hi == 0) { f32x2 ml; ml.x = m_reg; ml.y = l_reg; *(f32x2*)((char*)cur.ML + (unsigned)(wid * QBLK + r32e) * 8u) = ml; }
    char* Ow = (char*)cur.O; const unsigned ooff = (unsigned)((wid * QBLK) * OPITCH + r32e) * 2u;
#pragma unroll
    for (int r = 0; r < 16; ++r) { const int orow = crow(r, hi);
#pragma unroll
        for (int d0 = 0; d0 < 4; ++d0) { const float v = o[d0][r];
            const float vn = __shfl_xor(v, 1);
            if ((r32 & 1) == 0) *(unsigned*)(Ow + ooff + (unsigned)(orow * OPITCH + d0 * 32) * 2u) = cvt_pk_bf16_asm(v, vn); } }
    __syncthreads();
#undef RESC
#undef SEAM_K0
#undef HALF_STEP
}
#undef KVB
#undef VMW
#undef VMWN
#undef LD8
#undef SLOAD_H
#undef SWRITE_HK
#undef SWRITE_HV
#undef SWRITE_H
#undef MLOAD
#undef KSWZ
#undef SBAR
}

constexpr int AT_NPARTS = 96;
__constant__ unsigned char AT_SCHED[32][3] = {{159,154,20}, {127,122,47}, {63,58,15}, {121,117,115}, {89,85,83}, {57,53,51}, {25,21,19}, {82,16,78}, {44,79,46}, {12,42,14}, {95,28,41}, {31,155,9}, {158,91,4}, {126,118,77}, {94,86,45}, {62,54,13}, {120,22,40}, {88,80,8}, {56,48,39}, {24,123,10}, {50,59,90}, {18,27,26}, {30,23,7}, {157,81,3}, {125,49,38}, {93,17,6}, {61,43,2}, {29,11,1}, {156,5,0}, {119,124,116}, {87,92,84}, {55,60,52}};
__constant__ unsigned char AT_NPART[32] = {1,1,1,1,1,1,2,2,2,2,2,2,2,3,3,3,3,3,3,4,4,4,4,4,4,4,5,5,5,5,5,5};
__constant__ unsigned char AT_PBASE[32] = {0,1,2,3,4,5,6,8,10,12,14,16,18,20,23,26,29,32,35,38,42,46,50,54,58,62,66,71,76,81,86,91};
constexpr size_t AT_PARTO_BYTES = (size_t)256 * 128 * 2, AT_ML_OFF = (size_t)DNH * AT_NPARTS * AT_PARTO_BYTES;
__device__ __forceinline__ void p_attn(const Ctx& c) {
    unsigned char* ws = c.ws;
    const bf16_t* PROJ = (const bf16_t*)(ws + WS_PROJ); const unsigned* MASKT = (const unsigned*)(ws + WS_MASK);
    const int h = c.bx & 7, slot = c.bx >> 3;
    if (slot >= 32) return;
    auto ref = [&](int j) { const int e = AT_SCHED[slot][j]; const int qb = e & 31, p = e >> 5, np = AT_NPART[qb], nt = 4 * (qb + 1), lo = (p * nt) / np, hi2 = ((p + 1) * nt) / np; att::BlockRef r;
        const size_t pi = (size_t)h * AT_NPARTS + AT_PBASE[qb] + p;
        r.Q = (const char*)(PROJ + (size_t)qb * att::QB * NPB + PC_QSA + h * 128); r.K = (const char*)(PROJ + (size_t)lo * 64 * NPB + PC_KSA + h * 128);
        r.O = (bf16_t*)(ws + WS_DNF + pi * AT_PARTO_BYTES); r.ML = (float*)(ws + WS_DNF + AT_ML_OFF + pi * 2048);
        r.M = (const char*)(MASKT + (size_t)qb * 8 * (128 * 64)) + (size_t)lo * 256; r.NT = hi2 - lo; return r; };
    int nit = 0;
    for (int j = 0; j < 3; ++j) nit += AT_SCHED[slot][j] != 255 ? 1 : 0;
    att::BlockRef cur = ref(0); att::Seam Sm;
    att::prime(cur, (LAS char*)c.lds, Sm, c.tid);
    for (int j = 0; j < nit; ++j) { const bool more = j + 1 < nit; const att::BlockRef nxt = more ? ref(j + 1) : cur;
        att::block(cur, nxt, (LAS char*)c.lds, Sm, c.tid);
        cur = nxt; }
}
__device__ __forceinline__ void p_attn_merge(const Ctx& c) {
    unsigned char* ws = c.ws; bf16_t* OSA = (bf16_t*)(ws + WS_OSA);
    constexpr float C2 = 1.4426950408889634f * att::SCALE;
    for (int u = c.gw; u < DNH * 32 * 32; u += c.NGW) {
        const int rg = u & 31, qb = (u >> 5) & 31, h = u >> 10, np = AT_NPART[qb]; const size_t pi0 = (size_t)h * AT_NPARTS + AT_PBASE[qb];
        const int row = rg * 8 + (c.lane >> 3), cg = (c.lane & 7) * 16;
        float M = -1e30f;
        for (int p = 0; p < np; ++p) M = fmaxf(M, ((const float*)(ws + WS_DNF + AT_ML_OFF + (pi0 + p) * 2048))[2 * row]);
        float acc[16], den = 0.f;
#pragma unroll
        for (int e = 0; e < 16; ++e) acc[e] = 0.f;
        for (int p = 0; p < np; ++p) { const f32x2 ml = *(const f32x2*)(ws + WS_DNF + AT_ML_OFF + (pi0 + p) * 2048 + 8 * row); const float w = __builtin_amdgcn_exp2f((ml.x - M) * C2); den += w * ml.y;
            const bf16_t* op = (const bf16_t*)(ws + WS_DNF + (pi0 + p) * AT_PARTO_BYTES) + row * 128 + cg; float v[16]; unpack8(*(const u32x4*)op, v); unpack8(*(const u32x4*)(op + 8), v + 8);
#pragma unroll
            for (int e = 0; e < 16; ++e) acc[e] += w * v[e]; }
        const float rd = 1.f / den;
#pragma unroll
        for (int e = 0; e < 16; ++e) acc[e] *= rd;
        bf16_t* o = OSA + (size_t)(qb * 256 + row) * 1024 + h * 128 + cg; *(u32x4*)o = pack8(acc); *(u32x4*)(o + 8) = pack8(acc + 8);
    }
}

__device__ __forceinline__ void p_moe_dispatch(const Ctx& c) {
    unsigned char* ws = c.ws;
    const u32x4* SEL = (const u32x4*)(ws + WS_ROUTE + RT_SEL); int* TOKROW = (int*)(ws + WS_ROUTE + RT_TOKROW); float* ROWW = (float*)(ws + WS_ROUTE + RT_ROWW);
    const bf16_t* XN = (const bf16_t*)(ws + WS_XN); bf16_t* AS = (bf16_t*)(ws + WS_AS);
    LAS int* tot = (LAS int*)c.lds;
    LAS int* rowof = (LAS int*)(c.lds + 1024);
    const int ntok_blk = S / c.G;
    const int tb0 = c.bx * ntok_blk;
    if (c.tid < 16) tot[c.tid] = 0;
    __syncthreads();
    { int ct[NEXP], cb[NEXP];
#pragma unroll
        for (int e = 0; e < NEXP; ++e) { ct[e] = 0; cb[e] = 0; }
        for (int t = c.tid; t < S; t += 512) { const u32x4 r = SEL[t]; const bool before = t < tb0;
#pragma unroll
            for (int e = 0; e < NEXP; ++e) { const int hit = ((int)r.x == e) + ((int)r.y == e); ct[e] += hit; cb[e] += before ? hit : 0; } }
#pragma unroll
        for (int e = 0; e < NEXP; ++e) { int a = ct[e], b = cb[e];
#pragma unroll
            for (int o = 1; o < 64; o <<= 1) { a += __shfl_xor(a, o); b += __shfl_xor(b, o); }
            if (c.lane == 0) { __hip_atomic_fetch_add(&tot[e], a, __ATOMIC_RELAXED, __HIP_MEMORY_SCOPE_WORKGROUP); __hip_atomic_fetch_add(&tot[8 + e], b, __ATOMIC_RELAXED, __HIP_MEMORY_SCOPE_WORKGROUP); } } }
    __syncthreads();
    if (c.tid == 0) { int off = 0; for (int e = 0; e < NEXP; ++e) { tot[16 + e] = off; off += ((tot[e] + 255) >> 8) << 8; }
        int fill[NEXP]; for (int e = 0; e < NEXP; ++e) fill[e] = tot[16 + e] + tot[8 + e];
        for (int i = 0; i < ntok_blk; ++i) { const int t = tb0 + i; const u32x4 r = SEL[t]; const int r0 = fill[r.x]++; const int r1 = fill[r.y]++;
            rowof[2 * i] = r0; rowof[2 * i + 1] = r1; TOKROW[2 * t] = r0; TOKROW[2 * t + 1] = r1; ROWW[r0] = __uint_as_float(r.z); ROWW[r1] = __uint_as_float(r.w); } }
    __syncthreads();
    for (int s = c.wave; s < 2 * ntok_blk; s += 8) { const int t = tb0 + (s >> 1); const u32x4* src = (const u32x4*)((const unsigned char*)XN + (size_t)t * DM); u32x4* dst = (u32x4*)((unsigned char*)AS + (size_t)rowof[s] * DM);
#pragma unroll
        for (int j = 0; j < 2; ++j) dst[c.lane + 64 * j] = src[c.lane + 64 * j]; }
    if (c.bx == 0 && c.tid < NEXP) { const int e = c.tid; const int lo = tot[16 + e] + tot[e], hi = tot[16 + e] + (((tot[e] + 255) >> 8) << 8); for (int r = lo; r < hi; ++r) ROWW[r] = 0.f; }
    __syncthreads();
}
__device__ __forceinline__ int moe_tiles(const Ctx& c, LAS int* te) {
    const u32x4* SEL = (const u32x4*)(c.ws + WS_ROUTE + RT_SEL);
    LAS int* tot = te + 128;
    if (c.tid < 8) tot[c.tid] = 0;
    __syncthreads();
    { int ct[NEXP];
#pragma unroll
        for (int e = 0; e < NEXP; ++e) ct[e] = 0;
        for (int t = c.tid; t < S; t += 512) { const u32x4 r = SEL[t];
#pragma unroll
            for (int e = 0; e < NEXP; ++e) ct[e] += ((int)r.x == e) + ((int)r.y == e); }
#pragma unroll
        for (int e = 0; e < NEXP; ++e) { int a = ct[e];
#pragma unroll
            for (int o = 1; o < 64; o <<= 1) a += __shfl_xor(a, o);
            if (c.lane == 0) __hip_atomic_fetch_add(&tot[e], a, __ATOMIC_RELAXED, __HIP_MEMORY_SCOPE_WORKGROUP); } }
    __syncthreads();
    if (c.tid == 0) { int rt = 0; for (int e = 0; e < NEXP; ++e) { const int nt = (tot[e] + 255) >> 8; for (int i = 0; i < nt; ++i) te[rt++] = e; } tot[8] = rt; }
    __syncthreads();
    const int nrt = tot[8];
    return nrt;
}
__device__ __forceinline__ void p_final(const Ctx& c) {
    unsigned char* ws = c.ws;
    const float* X = (const float*)(ws + WS_X); const bf16_t* YS = (const bf16_t*)(ws + WS_YS); const int* TOKROW = (const int*)(ws + WS_ROUTE + RT_TOKROW);
    const float* fng = inptr<const float>(c, IN_FINAL_NORM); float* outp = inptr<float>(c, IN_OUT);
    for (int t = c.gw; t < S; t += c.NGW) {
        const int r0 = TOKROW[2 * t], r1 = TOKROW[2 * t + 1];
        float v[32]; float ss = 0.f;
#pragma unroll
        for (int j = 0; j < 4; ++j) { const int col = 512 * j + c.lane * 8; float a[8], b[8]; unpack8(*(const u32x4*)(YS + (size_t)r0 * DM + col), a); unpack8(*(const u32x4*)(YS + (size_t)r1 * DM + col), b);
            const f32x4 x0 = *(const f32x4*)(X + (size_t)t * DM + col), x1 = *(const f32x4*)(X + (size_t)t * DM + col + 4);
#pragma unroll
            for (int e = 0; e < 4; ++e) { v[8 * j + e] = x0[e] + a[e] + b[e]; v[8 * j + 4 + e] = x1[e] + a[4 + e] + b[4 + e]; }
#pragma unroll
            for (int e = 0; e < 8; ++e) ss += v[8 * j + e] * v[8 * j + e]; }
        const float rstd = rsqrtf(wave_sum(ss) * (1.f / DM) + RMS_EPS);
#pragma unroll
        for (int j = 0; j < 4; ++j) { const int col = 512 * j + c.lane * 8; const f32x4 g0 = *(const f32x4*)(fng + col), g1 = *(const f32x4*)(fng + col + 4); f32x4 o0, o1;
#pragma unroll
            for (int e = 0; e < 4; ++e) { o0[e] = v[8 * j + e] * rstd * g0[e]; o1[e] = v[8 * j + 4 + e] * rstd * g1[e]; }
            *(f32x4*)(outp + (size_t)t * DM + col) = o0; *(f32x4*)(outp + (size_t)t * DM + col + 4) = o1; }
    }
}

constexpr int PH_PER_LAYER = 12;
constexpr int N_PHASES = 1 + (PH_PER_LAYER - 3) + (PH_PER_LAYER - 1) + 1;
__global__ void __launch_bounds__(512, 2) mega_fwd(Params p) {
    extern __shared__ __attribute__((aligned(16))) unsigned char lds_raw[];
    Ctx c0; { Ctx& c = c0; c.lds = (LAS unsigned char*)lds_raw; c.tid = threadIdx.x; c.bx = blockIdx.x; c.lane = c.tid & 63; c.wave = __builtin_amdgcn_readfirstlane(c.tid >> 6);
    c.G = gridDim.x; c.gw = (int)blockIdx.x * 8 + c.wave; c.NGW = c.G * 8; c.ws = p.ws; }
    const Ctx& c = c0;
    for (int u = c.tid; u < (LDS_BYTES - LDSCTL_OFF) / 4; u += 512) ((LAS unsigned*)(c.lds + LDSCTL_OFF))[u] = 0u;
    __syncthreads();
    if (c.tid < IN_COUNT) { const unsigned long long v = (unsigned long long)p.in[c.tid]; LAS unsigned* tab = (LAS unsigned*)(c.lds + PTAB_OFF); tab[2 * c.tid] = (unsigned)v; tab[2 * c.tid + 1] = (unsigned)(v >> 32); }
    __syncthreads();
    XcdBarrier bar = xcd_barrier_post((unsigned*)(c.ws + WS_CTL) + CW_BAR, (volatile LAS unsigned*)(c.lds + MISC_OFF) + 8);
    const int lo = p.ph_lo, hi = p.ph_hi;
    int ph = 0;
#define PHASE_BEGIN if (ph >= lo && ph < hi) { const Ctx c = launder(c0);
#define PHASE_END   if (ph + 1 < hi) { XcdBarrier b2 = bar; unsigned long long bp = (unsigned long long)b2.bar; asm volatile("" : "+s"(bp), "+s"(b2.x)); b2.bar = (unsigned*)(GAS unsigned*)bp; xcd_barrier(b2); } } ++ph;
#define WSP(T, off) ((T*)(c.ws + (off)))

    PHASE_BEGIN p_prologue(c); { const Ctx c8 = launder(c0); p_norm<false, false, true>(c8, inptr<const float>(c8, IN_X), nullptr); } PHASE_END

#define LAYER_BODY(l) {\
        PHASE_BEGIN { pg8::StaticOrder so; so.init(WSP(const bf16_t, WS_XN), WSP(const bf16_t, WS_WIN) + (size_t)l * NPW * DM, S, NPH, DM, c.G, c.bx); \
            pg8::EpiProj E{WSP(bf16_t, WS_PROJ), 0, l == 0 ? nullptr : WSP(const unsigned long long, WS_ROUTE + RT_SS) + S}; pg8::gemm_phase<pg8::EpiProj, pg8::StaticOrder>(c.lds, c.tid, DM, so, E); } \
          { pg8::StaticOrder so; so.init(WSP(const bf16_t, WS_XN8), (const bf16_t*)(c.ws + WS_WIN + (size_t)l * NPW * DM * 2 + WIN8_OFF), S, NPB - NPH, DM / 2, c.G, c.bx); \
            pg8::EpiProj E{WSP(bf16_t, WS_PROJ), NPH, l == 0 ? nullptr : WSP(const unsigned long long, WS_ROUTE + RT_SS) + S}; pg8::gemm_phase<pg8::EpiProj, pg8::StaticOrder, true, true, true>(c.lds, c.tid, DM / 2, so, E, F8_SC_WIN, 127); } \
          { pg8::SplitKOrder so; so.nM = S / 256; so.nks = SMALL_KS; so.G = c.G; so.c = c.bx; so.A = (const char*)WSP(const bf16_t, WS_XN); so.Bt = (const char*)(WSP(const bf16_t, WS_WIN) + ((size_t)l * NPW + NPH) * DM); so.tstep = (size_t)256 * DM * 2; so.ksb = (DM / SMALL_KS) * 2; \
            pg8::EpiSmallPart E{WSP(float, WS_MERGED), l == 0 ? nullptr : WSP(const unsigned long long, WS_ROUTE + RT_SS) + S}; pg8::gemm_phase<pg8::EpiSmallPart, pg8::SplitKOrder>(c.lds, c.tid, DM / SMALL_KS, so, E, 127, 127, DM); } PHASE_END \
        PHASE_BEGIN if (c.wave >= 4) { { const Ctx c5 = launder(c0); p_prep(c5, l, c5.bx * 4 + c5.wave - 4, c5.G * 4); } { const Ctx c9 = launder(c0); p_dn_vside(c9, l); } } else { const Ctx c6 = launder(c0); p_dn_intra(c6, l); } PHASE_END \
        PHASE_BEGIN if (c.bx < 8) dn::scan_head(c, c.bx); else if (c.bx < 64) { const Ctx c7 = launder(c0); p_convert(c7, l == 0 ? 4 : 17, l == 0 ? 17 : 35, (c7.bx - 8) * 8 + c7.wave, 56 * 8); } { const Ctx c8 = launder(c0); p_select(c8, l); } PHASE_END \
        PHASE_BEGIN p_dn_post(c, l); { const Ctx c2 = launder(c0); p_attn(c2); } PHASE_END \
        PHASE_BEGIN p_attn_merge(c); PHASE_END \
        PHASE_BEGIN { pg8::StaticOrder so; so.init(WSP(const bf16_t, WS_ODN), WSP(const bf16_t, WS_WDN) + (size_t)l * DM * DNW, S, DM, DNW, c.G, c.bx); \
            pg8::EpiGate<false> E{WSP(bf16_t, WS_MERGED), WSP(const bf16_t, WS_PROJ) + PC_GDN}; pg8::gemm_phase<pg8::EpiGate<false>, pg8::StaticOrder>(c.lds, c.tid, DNW, so, E); } \
          { pg8::StaticOrder so; so.init(WSP(const bf16_t, WS_OSA), WSP(const bf16_t, WS_WSA) + (size_t)l * DM * DNW, S, DM, DNW, c.G, c.bx); \
            pg8::EpiGate<true> E{WSP(bf16_t, WS_MERGED), WSP(const bf16_t, WS_PROJ) + PC_GSA}; pg8::gemm_phase<pg8::EpiGate<true>, pg8::StaticOrder>(c.lds, c.tid, DNW, so, E); } PHASE_END \
        PHASE_BEGIN { pg8::StaticOrder so; so.init(WSP(const bf16_t, WS_MERGED), WSP(const bf16_t, WS_WO) + (size_t)l * DM * DM, S, DM, DM, c.G, c.bx); \
            if (l == 0) { pg8::EpiResidN<true> E{inptr<const float>(c, IN_X), WSP(float, WS_X), WSP(void, WS_XN), WSP(unsigned long long, WS_ROUTE + RT_SS), nullptr}; pg8::gemm_phase<pg8::EpiResidN<true>, pg8::StaticOrder>(c.lds, c.tid, DM, so, E); } \
            else { pg8::EpiResid E{WSP(const float, WS_X), WSP(float, WS_X)}; pg8::gemm_phase<pg8::EpiResid, pg8::StaticOrder>(c.lds, c.tid, DM, so, E); } } PHASE_END \
        if (l == 1) { PHASE_BEGIN p_norm<true, true>(c, WSP(const float, WS_X), inptr<const float>(c, IN_NORM_FFN) + DM); PHASE_END } \
        if (l == 1) { PHASE_BEGIN p_moe_dispatch(c); PHASE_END } \
        PHASE_BEGIN if (l == 0) { pg8::StaticOrder so; so.init(WSP(const bf16_t, WS_XN), WSP(const bf16_t, WS_WGU0), S, 2 * DFF, DM / 2, c.G, c.bx); \
                pg8::EpiSwiglu8 E{WSP(unsigned char, WS_HID), DFF, F8_HID, WSP(const unsigned long long, WS_ROUTE + RT_SS)}; pg8::gemm_phase<pg8::EpiSwiglu8, pg8::StaticOrder, true, true, true>(c.lds, c.tid, DM / 2, so, E, F8_SC_WGU, 127); } \
            else { LAS int* te = (LAS int*)(c.lds + MISC_OFF + 1024); const int nrt = moe_tiles(c, te); \
                pg8::GroupOrder go; go.so.init(WSP(const bf16_t, WS_AS), WSP(const bf16_t, WS_WGU1), nrt * 256, 2 * DFE, DM / 2, c.G, c.bx); go.te = te; go.estride = (size_t)2 * DFE * DM; \
                pg8::EpiSwiglu8 E{WSP(unsigned char, WS_HIDM), DFE, F8_HID, nullptr}; pg8::gemm_phase<pg8::EpiSwiglu8, pg8::GroupOrder, true, true, true>(c.lds, c.tid, DM / 2, go, E, F8_SC_WGU, 127); } PHASE_END \
        PHASE_BEGIN if (l == 0) { pg8::StaticOrder so; so.init(WSP(const bf16_t, WS_HID), WSP(const bf16_t, WS_WD0), S, DM, DFF / 2, c.G, c.bx); \
                pg8::EpiResidN<false> E{WSP(const float, WS_X), WSP(float, WS_X), WSP(void, WS_XN), WSP(unsigned long long, WS_ROUTE + RT_SS) + S, WSP(unsigned char, WS_XN8)}; pg8::gemm_phase<pg8::EpiResidN<false>, pg8::StaticOrder, true, true, true>(c.lds, c.tid, DFF / 2, so, E, F8_SC_WD, F8_SC_HID); } \
            else { LAS int* te = (LAS int*)(c.lds + MISC_OFF + 1024); const int nrt = moe_tiles(c, te); \
                pg8::GroupOrder go; go.so.init(WSP(const bf16_t, WS_HIDM), WSP(const bf16_t, WS_WD1), nrt * 256, DM, DFE / 2, c.G, c.bx); go.te = te; go.estride = (size_t)DM * DFE; \
                pg8::EpiMoeDown E{WSP(bf16_t, WS_YS), WSP(const float, WS_ROUTE + RT_ROWW)}; pg8::gemm_phase<pg8::EpiMoeDown, pg8::GroupOrder, true, true, true>(c.lds, c.tid, DFE / 2, go, E, F8_SC_WD, F8_SC_HID); } PHASE_END \
    }
    LAYER_BODY(0)
    LAYER_BODY(1)
#undef LAYER_BODY
    PHASE_BEGIN p_final(c); PHASE_END
#undef PHASE_BEGIN
#undef PHASE_END
#undef WSP
}

extern "C" void kernel_launch(void* const* d_in, const int* in_sizes, int n_in, void* d_out, int out_size, void* d_ws, size_t ws_size, hipStream_t stream) {
    static int grid = 0;
    if (grid == 0) {
        if (n_in != 20 || in_sizes[0] != S * DM || out_size != S * DM || ws_size < WS_END) { fprintf(stderr, "kernel_launch: unexpected shapes (n_in %d, in0 %d, out %d, ws %zu < %zu)\n", n_in, n_in > 0 ? in_sizes[0] : -1, out_size, ws_size, (size_t)WS_END); grid = -1; return; }
        int dev = 0, cus = 0, per_cu = 0;
        if (hipGetDevice(&dev) != hipSuccess || hipDeviceGetAttribute(&cus, hipDeviceAttributeMultiprocessorCount, dev) != hipSuccess) { grid = -1; return; }
        if (hipFuncSetAttribute((const void*)mega_fwd, hipFuncAttributeMaxDynamicSharedMemorySize, LDS_BYTES) != hipSuccess) { fprintf(stderr, "kernel_launch: hipFuncSetAttribute failed\n"); grid = -1; return; }
        if (hipOccupancyMaxActiveBlocksPerMultiprocessor(&per_cu, (const void*)mega_fwd, 512, LDS_BYTES) != hipSuccess || per_cu < 1) fprintf(stderr, "kernel_launch: occupancy query reports %d blocks per CU\n", per_cu);
        (void)hipGetLastError();
        grid = cus;
        if (grid != 256) { fprintf(stderr, "kernel_launch: %d CUs (this kernel is laid out for 256)\n", grid); grid = -1; return; }
    }
    if (grid < 0) return;
    (void)hipMemsetAsync((char*)d_ws + WS_CTL, 0, CTL_ZERO_BYTES, stream);
    Params p{};
    for (int i = 0; i < 20; ++i) p.in[i] = d_in[i];
    p.in[IN_OUT] = d_out; p.ws = (unsigned char*)d_ws; p.ph_lo = 0; p.ph_hi = N_PHASES;
    hipLaunchKernelGGL(mega_fwd, dim3(grid), dim3(512), LDS_BYTES, stream, p);
}
```

```cpp
#include <hip/hip_runtime.h>
#include <cstdio>
#include <cstdint>

#define GAS __attribute__((address_space(1)))
#define LAS __attribute__((address_space(3)))
typedef unsigned short bf16_t;
typedef short bf16x8 __attribute__((ext_vector_type(8)));
typedef float f32x2 __attribute__((ext_vector_type(2)));
typedef float f32x4 __attribute__((ext_vector_type(4)));
typedef float f32x16 __attribute__((ext_vector_type(16)));
typedef unsigned u32x2 __attribute__((ext_vector_type(2)));
typedef _Float16 h2_t __attribute__((ext_vector_type(2)));
typedef unsigned short u16x2_t __attribute__((ext_vector_type(2)));
typedef unsigned u32x4 __attribute__((ext_vector_type(4)));

constexpr int S = 8192, DM = 2048, NLAYER = 2;
constexpr int DNH = 8, HD = 128, DNW = 1024;
constexpr int IXH = 16, IXD = 64, TOPK = 256;
constexpr int DFF = 5632, NEXP = 8, DFE = 2816;
constexpr int NIN = 12384;
constexpr int NPB = 12288;
constexpr int NPW = 12544;
constexpr int NPH = 6144;
constexpr int PC_QKV = 0, PC_QSA = 3072, PC_KSA = 4096, PC_QIX = 5120, PC_Z = 6144, PC_VSA = 7168, PC_GDN = 8192, PC_GSA = 10240;
constexpr float F8_WIN = 32.f; constexpr int F8_SC_WIN = 127 - 5;
constexpr float F8_WY = 16.f, F8_WO = 32.f, F8_ODN = 4.f, F8_OSA = 16.f, F8_MRG = 8.f; constexpr int F8_SC_WY = 127 - 4, F8_SC_WO = 127 - 5, F8_SC_ODN = 127 - 2, F8_SC_OSA = 127 - 4, F8_SC_MRG = 127 - 3;
constexpr int SC_KIX = 0, SC_WIX = 64, SC_A = 80, SC_B = 88;
constexpr float RMS_EPS = 1e-6f, L2_EPS = 1e-6f;
constexpr float F8_WGU = 32.f, F8_WD = 64.f, F8_HID = 8.f; constexpr int F8_SC_WGU = 127 - 5, F8_SC_WD = 127 - 6, F8_SC_HID = 127 - 3;
constexpr int SMALL_KS = 4;
constexpr int MOE_ROWS = 2 * S + NEXP * 256;
constexpr int MOE_MAXT = MOE_ROWS / 256;

constexpr size_t MiB = 1u << 20;
constexpr size_t WS_CTL = 0, CTL_ZERO_BYTES = 1 * MiB;
constexpr size_t WS_WIN = 1 * MiB;
constexpr size_t WS_WDN = WS_WIN + 98 * MiB;
constexpr size_t WS_WSA = WS_WDN + 8 * MiB;
constexpr size_t WS_WO = WS_WSA + 8 * MiB;
constexpr size_t WS_WGU0 = WS_WO + 16 * MiB;
constexpr size_t WS_WD0 = WS_WGU0 + 44 * MiB;
constexpr size_t WS_WGU1 = WS_WD0 + 22 * MiB;
constexpr size_t WS_WD1 = WS_WGU1 + 176 * MiB;
constexpr size_t WS_X = WS_WD1 + 88 * MiB;
constexpr size_t WS_XN = WS_X + 64 * MiB;
constexpr size_t WS_PROJ = WS_XN + 32 * MiB;
constexpr size_t WS_SMALL = WS_PROJ + 192 * MiB;
constexpr size_t WS_DNQKV = WS_SMALL + 8 * MiB;
constexpr size_t WS_ODNRAW = WS_DNQKV + 48 * MiB;
constexpr size_t WS_ODN = WS_ODNRAW + 32 * MiB;
constexpr size_t WS_OSA = WS_ODN + 16 * MiB;
constexpr size_t WS_OSA8 = WS_ODN + 8 * MiB;
constexpr size_t WS_M8 = WS_ODN + 16 * MiB;
constexpr size_t WS_MASK = WS_OSA + 16 * MiB;
constexpr size_t WS_MERGED = WS_MASK + 8 * MiB;
constexpr size_t WS_KIX = WS_MERGED + 32 * MiB;
constexpr size_t WS_WIX = WS_KIX + 1 * MiB;
constexpr size_t WS_GB = WS_WIX + MiB / 2;
constexpr size_t WS_ROPE = WS_GB + MiB / 2;
constexpr size_t WS_ROUTE = WS_ROPE + 6 * MiB;
constexpr size_t WS_ODNRAW2 = WS_ROUTE + 1 * MiB;
constexpr size_t WS_GL = WS_ODNRAW2 + 32 * MiB;
constexpr size_t WS_XN8 = WS_GL + 1 * MiB;
constexpr size_t WS_END = WS_XN8 + 16 * MiB;
constexpr size_t WS_DNF = WS_DNQKV;
static_assert(1024 * 81920 == 80 * MiB, "DNF");
constexpr size_t WS_HID = WS_PROJ;
constexpr size_t WS_AS = WS_PROJ;
constexpr size_t WS_HIDM = WS_PROJ + 72 * MiB;
constexpr size_t WS_YS = WS_DNQKV;
static_assert(72 + 99 <= 192 && 72 <= 48 + 32, "overlays");
constexpr size_t RT_SEL = 0;
constexpr size_t RT_CNTB = 128 * 1024;
constexpr size_t RT_TOKROW = 160 * 1024;
constexpr size_t RT_ROWW = 256 * 1024;
constexpr size_t RT_SS = 512 * 1024;
constexpr int CW_BAR = 4096, CW_SELQ = 64;

constexpr int RING_BYTES = 131072;
constexpr int LDSCTL_OFF = RING_BYTES, MISC_OFF = LDSCTL_OFF + 320;
constexpr int LDS_BYTES = 147456;
constexpr int DN_TAB_OFF = LDSCTL_OFF + 4096;

__device__ __forceinline__ float bf2f(unsigned b) { return __uint_as_float(b << 16); }
typedef __bf16 bf16x2_t __attribute__((ext_vector_type(2)));
__device__ __forceinline__ unsigned cvt_pk_bf16_asm(float lo, float hi) { unsigned r; asm volatile("v_cvt_pk_bf16_f32 %0, %1, %2" : "=v"(r) : "v"(lo), "v"(hi)); return r; }
__device__ __forceinline__ unsigned cvt_pk_bf16(float lo, float hi) { const f32x2 v = {lo, hi}; const bf16x2_t b = __builtin_convertvector(v, bf16x2_t); return __builtin_bit_cast(unsigned, b); }
__device__ __forceinline__ unsigned cvt4_fp8(float a, float b, float c2, float d) { int w = 0; w = __builtin_amdgcn_cvt_pk_fp8_f32(a, b, w, false); w = __builtin_amdgcn_cvt_pk_fp8_f32(c2, d, w, true); return (unsigned)w; }
__device__ __forceinline__ float clamp448(float x) { return __builtin_amdgcn_fmed3f(x, -448.f, 448.f); }
__device__ __forceinline__ unsigned cvt4_fp8c(float a, float b, float c2, float d) { return cvt4_fp8(clamp448(a), clamp448(b), clamp448(c2), clamp448(d)); }
__device__ __forceinline__ bf16_t f2bf(float f) { return (bf16_t)(cvt_pk_bf16(f, 0.f) & 0xffffu); }
__device__ __forceinline__ void unpack8(const u32x4 w, float* f) {
    f[0] = __uint_as_float(w.x << 16); f[1] = __uint_as_float(w.x & 0xffff0000u); f[2] = __uint_as_float(w.y << 16); f[3] = __uint_as_float(w.y & 0xffff0000u);
    f[4] = __uint_as_float(w.z << 16); f[5] = __uint_as_float(w.z & 0xffff0000u); f[6] = __uint_as_float(w.w << 16); f[7] = __uint_as_float(w.w & 0xffff0000u); }
__device__ __forceinline__ u32x4 pack8(const float* f) { u32x4 w; w.x = cvt_pk_bf16(f[0], f[1]); w.y = cvt_pk_bf16(f[2], f[3]); w.z = cvt_pk_bf16(f[4], f[5]); w.w = cvt_pk_bf16(f[6], f[7]); return w; }
__device__ __forceinline__ float wave_sum(float v) {
#pragma unroll
    for (int o = 1; o < 64; o <<= 1) v += __shfl_xor(v, o);
    return v; }
__device__ __forceinline__ float wave_max(float v) {
#pragma unroll
    for (int o = 1; o < 64; o <<= 1) v = fmaxf(v, __shfl_xor(v, o));
    return v; }
template <int CTRL> __device__ __forceinline__ float dpp_f(float v) { return __builtin_bit_cast(float, __builtin_amdgcn_update_dpp(0, __builtin_bit_cast(int, v), CTRL, 0xF, 0xF, true)); }
__device__ __forceinline__ float row16_sum(float v) {
    v += dpp_f<0xB1>(v);
    v += dpp_f<0x4E>(v);
    v += dpp_f<0x141>(v);
    v += dpp_f<0x140>(v);
    return v; }
template <int CTRL, int RM> __device__ __forceinline__ int dpp_i(int v) { return __builtin_amdgcn_update_dpp(0, v, CTRL, RM, 0xF, false); }
__device__ __forceinline__ int wave_isum(int v) {
    v += dpp_i<0xB1, 0xF>(v); v += dpp_i<0x4E, 0xF>(v); v += dpp_i<0x141, 0xF>(v); v += dpp_i<0x140, 0xF>(v);
    v += dpp_i<0x142, 0xA>(v); v += dpp_i<0x143, 0xC>(v);
    return __builtin_amdgcn_readlane(v, 63); }
__device__ __forceinline__ float sigmoidf_(float x) { return __builtin_amdgcn_rcpf(1.f + __expf(-x)); }
__device__ __forceinline__ float siluf_(float x) { return x * sigmoidf_(x); }
#define LDS_WAIT() asm volatile("s_waitcnt lgkmcnt(0)" ::: "memory")
#define VM_WAIT() asm volatile("s_waitcnt vmcnt(0)" ::: "memory")

__constant__ double RF_SA[64] = {1.59154943091895346e-01, 1.37822502603982849e-01, 1.19349370211248862e-01, 1.03352296618434064e-01, 8.94994016088910133e-02, 7.75032887553740585e-02, 6.71150830052272551e-02, 5.81192674418762462e-02, 5.03292121044870353e-02, 4.35833021053073297e-02, 3.77415847174197711e-02, 3.26828658723569976e-02, 2.83021958306233987e-02, 2.45086918620698521e-02, 2.12236527647776604e-02, 1.83789261056796667e-02, 1.59154943091895339e-02, 1.37822502603982839e-02, 1.19349370211248862e-02, 1.03352296618434061e-02, 8.94994016088910063e-03, 7.75032887553740550e-03, 6.71150830052272534e-03, 5.81192674418762410e-03, 5.03292121044870370e-03, 4.35833021053073227e-03, 3.77415847174197719e-03, 3.26828658723569932e-03, 2.83021958306233987e-03, 2.45086918620698565e-03, 2.12236527647776578e-03, 1.83789261056796667e-03, 1.59154943091895356e-03, 1.37822502603982878e-03, 1.19349370211248871e-03, 1.03352296618434048e-03, 8.94994016088910237e-04, 7.75032887553740507e-04, 6.71150830052272490e-04, 5.81192674418762388e-04, 5.03292121044870326e-04, 4.35833021053073292e-04, 3.77415847174197687e-04, 3.26828658723569922e-04, 2.83021958306233954e-04, 2.45086918620698489e-04, 2.12236527647776578e-04, 1.83789261056796662e-04, 1.59154943091895351e-04, 1.37822502603982856e-04, 1.19349370211248862e-04, 1.03352296618434061e-04, 8.94994016088910047e-05, 7.75032887553740561e-05, 6.71150830052272545e-05, 5.81192674418762388e-05, 5.03292121044870354e-05, 4.35833021053073292e-05, 3.77415847174197768e-05, 3.26828658723569989e-05, 2.83021958306233995e-05, 2.45086918620698523e-05, 2.12236527647776592e-05, 1.83789261056796682e-05};

namespace pg8 {
constexpr int BM = 256, BK = 64, HALF = 128, HTB = HALF * BK * 2, STAGE_BYTES = 8 * HTB, NXCD = 8, WGM = 8;
__host__ __device__ __forceinline__ int lds_byte(int r, int c) { const int st = (r >> 4) * 2 + (c >> 5), rr = r & 15, cc = c & 31, ob = rr * 64 + cc * 2; return st * 1024 + (ob ^ (((ob >> 9) & 1) << 5)); }
__host__ __device__ __forceinline__ void stage_rc(int b, int& R, int& C) { const int st = b / 1024, sb = b % 1024, swz = sb ^ (((sb >> 9) & 1) << 5); R = (st >> 1) * 16 + swz / 64; C = (st & 1) * 32 + (swz % 64) / 2; }
__host__ __device__ __forceinline__ int perm32(int rho) { const int n = rho >> 4, i = rho & 15; return 8 * (i >> 2) + 4 * n + (i & 3); }

struct Unit { int pm, pn; const char* a; const char* b; };

struct StaticOrder {
    int nM, nN, nwg, G, c; const char* A; const char* Bt; size_t tstep;
    __device__ void init(const bf16_t* A_, const bf16_t* Bt_, int M, int N, int K, int G_, int c_) { nM = M / BM; nN = N / BM; nwg = nM * nN; G = G_; c = c_; A = (const char*)A_; Bt = (const char*)Bt_; tstep = (size_t)BM * K * 2; }
    __device__ bool tile(int i, int& pm, int& pn) const {
        const long L = (long)i * G + c; if (L >= nwg) return false;
        int wgid = (int)L; { const int q = nwg / NXCD, r = nwg % NXCD, xcd = wgid % NXCD, off = wgid / NXCD; wgid = (xcd < r ? xcd * (q + 1) : r * (q + 1) + (xcd - r) * q) + off; }
        const int nig = WGM * nN, gid = wgid / nig, fm = gid * WGM, gsz = (nM - fm) < WGM ? (nM - fm) : WGM;
        pm = fm + ((wgid % nig) % gsz); pn = (wgid % nig) / gsz; return true;
    }
    __device__ bool next(int i, Unit& u) const { if (!tile(i, u.pm, u.pn)) return false; u.a = A + (size_t)u.pm * tstep; u.b = Bt + (size_t)u.pn * tstep; return true; }
};
struct SplitKOrder {
    int nM, nks, G, c; const char* A; const char* Bt; size_t tstep; int ksb;
    __device__ bool next(int i, Unit& u) const { const long L = (long)i * G + c; if (L >= (long)nM * nks) return false; u.pm = (int)(L % nM); u.pn = (int)(L / nM);
        u.a = A + (size_t)u.pm * tstep + (size_t)u.pn * ksb; u.b = Bt + (size_t)u.pn * ksb; return true; }
};
struct GroupOrder {
    StaticOrder so; const LAS int* te; size_t estride;
    __device__ bool next(int i, Unit& u) const { if (!so.tile(i, u.pm, u.pn)) return false; u.a = so.A + (size_t)u.pm * so.tstep; u.b = so.Bt + (size_t)te[u.pm] * estride + (size_t)u.pn * so.tstep; return true; }
};

typedef int i32x4_t __attribute__((ext_vector_type(4)));
typedef int i32x8_t __attribute__((ext_vector_type(8)));
template <class Epi, class Sched, bool ALIGN_EPI = true, bool SP2 = true, bool F8 = false>
__device__ __forceinline__ void gemm_phase(LAS unsigned char* lds, const int tid, const int K, const Sched& S, const Epi& E, const int sW = 127, const int sX = 127, const int KP_ = 0) {
    const int wid = __builtin_amdgcn_readfirstlane(tid >> 6), lane = tid & 63, wr = wid >> 2, wc = wid & 3, fr = lane & 15, fq = lane >> 4;
    const int nt = K / BK, KP = KP_ ? KP_ : K;
    unsigned voffA[2], voffB[2];
#pragma unroll
    for (int i = 0; i < 2; ++i) { int R, C; stage_rc(tid * 16 + i * 8192, R, C); const int Rb = Epi::PERM ? ((R & ~31) + perm32(R & 31)) : R;
        voffA[i] = (unsigned)(R * KP + C) * 2u; voffB[i] = (unsigned)(Rb * KP + C) * 2u; }
    const size_t kstep = (size_t)(BK * 2);
    const size_t hstep = (size_t)HALF * KP * 2;
    const unsigned ldsw = (unsigned)wid * 1024u;
    const int aoff = lds_byte(wr * 64 + fr, fq * 8), boff = lds_byte(wc * 32 + fr, fq * 8);
#define PG8_SA(b, h) (((b) * 2 + (h)) * HTB)
#define PG8_SB(b, h) ((4 + (b) * 2 + (h)) * HTB)
#define PG8_STAGE(bufoff, gbase, voff) do { _Pragma("unroll") for (int _i = 0; _i < 2; ++_i) \
        __builtin_amdgcn_global_load_lds((const unsigned*)((const char*)(gbase) + (voff)[_i]), (LAS unsigned*)(lds + (bufoff) + ldsw + _i * 8192), 16, 0, 0); } while (0)
#define PG8_LD32(p_) PG8_CAT(*(const LAS i32x4_t*)(p_), *(const LAS i32x4_t*)((p_) + 1024))
#define PG8_LDA(dst, b, h) do { _Pragma("unroll") for (int m = 0; m < 4; ++m) dst[m] = PG8_LD32(lds + PG8_SA(b, h) + aoff + m * 2048); } while (0)
#define PG8_LDB(dst, b, h) do { _Pragma("unroll") for (int n = 0; n < 2; ++n) dst[n] = PG8_LD32(lds + PG8_SB(b, h) + boff + n * 2048); } while (0)
#define PG8_CAT(x0, x1) __builtin_shufflevector(x0, x1, 0, 1, 2, 3, 4, 5, 6, 7)
#define PG8_LO(x) __builtin_bit_cast(bf16x8, __builtin_shufflevector(x, x, 0, 1, 2, 3))
#define PG8_HI(x) __builtin_bit_cast(bf16x8, __builtin_shufflevector(x, x, 4, 5, 6, 7))
#define PG8_MMA(ai, bj, At, Bt) do { __builtin_amdgcn_s_setprio(1); _Pragma("unroll") for (int m = 0; m < 4; ++m) _Pragma("unroll") for (int n = 0; n < 2; ++n) { \
        if constexpr (F8) asm("v_mfma_scale_f32_16x16x128_f8f6f4 %0, %1, %2, %0, %3, %4 op_sel_hi:[0,0,0]" : "+v"(acc[ai][bj][m][n]) : "v"(Bt[n]), "v"(At[m]), "v"(sW), "v"(sX));   \
        else { acc[ai][bj][m][n] = __builtin_amdgcn_mfma_f32_16x16x32_bf16(PG8_LO(Bt[n]), PG8_LO(At[m]), acc[ai][bj][m][n], 0, 0, 0); acc[ai][bj][m][n] = __builtin_amdgcn_mfma_f32_16x16x32_bf16(PG8_HI(Bt[n]), PG8_HI(At[m]), acc[ai][bj][m][n], 0, 0, 0); } } __builtin_amdgcn_s_setprio(0); } while (0)
#define PG8_WAIT_V(n) asm volatile("s_waitcnt vmcnt(" #n ")" ::: "memory")
#define PG8_WAIT_L(n) asm volatile("s_waitcnt lgkmcnt(" #n ")" ::: "memory")
#define PG8_BAR __builtin_amdgcn_s_barrier()
#define PG8_SCHED __builtin_amdgcn_sched_barrier(0)
    Unit cur, nxt; int ui = 0;
    if (!S.next(0, cur)) return;
    f32x4 acc[2][2][4][2];
#pragma unroll
    for (int a = 0; a < 2; ++a)
#pragma unroll
        for (int b = 0; b < 2; ++b)
#pragma unroll
            for (int m = 0; m < 4; ++m)
#pragma unroll
                for (int n = 0; n < 2; ++n) acc[a][b][m][n] = (f32x4){0.f, 0.f, 0.f, 0.f};
    i32x8_t At[4], B0[2], B1[2];
    const char* cA = cur.a; const char* cB = cur.b;
    if constexpr (SP2) {
        PG8_STAGE(PG8_SB(0, 0), cB, voffB); PG8_STAGE(PG8_SB(0, 1), cB + hstep, voffB); PG8_STAGE(PG8_SA(0, 0), cA, voffA); PG8_STAGE(PG8_SA(0, 1), cA + hstep, voffA);
        if (wr == 1) PG8_BAR;
        PG8_WAIT_V(2); PG8_BAR;
        PG8_STAGE(PG8_SB(1, 0), cB + kstep, voffB); PG8_STAGE(PG8_SA(1, 0), cA + kstep, voffA); PG8_STAGE(PG8_SB(1, 1), cB + hstep + kstep, voffB);
        PG8_WAIT_V(6); PG8_BAR;
    } else {
        PG8_STAGE(PG8_SB(0, 0), cB, voffB); PG8_STAGE(PG8_SA(0, 0), cA, voffA); PG8_STAGE(PG8_SB(0, 1), cB + hstep, voffB); PG8_STAGE(PG8_SA(0, 1), cA + hstep, voffA);
        if (wr == 1) PG8_BAR;
        PG8_WAIT_V(4); PG8_BAR;
        PG8_STAGE(PG8_SB(1, 0), cB + kstep, voffB); PG8_STAGE(PG8_SA(1, 0), cA + kstep, voffA); PG8_STAGE(PG8_SB(1, 1), cB + hstep + kstep, voffB);
        PG8_WAIT_V(6); PG8_BAR;
    }
    for (;;) {
        const bool has_next = S.next(ui + 1, nxt);
        const char* nA = has_next ? nxt.a : cA; const char* nB = has_next ? nxt.b : cB;
        for (int t = 0; t < nt; t += 2) {
            const bool last = (t == nt - 2);
            const char* a1 = cA + (size_t)(t + 1) * kstep;
            const char* a2 = last ? nA : cA + (size_t)(t + 2) * kstep; const char* b2 = last ? nB : cB + (size_t)(t + 2) * kstep;
            const char* a3 = a2 + kstep; const char* b3 = b2 + kstep;
            if constexpr (SP2) {
            PG8_LDB(B0, 0, 0); PG8_LDB(B1, 0, 1); PG8_SCHED; PG8_LDA(At, 0, 0); PG8_STAGE(PG8_SA(1, 1), a1 + hstep, voffA);
            PG8_WAIT_V(8); PG8_WAIT_L(0); PG8_BAR; PG8_MMA(0, 0, At, B0); PG8_MMA(0, 1, At, B1); PG8_BAR; PG8_SCHED;
            PG8_LDA(At, 0, 1); PG8_STAGE(PG8_SB(0, 0), b2, voffB); PG8_STAGE(PG8_SB(0, 1), b2 + hstep, voffB); PG8_STAGE(PG8_SA(0, 0), a2, voffA);
            PG8_WAIT_V(8); PG8_WAIT_L(0); PG8_BAR; PG8_MMA(1, 0, At, B0); PG8_MMA(1, 1, At, B1); PG8_BAR; PG8_SCHED;
            PG8_LDB(B0, 1, 0); PG8_LDB(B1, 1, 1); PG8_SCHED; PG8_LDA(At, 1, 0); PG8_STAGE(PG8_SA(0, 1), a2 + hstep, voffA);
            PG8_WAIT_V(8); PG8_WAIT_L(0); PG8_BAR; PG8_MMA(0, 0, At, B0); PG8_MMA(0, 1, At, B1); PG8_BAR; PG8_SCHED;
            PG8_LDA(At, 1, 1); PG8_STAGE(PG8_SB(1, 0), b3, voffB); PG8_STAGE(PG8_SB(1, 1), b3 + hstep, voffB); PG8_STAGE(PG8_SA(1, 0), a3, voffA);
            PG8_WAIT_V(8); PG8_WAIT_L(0); PG8_BAR; PG8_MMA(1, 0, At, B0); PG8_MMA(1, 1, At, B1); PG8_BAR; PG8_SCHED;
            } else {
            PG8_LDB(B0, 0, 0); PG8_SCHED; PG8_LDA(At, 0, 0); PG8_STAGE(PG8_SA(1, 1), a1 + hstep, voffA);
            PG8_WAIT_L(8); PG8_BAR; PG8_WAIT_L(0); PG8_MMA(0, 0, At, B0); PG8_BAR; PG8_SCHED;
            PG8_LDB(B1, 0, 1); PG8_STAGE(PG8_SB(0, 0), b2, voffB);
            PG8_BAR; PG8_WAIT_L(0); PG8_MMA(0, 1, At, B1); PG8_BAR;
            PG8_LDA(At, 0, 1); PG8_STAGE(PG8_SA(0, 0), a2, voffA);
            PG8_BAR; PG8_WAIT_L(0); PG8_MMA(1, 0, At, B0); PG8_BAR; PG8_SCHED;
            PG8_STAGE(PG8_SB(0, 1), b2 + hstep, voffB);
            PG8_WAIT_V(6); PG8_BAR; PG8_MMA(1, 1, At, B1); PG8_BAR;
            PG8_LDB(B0, 1, 0); PG8_SCHED; PG8_LDA(At, 1, 0); PG8_STAGE(PG8_SA(0, 1), a2 + hstep, voffA);
            PG8_WAIT_L(8); PG8_BAR; PG8_WAIT_L(0); PG8_MMA(0, 0, At, B0); PG8_BAR; PG8_SCHED;
            PG8_LDB(B1, 1, 1); PG8_STAGE(PG8_SB(1, 0), b3, voffB);
            PG8_BAR; PG8_WAIT_L(0); PG8_MMA(0, 1, At, B1); PG8_BAR;
            PG8_LDA(At, 1, 1); PG8_STAGE(PG8_SA(1, 0), a3, voffA);
            PG8_BAR; PG8_WAIT_L(0); PG8_MMA(1, 0, At, B0); PG8_BAR; PG8_SCHED;
            PG8_STAGE(PG8_SB(1, 1), b3 + hstep, voffB);
            PG8_WAIT_V(6); PG8_BAR; PG8_MMA(1, 1, At, B1); PG8_BAR;
            }
        }
        if constexpr (ALIGN_EPI) { if (wr == 0) PG8_BAR; }
        if constexpr (F8) asm volatile("s_nop 15\n\ts_nop 15" ::: "memory");
        E(acc, cur, wr, wc, fr, fq);
        if (!has_next) break;
#pragma unroll
        for (int a = 0; a < 2; ++a)
#pragma unroll
            for (int b = 0; b < 2; ++b)
#pragma unroll
                for (int m = 0; m < 4; ++m)
#pragma unroll
                    for (int n = 0; n < 2; ++n) acc[a][b][m][n] = (f32x4){0.f, 0.f, 0.f, 0.f};
        cur = nxt; cA = nA; cB = nB; ++ui;
        if constexpr (ALIGN_EPI) { if (wr == 1) PG8_BAR; }
    }
    PG8_WAIT_V(0);
    if constexpr (!ALIGN_EPI) { if (wr == 0) PG8_BAR; }
    PG8_BAR;
#undef PG8_SA
#undef PG8_SB
#undef PG8_STAGE
#undef PG8_LDA
#undef PG8_LDB
#undef PG8_MMA
#undef PG8_CAT
#undef PG8_LO
#undef PG8_HI
#undef PG8_LD32
#undef PG8_WAIT_V
#undef PG8_WAIT_L
#undef PG8_BAR
#undef PG8_SCHED
}

typedef const f32x4 (&AccRef)[2][2][4][2];
struct EpiProj {
    static constexpr bool PERM = true;
    bf16_t* P; int coff; const unsigned long long* SS;
    __device__ __forceinline__ void operator()(AccRef acc, const Unit& u, int wr, int wc, int fr, int fq) const {
        asm volatile("" : "+v"(fr), "+v"(fq));
        const int row0 = u.pm * BM + wr * 64 + fr, cl = wc * 32 + 8 * fq;
#pragma unroll
        for (int ai = 0; ai < 2; ++ai)
#pragma unroll
            for (int m = 0; m < 4; ++m) { const int rr = row0 + ai * HALF + m * 16; const float rs = SS ? rsqrtf((float)SS[rr] * (1.f / (1048576.f * DM)) + RMS_EPS) : 1.f; bf16_t* rowp = P + (size_t)rr * NPB + coff + u.pn * BM + cl;
#pragma unroll
                for (int bj = 0; bj < 2; ++bj) { const f32x4 v0 = acc[ai][bj][m][0] * rs, v1 = acc[ai][bj][m][1] * rs;
                    u32x4 w; w.x = cvt_pk_bf16(v0[0], v0[1]); w.y = cvt_pk_bf16(v0[2], v0[3]); w.z = cvt_pk_bf16(v1[0], v1[1]); w.w = cvt_pk_bf16(v1[2], v1[3]);
                    *(u32x4*)(rowp + bj * HALF) = w; } }
    }
};
struct EpiSmallPart {
    static constexpr bool PERM = true;
    float* SP; const unsigned long long* SS;
    __device__ __forceinline__ void operator()(AccRef acc, const Unit& u, int wr, int wc, int fr, int fq) const {
        asm volatile("" : "+v"(fr), "+v"(fq));
        const int row0 = u.pm * BM + wr * 64 + fr, cl = wc * 32 + 8 * fq;
#pragma unroll
        for (int ai = 0; ai < 2; ++ai)
#pragma unroll
            for (int m = 0; m < 4; ++m) { const int rr = row0 + ai * HALF + m * 16; const float rs = SS ? rsqrtf((float)SS[rr] * (1.f / (1048576.f * DM)) + RMS_EPS) : 1.f;
                float* rowp = SP + ((size_t)u.pn * S + rr) * 128 + cl; *(f32x4*)rowp = acc[ai][0][m][0] * rs; *(f32x4*)(rowp + 4) = acc[ai][0][m][1] * rs; }
    }
};
template <bool ADD> struct EpiGate {
    static constexpr bool PERM = true;
    bf16_t* MT; unsigned char* M8; const bf16_t* Gt;
    __device__ __forceinline__ void operator()(AccRef acc, const Unit& u, int wr, int wc, int fr, int fq) const {
        asm volatile("" : "+v"(fr), "+v"(fq));
        const int row0 = u.pm * BM + wr * 64 + fr, col0 = u.pn * BM + wc * 32 + 8 * fq;
#pragma unroll
        for (int ai = 0; ai < 2; ++ai)
#pragma unroll
            for (int m = 0; m < 4; ++m) { const size_t r = (size_t)(row0 + ai * HALF + m * 16);
#pragma unroll
                for (int bj = 0; bj < 2; ++bj) {
                    float g[8], o[8]; unpack8(*(const u32x4*)(Gt + r * NPB + col0 + bj * HALF), g);
                    const f32x4 v0 = acc[ai][bj][m][0], v1 = acc[ai][bj][m][1];
                    bf16_t* op = MT + r * DM + col0 + bj * HALF;
                    if (ADD) unpack8(*(const u32x4*)op, o); else { for (int j = 0; j < 8; ++j) o[j] = 0.f; }
#pragma unroll
                    for (int j = 0; j < 4; ++j) { o[j] += sigmoidf_(g[j]) * v0[j]; o[4 + j] += sigmoidf_(g[4 + j]) * v1[j]; }
                    if (ADD) { u32x2 w; w.x = cvt4_fp8c(F8_MRG * o[0], F8_MRG * o[1], F8_MRG * o[2], F8_MRG * o[3]); w.y = cvt4_fp8c(F8_MRG * o[4], F8_MRG * o[5], F8_MRG * o[6], F8_MRG * o[7]); *(u32x2*)(M8 + r * DM + col0 + bj * HALF) = w; }
                    else *(u32x4*)op = pack8(o); } }
    }
};
struct EpiResid {
    static constexpr bool PERM = false;
    const float* Xin; float* Xout;
    __device__ __forceinline__ void operator()(AccRef acc, const Unit& u, int wr, int wc, int fr, int fq) const {
        asm volatile("" : "+v"(fr), "+v"(fq));
        const int row0 = u.pm * BM + wr * 64 + fr, col0 = u.pn * BM + wc * 32 + 4 * fq;
#pragma unroll
        for (int ai = 0; ai < 2; ++ai)
#pragma unroll
            for (int m = 0; m < 4; ++m) { const size_t off = (size_t)(row0 + ai * HALF + m * 16) * DM + col0;
#pragma unroll
                for (int bj = 0; bj < 2; ++bj)
#pragma unroll
                    for (int n = 0; n < 2; ++n) { const f32x4 b = *(const f32x4*)(Xin + off + bj * HALF + n * 16); *(f32x4*)(Xout + off + bj * HALF + n * 16) = b + acc[ai][bj][m][n]; } }
    }
};
template <bool F8OUT> struct EpiResidN {
    static constexpr bool PERM = false;
    const float* Xin; float* Xout; void* XL; unsigned long long* SS; unsigned char* XL8;
    __device__ __forceinline__ void operator()(AccRef acc, const Unit& u, int wr, int wc, int fr, int fq) const {
        asm volatile("" : "+v"(fr), "+v"(fq));
        const int row0 = u.pm * BM + wr * 64 + fr, col0 = u.pn * BM + wc * 32 + 4 * fq;
#pragma unroll
        for (int ai = 0; ai < 2; ++ai)
#pragma unroll
            for (int m = 0; m < 4; ++m) { const int rr = row0 + ai * HALF + m * 16; const size_t off = (size_t)rr * DM + col0; float ss = 0.f;
#pragma unroll
                for (int bj = 0; bj < 2; ++bj)
#pragma unroll
                    for (int n = 0; n < 2; ++n) { const f32x4 b = *(const f32x4*)(Xin + off + bj * HALF + n * 16); const f32x4 v = b + acc[ai][bj][m][n]; *(f32x4*)(Xout + off + bj * HALF + n * 16) = v;
                        ss += (v[0] * v[0] + v[1] * v[1]) + (v[2] * v[2] + v[3] * v[3]);
                        if (F8OUT) *(unsigned*)((unsigned char*)XL + off + bj * HALF + n * 16) = cvt4_fp8c(v[0], v[1], v[2], v[3]);
                        else { u32x2 w; w.x = cvt_pk_bf16(v[0], v[1]); w.y = cvt_pk_bf16(v[2], v[3]); *(u32x2*)((bf16_t*)XL + off + bj * HALF + n * 16) = w; if (XL8) *(unsigned*)(XL8 + off + bj * HALF + n * 16) = cvt4_fp8c(v[0], v[1], v[2], v[3]); } }
                ss += __shfl_xor(ss, 16); ss += __shfl_xor(ss, 32);
                if (fq == 0) atomicAdd(SS + rr, (unsigned long long)(ss * 1048576.f)); }
    }
};
struct EpiSwiglu {
    static constexpr bool PERM = true;
    bf16_t* H; int ldh;
    __device__ __forceinline__ void operator()(AccRef acc, const Unit& u, int wr, int wc, int fr, int fq) const {
        asm volatile("" : "+v"(fr), "+v"(fq));
        const int row0 = u.pm * BM + wr * 64 + fr, col0 = u.pn * HALF + wc * 32 + 8 * fq;
#pragma unroll
        for (int ai = 0; ai < 2; ++ai)
#pragma unroll
            for (int m = 0; m < 4; ++m) { float o[8];
#pragma unroll
                for (int n = 0; n < 2; ++n)
#pragma unroll
                    for (int j = 0; j < 4; ++j) o[4 * n + j] = siluf_(acc[ai][0][m][n][j]) * acc[ai][1][m][n][j];
                *(u32x4*)(H + (size_t)(row0 + ai * HALF + m * 16) * ldh + col0) = pack8(o); }
    }
};
struct EpiSwiglu8 {
    static constexpr bool PERM = true;
    unsigned char* H; int ldh; float hs; const unsigned long long* SS;
    __device__ __forceinline__ void operator()(AccRef acc, const Unit& u, int wr, int wc, int fr, int fq) const {
        asm volatile("" : "+v"(fr), "+v"(fq));
        const int row0 = u.pm * BM + wr * 64 + fr, col0 = u.pn * HALF + wc * 32 + 8 * fq;
#pragma unroll
        for (int ai = 0; ai < 2; ++ai)
#pragma unroll
            for (int m = 0; m < 4; ++m) { float o[8]; const float rs = SS ? rsqrtf((float)SS[row0 + ai * HALF + m * 16] * (1.f / (1048576.f * DM)) + RMS_EPS) : 1.f;
#pragma unroll
                for (int n = 0; n < 2; ++n)
#pragma unroll
                    for (int j = 0; j < 4; ++j) o[4 * n + j] = hs * siluf_(acc[ai][0][m][n][j] * rs) * (acc[ai][1][m][n][j] * rs);
                u32x2 w; w.x = cvt4_fp8c(o[0], o[1], o[2], o[3]); w.y = cvt4_fp8c(o[4], o[5], o[6], o[7]);
                *(u32x2*)(H + (size_t)(row0 + ai * HALF + m * 16) * ldh + col0) = w; }
    }
};
struct EpiMoeDown {
    static constexpr bool PERM = true;
    bf16_t* Y; const float* roww;
    __device__ __forceinline__ void operator()(AccRef acc, const Unit& u, int wr, int wc, int fr, int fq) const {
        asm volatile("" : "+v"(fr), "+v"(fq));
        const int row0 = u.pm * BM + wr * 64 + fr, col0 = u.pn * BM + wc * 32 + 8 * fq;
#pragma unroll
        for (int ai = 0; ai < 2; ++ai)
#pragma unroll
            for (int m = 0; m < 4; ++m) { const size_t r = (size_t)(row0 + ai * HALF + m * 16); const float w = roww[r];
#pragma unroll
                for (int bj = 0; bj < 2; ++bj) { float o[8];
#pragma unroll
                    for (int j = 0; j < 4; ++j) { o[j] = w * acc[ai][bj][m][0][j]; o[4 + j] = w * acc[ai][bj][m][1][j]; }
                    *(u32x4*)(Y + r * DM + col0 + bj * HALF) = pack8(o); } }
    }
};
}

#define XB_TMO      128
#define XB_XCNT(j)  (256  + 64 * (j))
#define XB_XSUB(j)  (1280 + 64 * (j))
#define XB_XGEN(j)  (2304 + 64 * (j))
#define XB_TOP      3328
#define XB_TOPGEN   3392
#define XCD_BAR_WORDS 3456
#define XB_SPIN_CAP (1u << 22)
__device__ __forceinline__ unsigned xb_ld(unsigned* p)              { return __hip_atomic_load(p, __ATOMIC_RELAXED, __HIP_MEMORY_SCOPE_AGENT); }
__device__ __forceinline__ unsigned xb_add(unsigned* p, unsigned v) { return __hip_atomic_fetch_add(p, v, __ATOMIC_RELAXED, __HIP_MEMORY_SCOPE_AGENT); }
__device__ __forceinline__ unsigned xb_xcc_id() { return (unsigned)__builtin_amdgcn_s_getreg((3 << 11) | 20) & 0xFu; }
#define XB_SPIN(cond, bar) do { unsigned _sp = 0; while (cond) { __builtin_amdgcn_s_sleep(1); \
    if ((++_sp & 255u) == 0u) { if (xb_ld(&(bar)[XB_TMO])) break; if (_sp > XB_SPIN_CAP) { atomicAdd(&(bar)[XB_TMO], 1u); break; } } } } while (0)
struct XcdBarrier { unsigned* bar; unsigned x; volatile LAS unsigned* st; };
__device__ __forceinline__ XcdBarrier xcd_barrier_post(unsigned* bar, volatile LAS unsigned* st) {
    XcdBarrier b; b.bar = bar; b.x = xb_xcc_id(); b.st = st;
    if (threadIdx.x == 0) (void)xb_add(&bar[XB_XCNT(b.x)], 1u);
    return b;
}
__device__ __forceinline__ void xcd_barrier_complete(unsigned* bar, unsigned x, unsigned& nloc, unsigned& nx) {
    const unsigned G = gridDim.x * gridDim.y * gridDim.z;
    unsigned sum, cnt, mine, sp = 0u;
    for (;;) {
        sum = 0u; cnt = 0u; mine = 0u;
#pragma unroll
        for (unsigned j = 0; j < 16; ++j) { const unsigned c = xb_ld(&bar[XB_XCNT(j)]); sum += c; cnt += (c > 0u) ? 1u : 0u; mine = (j == x) ? c : mine; }
        if (sum == G) break;
        __builtin_amdgcn_s_sleep(1);
        if ((++sp & 255u) == 0u) { if (xb_ld(&bar[XB_TMO])) break; if (sp > XB_SPIN_CAP) { atomicAdd(&bar[XB_TMO], 1u); break; } }
    }
    nloc = mine > 0u ? mine : 1u; nx = cnt > 0u ? cnt : 1u;
}
__device__ __forceinline__ void xcd_barrier(const XcdBarrier& b) {
    asm volatile("s_waitcnt vmcnt(0)" ::: "memory");
    __syncthreads();
    if (threadIdx.x == 0) {
        unsigned* bar = b.bar;
        __builtin_amdgcn_s_waitcnt(0);
        unsigned nloc = b.st[0], nx = b.st[1];
        if (nloc == 0u) { xcd_barrier_complete(bar, b.x, nloc, nx); b.st[0] = nloc; b.st[1] = nx; }
        const unsigned old = xb_add(&bar[XB_XSUB(b.x)], 1u);
        const unsigned gen = old / nloc;
        if (old + 1u == (gen + 1u) * nloc) {
            __builtin_amdgcn_fence(__ATOMIC_RELEASE, "agent");
            asm volatile("s_waitcnt vmcnt(0)" ::: "memory");
            const unsigned og = xb_add(&bar[XB_TOP], 1u);
            const unsigned tg = og / nx;
            if (og + 1u == (tg + 1u) * nx) xb_add(&bar[XB_TOPGEN], 1u);
            else XB_SPIN(xb_ld(&bar[XB_TOPGEN]) == tg, bar);
            __builtin_amdgcn_fence(__ATOMIC_ACQUIRE, "agent");
            xb_add(&bar[XB_XGEN(b.x)], 1u);
            asm volatile("s_waitcnt vmcnt(0)" ::: "memory");
        } else {
            XB_SPIN(xb_ld(&bar[XB_XGEN(b.x)]) == gen, bar);
            __builtin_amdgcn_fence(__ATOMIC_ACQUIRE, "agent");
            asm volatile("s_waitcnt vmcnt(0)" ::: "memory");
        }
    }
    __syncthreads();
}

struct Ctx { LAS unsigned char* lds; unsigned char* ws; int tid, lane, wave, G, gw, NGW, bx; };
enum { IN_X = 0, IN_POS, IN_NORM_MIX, IN_W_IN, IN_CONV_W, IN_A_LOG, IN_DT_BIAS, IN_DN_NORM, IN_W_DN_OUT, IN_W_SA_OUT, IN_W_O, IN_NORM_FFN, IN_DW_GATE, IN_DW_UP, IN_DW_DOWN,
       IN_ROUTER, IN_MW_GATE, IN_MW_UP, IN_MW_DOWN, IN_FINAL_NORM, IN_OUT, IN_COUNT };
constexpr int PTAB_OFF = 131072 + 512;
__device__ __forceinline__ Ctx launder(const Ctx& c0) { Ctx c = c0; int wv = c0.wave; asm volatile("" : "+s"(wv)); c.wave = wv;
    c.lane = (int)__builtin_amdgcn_mbcnt_hi(~0u, __builtin_amdgcn_mbcnt_lo(~0u, 0u)); asm volatile("" : "+v"(c.lane)); c.tid = c.wave * 64 + c.lane;
    asm volatile("" : "+s"(c.G)); { unsigned la = (unsigned)(unsigned long long)c.lds; asm volatile("" : "+s"(la)); c.lds = (LAS unsigned char*)(unsigned long long)la; } unsigned long long w = (unsigned long long)c.ws; asm volatile("" : "+s"(w)); c.ws = (unsigned char*)(GAS unsigned char*)w; int bx = c0.bx; asm volatile("" : "+s"(bx)); c.bx = bx; c.gw = bx * 8 + c.wave; c.NGW = c.G * 8; return c; }
template <class T> __device__ __forceinline__ T* inptr(const Ctx& c, int i) {
    const LAS unsigned* tab = (const LAS unsigned*)(c.lds + PTAB_OFF); unsigned lo = tab[2 * i], hi = tab[2 * i + 1];
    lo = __builtin_amdgcn_readfirstlane(lo); hi = __builtin_amdgcn_readfirstlane(hi); return (T*)(GAS T*)(((unsigned long long)hi << 32) | lo); }
struct Params { const void* in[IN_COUNT]; unsigned char* ws; int ph_lo, ph_hi; };

__device__ __forceinline__ int map_win(int n) {
    if (n < 3072) return PC_QKV + n;
    if (n < 4096) return PC_Z + (n - 3072);
    if (n < 4104) return NPB + SC_A + (n - 4096);
    if (n < 4112) return NPB + SC_B + (n - 4104);
    if (n < 5136) return PC_QSA + (n - 4112);
    if (n < 6160) return PC_KSA + (n - 5136);
    if (n < 7184) return PC_VSA + (n - 6160);
    if (n < 8208) return PC_QIX + (n - 7184);
    if (n < 8272) return NPB + SC_KIX + (n - 8208);
    if (n < 8288) return NPB + SC_WIX + (n - 8272);
    return PC_GDN + (n - 8288);
}
constexpr size_t WIN8_OFF = (size_t)(NPH + 256) * DM * 2;
__device__ __forceinline__ void ti_load(const float* W, int N, const float* gain, int nblk, int item, int lane, float (&v_)[32], f32x4 (&gv)[2]) {
    const int kb = item / nblk, nb = item % nblk, k0 = 64 * kb, n0 = 32 * nb;
#pragma unroll
    for (int i = 0; i < 32; ++i) v_[i] = __builtin_nontemporal_load(W + (size_t)(k0 + 2 * i + (lane >> 5)) * N + n0 + (lane & 31));
    if (gain) { const float* g = gain + k0 + 8 * (lane & 7); gv[0] = *(const f32x4*)g; gv[1] = *(const f32x4*)(g + 4); }
    else { const f32x4 o1 = {1.f, 1.f, 1.f, 1.f}; gv[0] = o1; gv[1] = o1; }
}
__device__ __forceinline__ void ti_store(const float (&v_)[32], const f32x4 (&gv)[2], int K, bf16_t* WT, int mode, LAS float* scr, int nblk, int item, int lane, const float f8s) {
    const int kb = item / nblk, nb = item % nblk, k0 = 64 * kb, n0 = 32 * nb;
#pragma unroll
    for (int i = 0; i < 32; ++i) scr[(2 * i + (lane >> 5)) * 33 + (lane & 31)] = v_[i];
    LDS_WAIT(); asm volatile("" ::: "memory");
    const int c = lane & 7;
#pragma unroll
    for (int j = 0; j < 4; ++j) { const int nl = (lane >> 3) + 8 * j, n = n0 + nl; const LAS float* s0_ = scr + (8 * c) * 33 + nl;
        float e[8];
#pragma unroll
        for (int q = 0; q < 8; ++q) e[q] = s0_[q * 33] * (q < 4 ? gv[0][q & 3] : gv[1][q & 3]);
        int row = n; float f8r = f8s; unsigned char* W8 = (unsigned char*)WT;
        if (mode == 1) { const int R = map_win(n); if (R >= NPH && R < NPB) { row = R - NPH; f8r = F8_WIN; W8 = (unsigned char*)WT + WIN8_OFF; } else row = R < NPH ? R : NPH + (R - NPB); }
        else if (mode == 2) row = (n >> 7) * 256 + (n & 127); else if (mode == 3) row = (n >> 7) * 256 + 128 + (n & 127);
        if (f8r != 0.f) { const float f8s = f8r; unsigned char* WTb = W8; u32x2 o; o.x = cvt4_fp8(f8s * e[0], f8s * e[1], f8s * e[2], f8s * e[3]); o.y = cvt4_fp8(f8s * e[4], f8s * e[5], f8s * e[6], f8s * e[7]);
            *(u32x2*)(WTb + (size_t)row * K + k0 + 8 * c) = o; }
        else { u32x4 o; o.x = cvt_pk_bf16(e[0], e[1]); o.y = cvt_pk_bf16(e[2], e[3]); o.z = cvt_pk_bf16(e[4], e[5]); o.w = cvt_pk_bf16(e[6], e[7]);
            *(u32x4*)(WT + (size_t)row * K + k0 + 8 * c) = o; } }
    LDS_WAIT(); asm volatile("" ::: "memory");
}
__device__ __forceinline__ void p_convert(const Ctx& c, const int j0, const int j1, const int wk, const int nwk) {
    unsigned char* ws = c.ws;
    LAS float* scr = (LAS float*)(c.lds + c.wave * 16384);
    for (int j = j0; j < j1; ++j) {
        const float* src; bf16_t* dst; const float* gain = nullptr; int K, N, mode = 0; float f8s = 0.f;
        if (j < 8) { const int l = j >> 2, k = j & 3;
            if (k == 0) { src = inptr<const float>(c, IN_W_IN) + (size_t)l * DM * NIN; dst = (bf16_t*)(ws + WS_WIN) + (size_t)l * NPW * DM; gain = inptr<const float>(c, IN_NORM_MIX) + l * DM; K = DM; N = NIN; mode = 1; }
            else if (k == 1) { src = inptr<const float>(c, IN_W_DN_OUT) + (size_t)l * DNW * DM; dst = (bf16_t*)(ws + WS_WDN + (size_t)l * DM * DNW); K = DNW; N = DM; f8s = F8_WY; }
            else if (k == 2) { src = inptr<const float>(c, IN_W_SA_OUT) + (size_t)l * DNW * DM; dst = (bf16_t*)(ws + WS_WSA + (size_t)l * DM * DNW); K = DNW; N = DM; f8s = F8_WY; }
            else { src = inptr<const float>(c, IN_W_O) + (size_t)l * DM * DM; dst = (bf16_t*)(ws + WS_WO + (size_t)l * DM * DM); K = DM; N = DM; f8s = F8_WO; }
        } else if (j < 11) { const int k = j - 8;
            if (k == 0) { src = inptr<const float>(c, IN_DW_GATE); dst = (bf16_t*)(ws + WS_WGU0); gain = inptr<const float>(c, IN_NORM_FFN); K = DM; N = DFF; mode = 2; f8s = F8_WGU; }
            else if (k == 1) { src = inptr<const float>(c, IN_DW_UP); dst = (bf16_t*)(ws + WS_WGU0); gain = inptr<const float>(c, IN_NORM_FFN); K = DM; N = DFF; mode = 3; f8s = F8_WGU; }
            else { src = inptr<const float>(c, IN_DW_DOWN); dst = (bf16_t*)(ws + WS_WD0); K = DFF; N = DM; f8s = F8_WD; }
        } else { const int e = (j - 11) / 3, k = (j - 11) % 3;
            if (k == 0) { src = inptr<const float>(c, IN_MW_GATE) + (size_t)e * DM * DFE; dst = (bf16_t*)(ws + WS_WGU1 + (size_t)e * 2 * DFE * DM); gain = inptr<const float>(c, IN_NORM_FFN) + DM; K = DM; N = DFE; mode = 2; f8s = F8_WGU; }
            else if (k == 1) { src = inptr<const float>(c, IN_MW_UP) + (size_t)e * DM * DFE; dst = (bf16_t*)(ws + WS_WGU1 + (size_t)e * 2 * DFE * DM); gain = inptr<const float>(c, IN_NORM_FFN) + DM; K = DM; N = DFE; mode = 3; f8s = F8_WGU; }
            else { src = inptr<const float>(c, IN_MW_DOWN) + (size_t)e * DFE * DM; dst = (bf16_t*)(ws + WS_WD1 + (size_t)e * DM * DFE); K = DFE; N = DM; f8s = F8_WD; }
        }
        const int nitems = (K / 64) * (N / 32), nblk = N / 32;
        for (int it = wk; it < nitems; it += 2 * nwk) { float va[32], vb[32]; f32x4 ga[2], gb[2]; const int itb = it + nwk;
            ti_load(src, N, gain, nblk, it, c.lane, va, ga); if (itb < nitems) ti_load(src, N, gain, nblk, itb, c.lane, vb, gb);
            ti_store(va, ga, K, dst, mode, scr, nblk, it, c.lane, f8s); if (itb < nitems) ti_store(vb, gb, K, dst, mode, scr, nblk, itb, c.lane, f8s); }
    }
}
__device__ __forceinline__ void p_prologue(const Ctx& c) {
    unsigned char* ws = c.ws;
    p_convert(c, 0, 4, c.gw, c.NGW);
    for (int l = 0; l < NLAYER; ++l) { u32x4* z = (u32x4*)((bf16_t*)(ws + WS_WIN) + ((size_t)l * NPW + NPH + 96) * DM); const int n16 = (256 - 96) * DM / 8;
        for (int i = c.gw * 64 + c.lane; i < n16; i += c.NGW * 64) z[i] = (u32x4){0u, 0u, 0u, 0u}; }
    { unsigned long long* ss = (unsigned long long*)(ws + WS_ROUTE + RT_SS); for (int i = c.gw * 64 + c.lane; i < 2 * S; i += c.NGW * 64) ss[i] = 0ull; }
    float* rope = (float*)(ws + WS_ROPE); const int* posp = inptr<const int>(c, IN_POS);
    for (int i = c.gw * 64 + c.lane; i < S * 96; i += c.NGW * 64) { const int t = i / 96, k = i % 96;
        const double rf = k < 64 ? RF_SA[k] : RF_SA[2 * (k - 64)];
        double fr = (double)posp[t] * rf; fr -= __builtin_rint(fr); const float ff = (float)fr;
        const float cs = __builtin_amdgcn_cosf(ff), sn = __builtin_amdgcn_sinf(ff);
        if (k < 64) { rope[(size_t)t * 192 + k] = cs; rope[(size_t)t * 192 + 64 + k] = sn; } else { rope[(size_t)t * 192 + 128 + (k - 64)] = cs; rope[(size_t)t * 192 + 160 + (k - 64)] = sn; } }
}

template <bool ROUTER, bool F8OUT, bool BOTH = false>
__device__ __forceinline__ void p_norm(const Ctx& c, const float* X, const float* gain_r) {
    bf16_t* XN = (bf16_t*)(c.ws + WS_XN); const float* router = ROUTER ? inptr<const float>(c, IN_ROUTER) : nullptr;
    LAS int* lsel = (LAS int*)(c.lds);
    for (int it = 0; it < S / (8 * c.G) + 1; ++it) {
        const int t = (it * c.G + c.bx) * 8 + c.wave;
        if (t >= S) break;
        const f32x4* xr = (const f32x4*)(X + (size_t)t * DM) + c.lane;
        f32x4 v[8]; float ss = 0.f;
#pragma unroll
        for (int j = 0; j < 8; ++j) { v[j] = xr[64 * j]; ss += (v[j].x * v[j].x + v[j].y * v[j].y) + (v[j].z * v[j].z + v[j].w * v[j].w); }
        const float rstd = rsqrtf(wave_sum(ss) * (1.f / DM) + RMS_EPS);
        if constexpr (F8OUT) { unsigned* o4 = (unsigned*)((unsigned char*)XN + (size_t)t * DM) + c.lane;
#pragma unroll
            for (int j = 0; j < 8; ++j) o4[64 * j] = cvt4_fp8c(v[j].x * rstd, v[j].y * rstd, v[j].z * rstd, v[j].w * rstd); }
        else { u32x2* o8 = (u32x2*)(XN + (size_t)t * DM) + c.lane;
#pragma unroll
            for (int j = 0; j < 8; ++j) { u32x2 w; w.x = cvt_pk_bf16(v[j].x * rstd, v[j].y * rstd); w.y = cvt_pk_bf16(v[j].z * rstd, v[j].w * rstd); o8[64 * j] = w; }
            if constexpr (BOTH) { unsigned* o4 = (unsigned*)(c.ws + WS_XN8 + (size_t)t * DM) + c.lane;
#pragma unroll
                for (int j = 0; j < 8; ++j) o4[64 * j] = cvt4_fp8c(v[j].x * rstd, v[j].y * rstd, v[j].z * rstd, v[j].w * rstd); } }
        if constexpr (ROUTER) {
            float lg[NEXP];
#pragma unroll
            for (int e = 0; e < NEXP; ++e) lg[e] = 0.f;
#pragma unroll
            for (int j = 0; j < 8; ++j)
#pragma unroll
                for (int q = 0; q < 4; ++q) { const int k = 256 * j + 4 * c.lane + q; const float xv = v[j][q] * gain_r[k]; const f32x4* wr = (const f32x4*)(router + (size_t)k * NEXP); const f32x4 w0 = wr[0], w1 = wr[1];
                    lg[0] += xv * w0.x; lg[1] += xv * w0.y; lg[2] += xv * w0.z; lg[3] += xv * w0.w; lg[4] += xv * w1.x; lg[5] += xv * w1.y; lg[6] += xv * w1.z; lg[7] += xv * w1.w; }
#pragma unroll
            for (int e = 0; e < NEXP; ++e) lg[e] = wave_sum(lg[e]) * rstd;
            int e0 = 0; float v0 = lg[0];
#pragma unroll
            for (int e = 1; e < NEXP; ++e) if (lg[e] > v0) { v0 = lg[e]; e0 = e; }
            int e1 = -1; float v1 = -__builtin_inff();
#pragma unroll
            for (int e = 0; e < NEXP; ++e) if (e != e0 && lg[e] > v1) { v1 = lg[e]; e1 = e; }
            const float w0 = 1.f / (1.f + __expf(v1 - v0)), w1 = 1.f - w0;
            if (c.lane == 0) { u32x4 r; r.x = (unsigned)e0; r.y = (unsigned)e1; r.z = __float_as_uint(w0); r.w = __float_as_uint(w1); *(u32x4*)(c.ws + WS_ROUTE + RT_SEL + (size_t)t * 16) = r; }
        }
    }
}

__device__ __forceinline__ void p_prep(const Ctx& c, int layer, const int w0, const int nw) {
    unsigned char* ws = c.ws;
    const bf16_t* PROJ = (const bf16_t*)(ws + WS_PROJ); bf16_t* PROJw = (bf16_t*)(ws + WS_PROJ);
    const float* SM = (const float*)(ws + WS_MERGED);
    const float* rope = (const float*)(ws + WS_ROPE);
    bf16_t* KIX = (bf16_t*)(ws + WS_KIX); float* WIX = (float*)(ws + WS_WIX);
    for (int t = w0; t < S; t += nw) {
        const float* rt = rope + (size_t)t * 192;
        { const int hh = c.lane >> 3, i8 = (c.lane & 7) * 8;
            float cs[8], sn[8]; *(f32x4*)cs = *(const f32x4*)(rt + i8); *(f32x4*)(cs + 4) = *(const f32x4*)(rt + i8 + 4); *(f32x4*)sn = *(const f32x4*)(rt + 64 + i8); *(f32x4*)(sn + 4) = *(const f32x4*)(rt + 64 + i8 + 4);
#pragma unroll
            for (int qk = 0; qk < 2; ++qk) { bf16_t* b = PROJw + (size_t)t * NPB + (qk ? PC_KSA : PC_QSA) + hh * 128 + i8; float a1[8], a2[8], o1[8], o2[8]; unpack8(*(const u32x4*)b, a1); unpack8(*(const u32x4*)(b + 64), a2);
#pragma unroll
                for (int e = 0; e < 8; ++e) { o1[e] = a1[e] * cs[e] - a2[e] * sn[e]; o2[e] = a2[e] * cs[e] + a1[e] * sn[e]; }
                *(u32x4*)b = pack8(o1); *(u32x4*)(b + 64) = pack8(o2); } }
        { const int hh = c.lane >> 2, i8 = (c.lane & 3) * 8;
            float cs[8], sn[8]; *(f32x4*)cs = *(const f32x4*)(rt + 128 + i8); *(f32x4*)(cs + 4) = *(const f32x4*)(rt + 128 + i8 + 4); *(f32x4*)sn = *(const f32x4*)(rt + 160 + i8); *(f32x4*)(sn + 4) = *(const f32x4*)(rt + 160 + i8 + 4);
            bf16_t* b = PROJw + (size_t)t * NPB + PC_QIX + hh * 64 + i8; float a1[8], a2[8], o1[8], o2[8]; unpack8(*(const u32x4*)b, a1); unpack8(*(const u32x4*)(b + 32), a2);
#pragma unroll
            for (int e = 0; e < 8; ++e) { o1[e] = a1[e] * cs[e] - a2[e] * sn[e]; o2[e] = a2[e] * cs[e] + a1[e] * sn[e]; }
            *(u32x4*)b = pack8(o1); *(u32x4*)(b + 32) = pack8(o2); }
        const float* sm = SM + (size_t)t * 128;
#define SMSUM(col) ({ float a_ = 0.f; _Pragma("unroll") for (int ks_ = 0; ks_ < SMALL_KS; ++ks_) a_ += sm[(size_t)ks_ * S * 128 + (col)]; a_; })
        if (c.lane < 32) { const float a1 = SMSUM(SC_KIX + c.lane), a2 = SMSUM(SC_KIX + 32 + c.lane), cs = rt[128 + c.lane], sn = rt[160 + c.lane];
            KIX[(size_t)t * 64 + c.lane] = f2bf(a1 * cs - a2 * sn); KIX[(size_t)t * 64 + 32 + c.lane] = f2bf(a2 * cs + a1 * sn); }
        else if (c.lane < 48) { const int i = c.lane - 32; WIX[(size_t)t * 16 + i] = SMSUM(SC_WIX + i) * 0.03125f; }
#undef SMSUM
    }
}

__device__ __forceinline__ void p_dn_scan(const Ctx& c) {
    unsigned char* ws = c.ws;
    const bf16_t* DQ = (const bf16_t*)(ws + WS_DNQKV); const float* GB = (const float*)(ws + WS_GB); float* OR = (float*)(ws + WS_ODNRAW);
    if (c.wave != 0) return;
    for (int u = c.bx; u < 256; u += c.G) {
        const int h = u >> 5, j = (u & 31) * 4 + (c.lane >> 4), li = c.lane & 15;
        float s[8];
#pragma unroll
        for (int e = 0; e < 8; ++e) s[e] = 0.f;
        const bf16_t* qp = DQ + h * 128 + li * 8; const bf16_t* kp = DQ + 1024 + h * 128 + li * 8; const bf16_t* vp = DQ + 2048 + h * 128 + j;
#pragma unroll 2
        for (int t = 0; t < S; ++t) {
            float k[8], q[8]; unpack8(*(const u32x4*)(kp + (size_t)t * 3072), k); unpack8(*(const u32x4*)(qp + (size_t)t * 3072), q);
            const float v = bf2f(vp[(size_t)t * 3072]); const float a = __expf(GB[(size_t)t * 8 + h]), beta = GB[(size_t)S * 8 + (size_t)t * 8 + h];
            float d = 0.f;
#pragma unroll
            for (int e = 0; e < 8; ++e) { s[e] *= a; d += k[e] * s[e]; }
            d = row16_sum(d);
            const float dl = beta * (v - d); float o = 0.f;
#pragma unroll
            for (int e = 0; e < 8; ++e) { s[e] += dl * k[e]; o += q[e] * s[e]; }
            o = row16_sum(o);
            if (li == 0) OR[(size_t)t * 1024 + h * 128 + j] = o;
        }
    }
}
__device__ __forceinline__ void p_dn_post(const Ctx& c, int layer) {
    unsigned char* ws = c.ws;
    const float* OR = (const float*)(ws + WS_ODNRAW2); const bf16_t* PROJ = (const bf16_t*)(ws + WS_PROJ); bf16_t* ODN = (bf16_t*)(ws + WS_ODN);
    const float* gn = inptr<const float>(c, IN_DN_NORM) + layer * HD;
    for (int u = c.gw; u < S * 2; u += c.NGW) { const int t = u >> 1, col = (u & 1) * 512 + c.lane * 8, d0 = (c.lane & 15) * 8;
        float o[8], z[8]; *(f32x4*)o = *(const f32x4*)(OR + (size_t)t * 1024 + col); *(f32x4*)(o + 4) = *(const f32x4*)(OR + (size_t)t * 1024 + col + 4);
        unpack8(*(const u32x4*)(PROJ + (size_t)t * NPB + PC_Z + col), z);
        float ss = 0.f;
#pragma unroll
        for (int e = 0; e < 8; ++e) ss += o[e] * o[e];
        ss = row16_sum(ss); const float r = rsqrtf(ss * (1.f / HD) + RMS_EPS);
#pragma unroll
        for (int e = 0; e < 8; ++e) o[e] = o[e] * r * gn[d0 + e] * siluf_(z[e]);
        { u32x2 w; w.x = cvt4_fp8c(F8_ODN * o[0], F8_ODN * o[1], F8_ODN * o[2], F8_ODN * o[3]); w.y = cvt4_fp8c(F8_ODN * o[4], F8_ODN * o[5], F8_ODN * o[6], F8_ODN * o[7]); *(u32x2*)((unsigned char*)ODN + (size_t)t * 1024 + col) = w; } }
}


namespace dn {
typedef const f32x4 cf4;
#define OPQ(p) ({ unsigned long long t_ = (unsigned long long)(p); asm volatile("" : "+s"(t_)); (unsigned char*)(GAS unsigned char*)t_; })
constexpr int UNIT_BYTES = 81920, OFF_WF = 0, OFF_KF = 16384, OFF_QF = 32768, OFF_UF = 49152, OFF_OF = 65536;
__device__ __forceinline__ f32x4 mma(bf16x8 a, bf16x8 b, f32x4 c) { return __builtin_amdgcn_mfma_f32_16x16x32_bf16(a, b, c, 0, 0, 0); }
__device__ __forceinline__ bf16x8 pack2(f32x4 a, f32x4 b) { u32x4 w; w.x = cvt_pk_bf16(a[0], a[1]); w.y = cvt_pk_bf16(a[2], a[3]); w.z = cvt_pk_bf16(b[0], b[1]); w.w = cvt_pk_bf16(b[2], b[3]); return __builtin_bit_cast(bf16x8, w); }
__device__ __forceinline__ u32x2 pack4(f32x4 a) { u32x2 w; w.x = cvt_pk_bf16(a[0], a[1]); w.y = cvt_pk_bf16(a[2], a[3]); return w; }
__device__ __forceinline__ f32x4 unpack4(u32x2 w) { f32x4 r; r[0] = __uint_as_float(w.x << 16); r[1] = __uint_as_float(w.x & 0xffff0000u); r[2] = __uint_as_float(w.y << 16); r[3] = __uint_as_float(w.y & 0xffff0000u); return r; }
__device__ __forceinline__ float conv_rows(const char* PROJb, const char* cwb, int n, int h, int tsel, int it, int c16, unsigned xoff, unsigned woff, float (&y)[4][8]) {
    const int t = 64 * n + 16 * it + c16; float ss = 0.f;
    const char* Pb = (const char*)OPQ(PROJb) - 3 * NPB * 2; const char* Cb = (const char*)OPQ(cwb);
    u32x4 xr[4][4];
#pragma unroll
    for (int s = 0; s < 4; ++s)
#pragma unroll
        for (int j = 0; j < 4; ++j) xr[s][j] = *(const u32x4*)(Pb + (xoff + (unsigned)((64 * n + 16 * it + j) * NPB + tsel * 1024 + h * 128 + 32 * s) * 2u));
#pragma unroll
    for (int s = 0; s < 4; ++s) { const int chu = tsel * 1024 + h * 128 + 32 * s;
        float acc[8];
#pragma unroll
        for (int e = 0; e < 8; ++e) acc[e] = 0.f;
#pragma unroll
        for (int j = 0; j < 4; ++j) { float x[8]; unpack8(xr[s][j], x);
            const bool ok = t - 3 + j >= 0;
            const unsigned wo = (unsigned)(j * 3072 + chu) * 4u;
            const f32x4 w0 = *(const f32x4*)(Cb + (woff + wo)), w1 = *(const f32x4*)(Cb + (woff + wo) + 16);
#pragma unroll
            for (int e = 0; e < 4; ++e) { acc[e] += w0[e] * (ok ? x[e] : 0.f); acc[4 + e] += w1[e] * (ok ? x[4 + e] : 0.f); } }
#pragma unroll
        for (int e = 0; e < 8; ++e) { const float v = siluf_(acc[e]); y[s][e] = v; ss += v * v; } }
    asm volatile("" ::: "memory");
    return ss;
}
__device__ __forceinline__ void conv_rows_s4(const char* PROJb, const char* cwb, int n, int h, int tsel, int s, int c16, unsigned xoff, unsigned woff, float (&y)[4][8]) {
    const int chu = tsel * 1024 + h * 128 + 32 * s; const char* Pb = (const char*)OPQ(PROJb) - 3 * NPB * 2; const char* Cb = (const char*)OPQ(cwb);
    u32x4 xr[4][4]; f32x4 w0[4], w1[4];
#pragma unroll
    for (int it = 0; it < 4; ++it)
#pragma unroll
        for (int j = 0; j < 4; ++j) xr[it][j] = *(const u32x4*)(Pb + (xoff + (unsigned)((64 * n + 16 * it + j) * NPB + chu) * 2u));
#pragma unroll
    for (int j = 0; j < 4; ++j) { const unsigned wo = (unsigned)(j * 3072 + chu) * 4u; w0[j] = *(const f32x4*)(Cb + (woff + wo)); w1[j] = *(const f32x4*)(Cb + (woff + wo) + 16); }
#pragma unroll
    for (int it = 0; it < 4; ++it) { const int t = 64 * n + 16 * it + c16; float acc[8];
#pragma unroll
        for (int e = 0; e < 8; ++e) acc[e] = 0.f;
#pragma unroll
        for (int j = 0; j < 4; ++j) { float x[8]; unpack8(xr[it][j], x); const bool ok = t - 3 + j >= 0;
#pragma unroll
            for (int e = 0; e < 4; ++e) { acc[e] += w0[j][e] * (ok ? x[e] : 0.f); acc[4 + e] += w1[j][e] * (ok ? x[4 + e] : 0.f); } }
#pragma unroll
        for (int e = 0; e < 8; ++e) y[it][e] = siluf_(acc[e]); }
}
__device__ __forceinline__ void intra_unit(const Ctx& c, LAS unsigned char* wl, int n, int h, int layer) {
    unsigned char* ws = c.ws;
    const char* PROJb = (const char*)(ws + WS_PROJ); const float* SM = (const float*)(ws + WS_MERGED);
    const char* cwb = (const char*)(inptr<const float>(c, IN_CONV_W) + (size_t)layer * 4 * 3072);
    const int lane = c.lane, c16 = lane & 15, g = lane >> 4;
    const unsigned xoff = (unsigned)(c16 * NPB + 8 * g) * 2u, woff = (unsigned)(8 * g) * 4u, lane16 = (unsigned)lane * 16u, lane8 = (unsigned)lane * 8u;
    unsigned char* ub = ws + WS_DNF + (size_t)(n * DNH + h) * UNIT_BYTES;
    float gtok, beta;
    { const float* sm = SM + (size_t)(64 * n + lane) * 128; float av = 0.f, bv = 0.f;
#pragma unroll
      for (int ks = 0; ks < SMALL_KS; ++ks) { av += sm[(size_t)ks * S * 128 + SC_A + h]; bv += sm[(size_t)ks * S * 128 + SC_B + h]; }
      const float xx = av + inptr<const float>(c, IN_DT_BIAS)[layer * DNH + h];
      const float sp = xx > 20.f ? xx : log1pf(__expf(xx)); gtok = -__expf(inptr<const float>(c, IN_A_LOG)[layer * DNH + h]) * sp; beta = sigmoidf_(bv); }
    LAS float* tgc = (LAS float*)(c.lds + DN_TAB_OFF + c.wave * 1024); LAS float* tbeta = tgc + 64; LAS float* tg = tgc + 128;
    tg[lane] = gtok; tbeta[lane] = beta; LDS_WAIT();
    float gc = 0.f;
#pragma unroll
    for (int m = 0; m < 16; ++m) { const f32x4 v = *(const LAS f32x4*)(tg + 4 * m);
#pragma unroll
        for (int q = 0; q < 4; ++q) gc += (4 * m + q <= lane) ? v[q] : 0.f; }
    tgc[lane] = gc; LDS_WAIT();
    const float gc63 = tgc[63];
    if (lane == 0) ((float*)(ws + WS_GL))[n * DNH + h] = __expf(gc63);
#define LOAD_GC() float gcR[16], gcC[4]; _Pragma("unroll") for (int jt_ = 0; jt_ < 4; ++jt_) { gcC[jt_] = tgc[16 * jt_ + c16]; *(f32x4*)(&gcR[4 * jt_]) = *(const LAS f32x4*)(tgc + 16 * jt_ + 4 * g); }
    const f32x4 Z4 = {0.f, 0.f, 0.f, 0.f};
    LAS float* AT = (LAS float*)wl;
    bf16x8 AF[4][2];
    { bf16x8 Kf[4][4];
#pragma unroll
      for (int it = 0; it < 4; ++it) { float y[4][8];
          float ss = conv_rows(PROJb, cwb, n, h, 1, it, c16, xoff, woff, y); ss += __shfl_xor(ss, 16); ss += __shfl_xor(ss, 32);
          const float r = rsqrtf(ss + L2_EPS);
#pragma unroll
          for (int s = 0; s < 4; ++s) { float z[8];
#pragma unroll
              for (int e = 0; e < 8; ++e) z[e] = y[s][e] * r;
              Kf[it][s] = __builtin_bit_cast(bf16x8, pack8(z)); *(bf16x8*)(OPQ(ub) + (OFF_OF + (it * 4 + s) * 1024) + lane16) = Kf[it][s]; }
          asm volatile("" ::: "memory"); }
      { LOAD_GC(); float betaR[16];
#pragma unroll
        for (int jt = 0; jt < 4; ++jt) *(f32x4*)(&betaR[4 * jt]) = *(const LAS f32x4*)(tbeta + 16 * jt + 4 * g);
#pragma unroll
        for (int ct = 0; ct < 4; ++ct)
#pragma unroll
            for (int jt = ct; jt < 4; ++jt) { f32x4 acc = Z4;
#pragma unroll
                for (int s = 0; s < 4; ++s) acc = mma(Kf[jt][s], Kf[ct][s], acc);
                const int cc = 16 * ct + c16; f32x4 o;
#pragma unroll
                for (int r = 0; r < 4; ++r) { const int j = 16 * jt + 4 * g + r; o[r] = j > cc ? betaR[4 * jt + r] * acc[r] * __expf(gcR[4 * jt + r] - gcC[ct]) : 0.f; }
                *(LAS f32x4*)(AT + cc * 64 + 16 * jt + 4 * g) = o; } }
      asm volatile("" ::: "memory"); }
#pragma unroll
    for (int it = 0; it < 4; ++it) { float y[4][8];
        float ss = conv_rows(PROJb, cwb, n, h, 0, it, c16, xoff, woff, y); ss += __shfl_xor(ss, 16); ss += __shfl_xor(ss, 32);
        const float r = rsqrtf(ss + L2_EPS) * 0.08838834764831845f;
#pragma unroll
        for (int s = 0; s < 4; ++s) { float z[8];
#pragma unroll
            for (int e = 0; e < 8; ++e) z[e] = y[s][e] * r;
            *(bf16x8*)(OPQ(ub) + (OFF_UF + (it * 4 + s) * 1024) + lane16) = __builtin_bit_cast(bf16x8, pack8(z)); }
        asm volatile("" ::: "memory"); }
    asm volatile("s_waitcnt vmcnt(0)" ::: "memory");
    { bf16x8 Kf[4][4];
#pragma unroll
      for (int it = 0; it < 4; ++it)
#pragma unroll
          for (int s = 0; s < 4; ++s) Kf[it][s] = *(const bf16x8*)(OPQ(ub) + (OFF_OF + (it * 4 + s) * 1024) + lane16);
      LOAD_GC();
      bf16x8 Qa[4][4];
#pragma unroll
      for (int it = 0; it < 4; ++it)
#pragma unroll
          for (int s = 0; s < 4; ++s) Qa[it][s] = *(const bf16x8*)(OPQ(ub) + (OFF_UF + (it * 4 + s) * 1024) + lane16);
#pragma unroll
      for (int it = 0; it < 4; ++it) { const bf16x8 (&Qr)[4] = Qa[it];
#pragma unroll
          for (int s = 0; s < 2; ++s) { f32x4 t2[2];
#pragma unroll
              for (int q = 0; q < 2; ++q) { const int jt = 2 * s + q; f32x4 acc = Z4;
                  if (it >= jt) {
#pragma unroll
                      for (int ks = 0; ks < 4; ++ks) acc = mma(Kf[jt][ks], Qr[ks], acc);
                      const int i = 16 * it + c16;
#pragma unroll
                      for (int r = 0; r < 4; ++r) { const int j = 16 * jt + 4 * g + r; acc[r] = i >= j ? acc[r] * __expf(gcC[it] - gcR[4 * jt + r]) : 0.f; } }
                  t2[q] = acc; }
              AF[it][s] = pack2(t2[0], t2[1]); } }
      asm volatile("" ::: "memory"); }
    LDS_WAIT();
    { float T[64];
#pragma unroll
      for (int cc = 63; cc >= 0; --cc) { float a0 = lane == cc ? 1.f : 0.f, a1 = 0.f;
#pragma unroll
          for (int m = (cc + 1) >> 2; m < 16; ++m) { const f32x4 av = *(const LAS f32x4*)(AT + cc * 64 + 4 * m);
#pragma unroll
              for (int q = 0; q < 4; ++q) { const int j = 4 * m + q; if (j > cc) { if (j & 1) a1 -= T[j] * av[q]; else a0 -= T[j] * av[q]; } } }
          T[cc] = a0 + a1; asm volatile("" : "+v"(T[cc])); }
      LDS_WAIT();
#pragma unroll
      for (int m = 0; m < 16; ++m) { u32x2 w; w.x = cvt_pk_bf16(T[4 * m], T[4 * m + 1]); w.y = cvt_pk_bf16(T[4 * m + 2], T[4 * m + 3]); *(LAS u32x2*)(wl + lane * 136 + 8 * m) = w; } }
    LDS_WAIT();
    bf16x8 TF[4][2];
#pragma unroll
    for (int it = 0; it < 4; ++it)
#pragma unroll
        for (int s = 0; s < 2; ++s) { const int i = 16 * it + c16; const u32x2 lo = *(const LAS u32x2*)(wl + i * 136 + (32 * s + 4 * g) * 2), hi2 = *(const LAS u32x2*)(wl + i * 136 + (32 * s + 16 + 4 * g) * 2);
            u32x4 w; w.x = lo.x; w.y = lo.y; w.z = hi2.x; w.w = hi2.y; TF[it][s] = __builtin_bit_cast(bf16x8, w); }
    bf16x8 ID0, ID1;
    { u32x4 w0 = {0u, 0u, 0u, 0u}, w1 = {0u, 0u, 0u, 0u}; const int e0 = c16 - 8 * g, e1 = c16 + 16 - 8 * g;
#pragma unroll
      for (int e = 0; e < 8; ++e) { const unsigned one = (e & 1) ? 0x3F800000u : 0x00003F80u; if (e == e0) w0[e >> 1] |= one; if (e == e1) w1[e >> 1] |= one; }
      ID0 = __builtin_bit_cast(bf16x8, w0); ID1 = __builtin_bit_cast(bf16x8, w1); }
    { asm volatile("" ::: "memory"); LOAD_GC(); float sc1[16], sc2[16];
#pragma unroll
      for (int jt = 0; jt < 4; ++jt)
#pragma unroll
          for (int r = 0; r < 4; ++r) { const float b = tbeta[16 * jt + 4 * g + r]; sc1[4 * jt + r] = b * __expf(gcR[4 * jt + r]); sc2[4 * jt + r] = __expf(gc63 - gcR[4 * jt + r]); }
      float egC[4];
#pragma unroll
      for (int it = 0; it < 4; ++it) egC[it] = __expf(gcC[it]);
      bf16x8 Kfn[4], Qfn[4];
#pragma unroll
      for (int it = 0; it < 4; ++it) { Kfn[it] = *(const bf16x8*)(OPQ(ub) + (OFF_OF + (it * 4) * 1024) + lane16); Qfn[it] = *(const bf16x8*)(OPQ(ub) + (OFF_UF + (it * 4) * 1024) + lane16); }
#pragma unroll
      for (int s4 = 0; s4 < 4; ++s4) { bf16x8 Kfs[4], Qfs[4];
#pragma unroll
          for (int it = 0; it < 4; ++it) { Kfs[it] = Kfn[it]; Qfs[it] = Qfn[it]; }
          if (s4 < 3) {
#pragma unroll
              for (int it = 0; it < 4; ++it) { Kfn[it] = *(const bf16x8*)(OPQ(ub) + (OFF_OF + (it * 4 + s4 + 1) * 1024) + lane16); Qfn[it] = *(const bf16x8*)(OPQ(ub) + (OFF_UF + (it * 4 + s4 + 1) * 1024) + lane16); } }
#pragma unroll
          for (int par = 0; par < 2; ++par) { const int dt = 2 * s4 + par; const bf16x8 ID = par ? ID1 : ID0;
              f32x4 Kc[4];
#pragma unroll
              for (int jt = 0; jt < 4; ++jt) Kc[jt] = mma(Kfs[jt], ID, Z4);
              bf16x8 B1A[2];
#pragma unroll
              for (int s = 0; s < 2; ++s) { f32x4 a, b, a2, b2;
#pragma unroll
                  for (int r = 0; r < 4; ++r) { a[r] = Kc[2 * s][r] * sc1[8 * s + r]; b[r] = Kc[2 * s + 1][r] * sc1[8 * s + 4 + r]; a2[r] = Kc[2 * s][r] * sc2[8 * s + r]; b2[r] = Kc[2 * s + 1][r] * sc2[8 * s + 4 + r]; }
                  B1A[s] = pack2(a, b);
                  *(bf16x8*)(OPQ(ub) + (OFF_KF + (dt * 2 + s) * 1024) + lane16) = pack2(a2, b2); }
#pragma unroll
              for (int it = 0; it < 4; ++it) { f32x4 acc = Z4;
#pragma unroll
                  for (int s = 0; s < 2; ++s) acc = mma(B1A[s], TF[it][s], acc);
                  *(u32x2*)(OPQ(ub) + (OFF_WF + (it * 4 + s4) * 1024 + 8 * par) + lane16) = pack4(acc); }
              f32x4 Wc[4];
#pragma unroll
              for (int jt = 0; jt < 4; ++jt) { f32x4 acc = Z4;
#pragma unroll
                  for (int s = 0; s < 2; ++s) acc = mma(TF[jt][s], B1A[s], acc);
                  Wc[jt] = -acc; }
              bf16x8 WA[2];
#pragma unroll
              for (int s = 0; s < 2; ++s) WA[s] = pack2(Wc[2 * s], Wc[2 * s + 1]);
#pragma unroll
              for (int it = 0; it < 4; ++it) { f32x4 acc = mma(ID, Qfs[it], Z4); acc = acc * egC[it];
#pragma unroll
                  for (int s = 0; s < 2; ++s) acc = mma(WA[s], AF[it][s], acc);
                  *(u32x2*)(OPQ(ub) + (OFF_QF + (it * 4 + s4) * 1024 + 8 * par) + lane16) = pack4(acc); }
              asm volatile("" ::: "memory"); } } }
    asm volatile("s_waitcnt vmcnt(0)" ::: "memory");
    { float betaR[16];
#pragma unroll
      for (int jt = 0; jt < 4; ++jt) *(f32x4*)(&betaR[4 * jt]) = *(const LAS f32x4*)(tbeta + 16 * jt + 4 * g);
#pragma unroll
      for (int s4 = 0; s4 < 4; ++s4) { bf16x8 Vfs[4];
          { float y[4][8]; conv_rows_s4(PROJb, cwb, n, h, 2, s4, c16, xoff, woff, y);
#pragma unroll
            for (int it = 0; it < 4; ++it) Vfs[it] = __builtin_bit_cast(bf16x8, pack8(y[it])); }
#pragma unroll
        for (int par = 0; par < 2; ++par) { const int dvt = 2 * s4 + par; const bf16x8 ID = par ? ID1 : ID0;
          f32x4 Vc[4];
#pragma unroll
          for (int jt = 0; jt < 4; ++jt) { Vc[jt] = mma(Vfs[jt], ID, Z4);
#pragma unroll
              for (int r = 0; r < 4; ++r) Vc[jt][r] *= betaR[4 * jt + r]; }
          bf16x8 B2F[2] = {pack2(Vc[0], Vc[1]), pack2(Vc[2], Vc[3])};
          f32x4 Uc[4];
#pragma unroll
          for (int it = 0; it < 4; ++it) { f32x4 acc = Z4;
#pragma unroll
              for (int s = 0; s < 2; ++s) acc = mma(TF[it][s], B2F[s], acc);
              Uc[it] = acc; *(u32x2*)(OPQ(ub) + (OFF_UF + (dvt * 4 + it) * 512) + lane8) = pack4(acc); }
          bf16x8 UB[2] = {pack2(Uc[0], Uc[1]), pack2(Uc[2], Uc[3])};
#pragma unroll
          for (int it = 0; it < 4; ++it) { f32x4 acc = Z4;
#pragma unroll
              for (int s = 0; s < 2; ++s) acc = mma(AF[it][s], UB[s], acc);
              *(u32x2*)(OPQ(ub) + (OFF_OF + (dvt * 4 + it) * 512) + lane8) = pack4(acc); }
          asm volatile("" ::: "memory"); } } }
    LDS_WAIT();
}
__device__ __forceinline__ void scan_head(const Ctx& c, int h) {
    unsigned char* ws = c.ws; const int lane = c.lane, ns = c.wave; const unsigned lane16 = (unsigned)lane * 16u, lane8 = (unsigned)lane * 8u;
    const float* GL = (const float*)(ws + WS_GL);
    const f32x4 Z4 = {0.f, 0.f, 0.f, 0.f};
    f32x4 Sc[8]; bf16x8 SB[4];
#pragma unroll
    for (int m = 0; m < 8; ++m) Sc[m] = Z4;
#pragma unroll
    for (int s = 0; s < 4; ++s) SB[s] = pack2(Z4, Z4);
    const unsigned char* base = ws + WS_DNF + (size_t)h * UNIT_BYTES;
    LAS unsigned char* lds = c.lds;
#define SCAN_DMA(n_, b_) do { const unsigned char* ug_ = OPQ(base + (size_t)(n_) * (DNH * UNIT_BYTES)); _Pragma("unroll") for (int i_ = 0; i_ < 6; ++i_) \
        __builtin_amdgcn_global_load_lds((const unsigned*)(ug_ + (ns * 6 + i_) * 1024 + lane16), (LAS unsigned*)(lds + (b_) * 49152 + (ns * 6 + i_) * 1024), 16, 0, 0); } while (0)
#define SCAN_UO(n_, U_, O_) do { const unsigned char* ug_ = OPQ(base + (size_t)(n_) * (DNH * UNIT_BYTES)); _Pragma("unroll") for (int it = 0; it < 4; ++it) { \
        U_[it] = *(const u32x2*)(ug_ + (OFF_UF + (ns * 4 + it) * 512) + lane8); O_[it] = *(const u32x2*)(ug_ + (OFF_OF + (ns * 4 + it) * 512) + lane8); } } while (0)
#define SCAN_STEP(n_, b_, U_, O_, GL_, UN_, ON_, GLN_) do { const int nn_ = (n_) + 1 < S / 64 ? (n_) + 1 : (n_); \
        __builtin_amdgcn_s_waitcnt(0x0F70);                         \
        asm volatile("" ::: "memory"); \
        __builtin_amdgcn_s_barrier();                               \
        asm volatile("" ::: "memory"); \
        if ((n_) + 1 < S / 64) SCAN_DMA((n_) + 1, (b_) ^ 1); \
        SCAN_UO(nn_, UN_, ON_); GLN_ = GL[nn_ * DNH + h];           \
        const LAS unsigned char* fb = lds + (b_) * 49152 + lane16; \
        unsigned char* ob = OPQ(ws + WS_ODNRAW2 + ((size_t)(64 * (n_)) * 1024 + h * 128 + 16 * ns) * 4); int ln_ = lane; asm volatile("" : "+v"(ln_)); const unsigned lo_ = (unsigned)(4 * (ln_ >> 4) * 1024 + (ln_ & 15)) * 4u; \
        _Pragma("unroll") for (int it = 0; it < 4; ++it) { f32x4 acc = unpack4(O_[it]);                  \
            _Pragma("unroll") for (int s4 = 0; s4 < 4; ++s4) acc = mma(*(const LAS bf16x8*)(fb + OFF_QF + (it * 4 + s4) * 1024), SB[s4], acc); \
            _Pragma("unroll") for (int r = 0; r < 4; ++r) *(float*)(ob + (size_t)(16 * it + r) * 4096 + lo_) = acc[r]; } \
        f32x4 R[4]; \
        _Pragma("unroll") for (int it = 0; it < 4; ++it) { f32x4 acc = Z4; \
            _Pragma("unroll") for (int s4 = 0; s4 < 4; ++s4) acc = mma(*(const LAS bf16x8*)(fb + OFF_WF + (it * 4 + s4) * 1024), SB[s4], acc); \
            R[it] = unpack4(U_[it]) - acc; } \
        const bf16x8 RB0 = pack2(R[0], R[1]), RB1 = pack2(R[2], R[3]); \
        _Pragma("unroll") for (int m = 0; m < 8; ++m) { f32x4 acc = Sc[m] * GL_; acc = mma(*(const LAS bf16x8*)(fb + OFF_KF + (m * 2) * 1024), RB0, acc); acc = mma(*(const LAS bf16x8*)(fb + OFF_KF + (m * 2 + 1) * 1024), RB1, acc); Sc[m] = acc; } \
        _Pragma("unroll") for (int s = 0; s < 4; ++s) SB[s] = pack2(Sc[2 * s], Sc[2 * s + 1]); } while (0)
    u32x2 Ua[4], Oa[4], Ub[4], Ob[4]; float gla, glb;
    SCAN_DMA(0, 0); SCAN_UO(0, Ua, Oa); gla = GL[h];
    for (int n = 0; n < S / 64; n += 2) {
        SCAN_STEP(n, 0, Ua, Oa, gla, Ub, Ob, glb);
        SCAN_STEP(n + 1, 1, Ub, Ob, glb, Ua, Oa, gla);
    }
    asm volatile("s_waitcnt vmcnt(0)" ::: "memory");
#undef SCAN_STEP
#undef SCAN_DMA
#undef SCAN_UO
}
#undef LOAD_GC
}

__device__ __forceinline__ void p_dn_intra(const Ctx& c, int layer) {
    LAS unsigned char* wl = c.lds + c.wave * 16384;
    for (int u = c.bx * 4 + c.wave; u < (S / 64) * DNH; u += c.G * 4) { Ctx cu = c; asm volatile("" : "+v"(cu.lane)); dn::intra_unit(cu, wl, u >> 3, u & 7, layer); }
}

constexpr int PKN = 32;
__device__ __forceinline__ unsigned fkey(float f) { const unsigned b = __float_as_uint(f); return b ^ ((unsigned)((int)b >> 31) | 0x80000000u); }
__device__ __forceinline__ void p_select(const Ctx& c, const int layer) {
    unsigned char* ws = c.ws;
    const bf16_t* PROJ = (const bf16_t*)(ws + WS_PROJ); const bf16_t* KIX = (const bf16_t*)(ws + WS_KIX); const float* WIX = (const float*)(ws + WS_WIX);
    unsigned* MASK = (unsigned*)(ws + WS_MASK);
    LAS float* SC = (LAS float*)c.lds;
    const int nunits = S / 4;
    unsigned* ctr = (unsigned*)(ws + WS_CTL) + CW_SELQ + layer * 64;
    LAS int* nx = (LAS int*)(c.lds + MISC_OFF + 512);
    const bool scorer = c.wave >= 4;
    auto score_unit = [&](int tk) {
        const int r = c.lane & 31, hi = c.lane >> 5, sw = c.wave - 4;
        const int u = nunits - 1 - tk, t0 = u * 4, ntile = (t0 + 4 + 31) >> 5;
        bf16x8 A[2][4]; h2_t wq[2][8];
#pragma unroll
        for (int m = 0; m < 2; ++m) { const int tq = t0 + 2 * m + ((r >> 2) & 1), hd = (r & 3) + 4 * (r >> 3);
#pragma unroll
            for (int s = 0; s < 4; ++s) A[m][s] = *(const bf16x8*)(PROJ + (size_t)tq * NPB + PC_QIX + hd * 64 + 16 * s + 8 * hi);
            const float* wp = WIX + (size_t)(t0 + 2 * m + hi) * 16;
#pragma unroll
            for (int q4 = 0; q4 < 4; ++q4) { const f32x4 wv = *(const f32x4*)(wp + 4 * q4); wq[m][2 * q4] = __builtin_bit_cast(h2_t, __builtin_amdgcn_cvt_pkrtz(wv[0], wv[1])); wq[m][2 * q4 + 1] = __builtin_bit_cast(h2_t, __builtin_amdgcn_cvt_pkrtz(wv[2], wv[3])); } }
        const bf16_t* kb = KIX + (size_t)r * 64 + 8 * hi;
        bf16x8 B0[4], B1[4], B2[4];
        int tl = sw;
#define LDB(dst, t_) do { const int tt_ = (t_) < ntile ? (t_) : ntile - 1; _Pragma("unroll") for (int s = 0; s < 4; ++s) dst[s] = *(const bf16x8*)(kb + (size_t)tt_ * 2048 + 16 * s); } while (0)
        asm volatile("" ::: "memory"); LDB(B0, tl); asm volatile("" ::: "memory"); LDB(B1, tl + 4); asm volatile("" ::: "memory"); LDB(B2, tl + 8); asm volatile("" ::: "memory");
#define SC_STEP(BX) do { const int key = (tl < ntile ? tl : ntile - 1) * 32 + r;     \
            _Pragma("unroll") for (int m = 0; m < 2; ++m) { f32x16 acc = {}; \
                _Pragma("unroll") for (int s = 0; s < 4; ++s) acc = __builtin_amdgcn_mfma_f32_32x32x16_bf16(A[m][s], BX[s], acc, 0, 0, 0); \
                float sc = 0.f; const h2_t hz = {(_Float16)0, (_Float16)0}; \
                _Pragma("unroll") for (int e = 0; e < 8; ++e) { h2_t x = __builtin_bit_cast(h2_t, __builtin_amdgcn_cvt_pkrtz(acc[2 * e], acc[2 * e + 1])); x = __builtin_elementwise_max(x, hz); sc = __builtin_amdgcn_fdot2(x, wq[m][e], sc, false); } \
                const int tq = t0 + 2 * m + hi; \
                ((LAS unsigned*)SC)[(2 * m + hi) * 8192 + key] = key <= tq ? fkey(sc) : 0u; } \
            __builtin_amdgcn_sched_barrier(0); LDB(BX, tl + 12); __builtin_amdgcn_sched_barrier(0); tl += 4; } while (0)
        while (tl < ntile) { SC_STEP(B0); SC_STEP(B1); SC_STEP(B2); }
        { const int Rz = ntile * 32, Rg = (Rz + 1023) & ~1023;
          for (int kk = Rz + c.lane; kk < Rg; kk += 64) ((LAS unsigned*)SC)[sw * 8192 + kk] = 0u; }
#undef SC_STEP
#undef LDB
    };
    if (c.tid == 0) { nx[0] = (int)__hip_atomic_fetch_add(ctr, 1u, __ATOMIC_RELAXED, __HIP_MEMORY_SCOPE_AGENT); nx[1] = (int)__hip_atomic_fetch_add(ctr, 1u, __ATOMIC_RELAXED, __HIP_MEMORY_SCOPE_AGENT); }
    __syncthreads();
    int tcur = nx[0];
    if (scorer) {
        if (tcur < nunits) score_unit(tcur);
        __syncthreads();
        for (int k = 0; tcur < nunits; ++k) { const int tnext = nx[(k + 1) & 1]; __syncthreads(); if (tnext < nunits) score_unit(tnext); __syncthreads(); tcur = tnext; }
    } else {
        __syncthreads();
        for (int k = 0; tcur < nunits; ++k) {
        const int tnext = nx[(k + 1) & 1];
        const int u = nunits - 1 - tcur, t0 = u * 4, ntile = (t0 + 4 + 31) >> 5;
        int ln = c.lane; asm volatile("" : "+v"(ln));
        const int q = c.wave & 3, tq = t0 + q, n = tq + 1, R = ntile * 32;
        unsigned key[128];
        { const LAS unsigned* sq = (const LAS unsigned*)SC + q * 8192 + ln;
#pragma unroll
            for (int gq = 0; gq < 8; ++gq) {
                if (gq * 1024 < R) {
#pragma unroll
                    for (int jj = 0; jj < 16; ++jj) key[gq * 16 + jj] = sq[(gq * 16 + jj) * 64];
                    __builtin_amdgcn_sched_barrier(0); }
                else {
#pragma unroll
                    for (int jj = 0; jj < 16; ++jj) key[gq * 16 + jj] = 0u; } }
            LDS_WAIT(); }
        __syncthreads();
        unsigned tk2 = 0u; if (c.tid == 0) tk2 = __hip_atomic_fetch_add(ctr, 1u, __ATOMIC_RELAXED, __HIP_MEMORY_SCOPE_AGENT);
        {
#define CNT_ALL(OP, V) ({ int c0_ = 0, c1_ = 0, c2_ = 0, c3_ = 0; _Pragma("unroll") for (int gq_ = 0; gq_ < 8; ++gq_) if (gq_ * 1024 < R) { _Pragma("unroll") for (int jj_ = 0; jj_ < 16; jj_ += 4) { \
    c0_ += (key[gq_ * 16 + jj_] OP (V)) ? 1 : 0; c1_ += (key[gq_ * 16 + jj_ + 1] OP (V)) ? 1 : 0; c2_ += (key[gq_ * 16 + jj_ + 2] OP (V)) ? 1 : 0; c3_ += (key[gq_ * 16 + jj_ + 3] OP (V)) ? 1 : 0; } } wave_isum((c0_ + c1_) + (c2_ + c3_)); })
#define CNT_CK(OP, V) ({ int c0_ = 0, c1_ = 0; _Pragma("unroll") for (int jj_ = 0; jj_ < 8; jj_ += 2) { c0_ += (ck[jj_] OP (V)) ? 1 : 0; c1_ += (ck[jj_ + 1] OP (V)) ? 1 : 0; } wave_isum(c0_ + c1_); })
            unsigned thr = 0u; int need_eq = 0; bool simple = true;
            if (n > TOPK) {
                u16x2_t pk[PKN];
#define PK_OF(i_) __builtin_bit_cast(u16x2_t, __builtin_amdgcn_perm(key[2 * (i_) + 1], key[2 * (i_)], sel_))
#pragma unroll
                for (int i = 0; i < PKN; ++i) { const unsigned sel_ = 0x07060302u; pk[i] = PK_OF(i); }
#define PK_GE(x_) ({ u16x2_t t_; asm("v_pk_sub_u16 %0, %1, %2 clamp\n\tv_pk_min_u16 %0, %0, %3" : "=&v"(t_) : "v"(x_), "s"(cv_), "s"(one_)); t_; })
#define PK_AT(i_) ((i_) < PKN ? pk[(i_) < PKN ? (i_) : 0] : PK_OF(i_))
#define CNT_PK(C16) ({ unsigned sel_ = 0x07060302u; asm volatile("" : "+s"(sel_));     \
    const unsigned cv_ = ((unsigned)(C16) - 1u) * 0x10001u, one_ = 0x10001u; u16x2_t a0_ = {0, 0}, a1_ = {0, 0}; \
    _Pragma("unroll") for (int gq_ = 0; gq_ < 8; ++gq_) if (gq_ * 1024 < R) { _Pragma("unroll") for (int jj_ = 0; jj_ < 8; jj_ += 2) { \
        a0_ += PK_GE(PK_AT(gq_ * 8 + jj_)); a1_ += PK_GE(PK_AT(gq_ * 8 + jj_ + 1)); } } \
    const unsigned s_ = __builtin_bit_cast(unsigned, a0_ + a1_); wave_isum((int)((s_ & 0xffffu) + (s_ >> 16))); })
                for (int bit = 31; bit >= 16; --bit) { const unsigned cand = thr | (1u << bit); if (CNT_PK(cand >> 16) >= TOPK) thr = cand; }
                const unsigned P = thr >> 16; const int c_hi = P == 0xFFFFu ? 0 : CNT_PK(P + 1u);
#undef CNT_PK
#undef PK_AT
#undef PK_OF
#undef PK_GE
                LAS unsigned* cl = (LAS unsigned*)(c.lds + DN_TAB_OFF + q * 2048); int nb = 0;
#pragma unroll
                for (int gq = 0; gq < 8; ++gq) if (gq * 1024 < R) {
#pragma unroll
                    for (int jj = 0; jj < 16; ++jj) { const unsigned kv = key[gq * 16 + jj]; const bool inb = (kv >> 16) == P && kv != 0u; const unsigned long long m = __ballot(inb);
                        if (inb) { const int o = nb + (int)__builtin_amdgcn_mbcnt_hi((unsigned)(m >> 32), __builtin_amdgcn_mbcnt_lo((unsigned)m, 0u)); if (o < 512) cl[o] = kv; } nb += __popcll(m); } }
                LDS_WAIT();
                if (nb <= 512) { unsigned ck[8];
#pragma unroll
                    for (int jj = 0; jj < 8; ++jj) ck[jj] = (jj * 64 + ln) < nb ? cl[jj * 64 + ln] : 0u;
                    for (int bit = 15; bit >= 0; --bit) { const unsigned cand = thr | (1u << bit); if (c_hi + CNT_CK(>=, cand) >= TOPK) thr = cand; }
                    need_eq = TOPK - (c_hi + CNT_CK(>, thr)); simple = CNT_CK(==, thr) == need_eq; }
                else {
                    for (int bit = 15; bit >= 0; --bit) { const unsigned cand = thr | (1u << bit); if (CNT_ALL(>=, cand) >= TOPK) thr = cand; }
                    need_eq = TOPK - CNT_ALL(>, thr); simple = CNT_ALL(==, thr) == need_eq; }
            }
            int tie_seen = 0; int mA0 = 0, mA1 = 0, mB0 = 0, mB1 = 0;
#pragma unroll
            for (int gq = 0; gq < 8; ++gq) if (gq * 1024 < R) {
#pragma unroll
                for (int jj = 0; jj < 16; ++jj) { const int j = gq * 16 + jj, kk = j * 64 + ln; bool sel;
                    if (n <= TOPK) sel = kk < n;
                    else if (simple) sel = key[j] >= thr;
                    else { const unsigned ku = key[j]; const bool inr = true; const bool tie = ku == thr; const unsigned long long tm = __ballot(tie);
                        const int rank = tie_seen + __popcll(tm & ((1ull << ln) - 1ull)); sel = inr && ((ku > thr) || (tie && rank < need_eq)); tie_seen += __popcll(tm); }
                    const unsigned long long bm = __ballot(sel);
                    if (j < 64) { const bool me = ln == j; mA0 = me ? (int)(unsigned)bm : mA0; mA1 = me ? (int)(unsigned)(bm >> 32) : mA1; }
                    else { const bool me = ln == j - 64; mB0 = me ? (int)(unsigned)bm : mB0; mB1 = me ? (int)(unsigned)(bm >> 32) : mB1; } } }
#undef CNT_ALL
#undef CNT_CK
            unsigned* mrow = MASK + ((size_t)(tq >> 5) * 128 * 32 + (tq & 31)) * 2;
            { u32x2 w; w.x = (unsigned)mA0; w.y = (unsigned)mA1; *(u32x2*)(mrow + (size_t)ln * 64) = w; w.x = (unsigned)mB0; w.y = (unsigned)mB1; *(u32x2*)(mrow + (size_t)(64 + ln) * 64) = w; }
        }
        if (c.tid == 0) nx[k & 1] = (int)tk2;
        __syncthreads();
        tcur = tnext;
        }
    }
}

__device__ __forceinline__ void p_attn_naive(const Ctx& c) {
    unsigned char* ws = c.ws;
    const bf16_t* PROJ = (const bf16_t*)(ws + WS_PROJ); const unsigned* MASK = (const unsigned*)(ws + WS_MASK); bf16_t* OSA = (bf16_t*)(ws + WS_OSA);
    LAS int* idx = (LAS int*)c.lds;
    LAS int* wtot = (LAS int*)(c.lds + 4096);
    LAS float* lg = (LAS float*)(c.lds + 8192) + c.wave * 512;
    const int h = c.wave, g4 = c.lane >> 4, li = c.lane & 15;
    for (int t = c.bx; t < S; t += c.G) {
        int cntw = 0; unsigned wbits = 0;
        if (c.tid < 256) { wbits = MASK[(size_t)t * 256 + c.tid]; cntw = __popc(wbits); }
        int incl = cntw;
#pragma unroll
        for (int o = 1; o < 64; o <<= 1) { const int y = __shfl_up(incl, o); if (c.lane >= o) incl += y; }
        if (c.tid < 256 && c.lane == 63) wtot[c.wave] = incl;
        __syncthreads();
        int base = 0, nsel = wtot[0] + wtot[1] + wtot[2] + wtot[3];
        for (int w = 0; w < 4; ++w) if (w < c.wave) base += wtot[w];
        if (c.tid < 256) { int pos = base + incl - cntw; unsigned b = wbits; while (b) { const int bit = __builtin_ctz(b); b &= b - 1; if (pos < 512) idx[pos] = c.tid * 32 + bit; ++pos; } }
        __syncthreads();
        if (nsel > 512) nsel = 512;
        float q[8]; unpack8(*(const u32x4*)(PROJ + (size_t)t * NPB + PC_QSA + h * 128 + li * 8), q);
#pragma unroll
        for (int e = 0; e < 8; ++e) q[e] *= 0.08838834764831845f;
        float mx = -__builtin_inff();
        for (int j0 = 0; j0 < nsel; j0 += 16) {
            float d[4];
#pragma unroll
            for (int uu = 0; uu < 4; ++uu) { const int j = j0 + uu * 4 + g4; d[uu] = 0.f;
                if (j < nsel) { float k[8]; unpack8(*(const u32x4*)(PROJ + (size_t)idx[j] * NPB + PC_KSA + h * 128 + li * 8), k);
#pragma unroll
                    for (int e = 0; e < 8; ++e) d[uu] += q[e] * k[e]; } }
#pragma unroll
            for (int uu = 0; uu < 4; ++uu) { const int j = j0 + uu * 4 + g4; const float dd = row16_sum(d[uu]); if (j < nsel) { if (li == 0) lg[j] = dd; mx = fmaxf(mx, dd); } }
        }
        mx = wave_max(mx);
        LDS_WAIT();
        float o[8], den = 0.f;
#pragma unroll
        for (int e = 0; e < 8; ++e) o[e] = 0.f;
        for (int j0 = 0; j0 < nsel; j0 += 16) {
#pragma unroll
            for (int uu = 0; uu < 4; ++uu) { const int j = j0 + uu * 4 + g4;
                if (j < nsel) { const float pj = __expf(lg[j] - mx); den += pj; float v[8]; unpack8(*(const u32x4*)(PROJ + (size_t)idx[j] * NPB + PC_VSA + h * 128 + li * 8), v);
#pragma unroll
                    for (int e = 0; e < 8; ++e) o[e] += pj * v[e]; } }
        }
        den += __shfl_xor(den, 16); den += __shfl_xor(den, 32);
#pragma unroll
        for (int e = 0; e < 8; ++e) { o[e] += __shfl_xor(o[e], 16); o[e] += __shfl_xor(o[e], 32); }
        const float rd = 1.f / den;
#pragma unroll
        for (int e = 0; e < 8; ++e) o[e] *= rd;
        if (g4 == 0) *(u32x4*)(OSA + (size_t)t * 1024 + h * 128 + li * 8) = pack8(o);
        __syncthreads();
    }
}


namespace att {
constexpr int NW = 8, QBLK = 32, KVBLK = 64, QB = NW * QBLK, D = 128;
constexpr int SHM_V = KVBLK * D * 2, SHM_K = KVBLK * D * 2;
constexpr int LDS_NEED = 2 * SHM_V + 2 * SHM_K + NW * 64 * 4;
constexpr int PITCH = NPB, OPITCH = 128;
constexpr float SCALE = 0.08838834764831845f, THR = 8.f;
typedef short s16x4 __attribute__((ext_vector_type(4)));
#define KSWZ(row, colB) ((row) * 256 + ((colB) ^ (((row) & 7) << 4)))
#define SBAR() __builtin_amdgcn_sched_barrier(0)
__device__ __forceinline__ int v_st(int k, int c) { const int kk = (k & ~0xC) | ((k & 4) << 1) | ((k & 8) >> 1); return ((kk >> 3) * 4 + (c >> 5)) * 512 + ((kk & 7) * 32 + (c & 31)) * 2; }
__device__ __forceinline__ int v_rd_base(int lane) { return ((lane & 3) << 3) | (((lane >> 2) & 3) << 6) | (((lane >> 4) & 1) << 5) | (((lane >> 5) & 1) << 8); }
constexpr int v_rd_off(int d0, int ks, int half) { return d0 * 512 + ks * 4096 + half * 2048; }
__device__ __forceinline__ int crow(int r, int hi) { return (r & 3) + 8 * (r >> 2) + 4 * hi; }
__device__ __forceinline__ void partialSM(f32x16& p0, f32x16& p1, float& m_reg, float& mn, float& alpha) {
    float pmax = p0[0]; for (int r = 1; r < 16; ++r) pmax = fmaxf(pmax, p0[r]); for (int r = 0; r < 16; ++r) pmax = fmaxf(pmax, p1[r]);
    { auto rr = __builtin_amdgcn_permlane32_swap(__float_as_uint(pmax), __float_as_uint(pmax), false, false);
      pmax = fmaxf(__uint_as_float(rr[0]), __uint_as_float(rr[1])); }
    constexpr float C2 = 1.4426950408889634f * SCALE;
    if (__builtin_expect(__all((pmax - m_reg) * SCALE <= THR), 1)) { mn = m_reg; alpha = 1.f; }
    else { mn = fmaxf(m_reg, pmax); alpha = __builtin_amdgcn_exp2f((m_reg - mn) * C2); m_reg = mn; }
    const float mnL = -mn * C2;
    for (int r = 0; r < 16; ++r) p0[r] = fmaf(p0[r], C2, mnL); for (int r = 0; r < 16; ++r) p1[r] = fmaf(p1[r], C2, mnL);
    for (int r = 0; r < 16; ++r) p0[r] = __builtin_amdgcn_exp2f(p0[r]);
}
__device__ __forceinline__ void finishSM(f32x16& p0, f32x16& p1, float alpha, float& l_reg, bf16x8& pa0, bf16x8& pa1, bf16x8& pa2, bf16x8& pa3) {
    for (int r = 0; r < 16; ++r) p1[r] = __builtin_amdgcn_exp2f(p1[r]);
    float ps = 0; for (int r = 0; r < 16; ++r) ps += p0[r]; for (int r = 0; r < 16; ++r) ps += p1[r];
    { auto rr = __builtin_amdgcn_permlane32_swap(__float_as_uint(ps), __float_as_uint(ps), false, false);
      ps = __uint_as_float(rr[0]) + __uint_as_float(rr[1]); }
    l_reg = l_reg * alpha + ps;
#define PK4(P, B_, OUT) do { unsigned a0 = cvt_pk_bf16_asm(P[B_+0], P[B_+1]), a1 = cvt_pk_bf16_asm(P[B_+2], P[B_+3]);                          \
        unsigned b0 = cvt_pk_bf16_asm(P[B_+4], P[B_+5]), b1 = cvt_pk_bf16_asm(P[B_+6], P[B_+7]);                                             \
        auto r0 = __builtin_amdgcn_permlane32_swap(a0, b0, false, false); auto r1 = __builtin_amdgcn_permlane32_swap(a1, b1, false, false); \
        u32x4 w = {r0[0], r1[0], r0[1], r1[1]}; OUT = *reinterpret_cast<bf16x8*>(&w); } while (0)
    PK4(p0, 0, pa0); PK4(p0, 8, pa1); PK4(p1, 0, pa2); PK4(p1, 8, pa3);
#undef PK4
}
__device__ __forceinline__ void mask_init(f32x16& p0, f32x16& p1, u32x2 mw, int hi) {
    const int i0 = (int)~(mw.x >> (4 * hi)), i1 = (int)~(mw.y >> (4 * hi));
#pragma unroll
    for (int r = 0; r < 16; ++r) { const unsigned c = (r & 3) + 8 * (r >> 2);
        p0[r] = __uint_as_float((unsigned)__builtin_amdgcn_sbfe(i0, c, 1u) & 0xFF800000u);
        p1[r] = __uint_as_float((unsigned)__builtin_amdgcn_sbfe(i1, c, 1u) & 0xFF800000u); }
}
template <int KB>
__device__ __forceinline__ void qkt(f32x16& p0, f32x16& p1, const LAS char* K_lds, int r32, int hi, const bf16x8* qr, u32x2 mw) {
    mask_init(p0, p1, mw, hi);
    const LAS char* kb[4];
#pragma unroll
    for (int dd = 0; dd < 4; ++dd) kb[dd] = K_lds + KB * SHM_K + KSWZ(r32, (dd * 16 + hi * 8) * 2);
#pragma unroll
    for (int d0 = 0; d0 < 8; ++d0) { const LAS char* a = kb[d0 & 3] + (d0 >> 2) * 128;
        bf16x8 b0 = *(const LAS bf16x8*)(a);
        bf16x8 b1 = *(const LAS bf16x8*)(a + 32 * 256);
        p0 = __builtin_amdgcn_mfma_f32_32x32x16_bf16(b0, qr[d0], p0, 0, 0, 0);
        p1 = __builtin_amdgcn_mfma_f32_32x32x16_bf16(b1, qr[d0], p1, 0, 0, 0); }
}
template <int VB>
__device__ __forceinline__ void pv_tile(f32x16* o, int vb0, bf16x8 pa0, bf16x8 pa1, bf16x8 pa2, bf16x8 pa3) {
#define TRRD(dst, off) asm volatile("ds_read_b64_tr_b16 %0, %1 offset:%2" : "=&v"(dst) : "v"(vb0), "i"(off) : "memory")
#define PV_D0(d0) do { s16x4 l0, l1, l2, l3, h0, h1, h2, h3; constexpr int b_ = VB * SHM_V + v_rd_off(d0, 0, 0); \
        TRRD(l0, b_); TRRD(h0, b_ + 2048); TRRD(l1, b_ + 4096); TRRD(h1, b_ + 6144); TRRD(l2, b_ + 8192); TRRD(h2, b_ + 10240); TRRD(l3, b_ + 12288); TRRD(h3, b_ + 14336); \
        asm volatile("s_waitcnt lgkmcnt(0)" ::: "memory"); SBAR();   \
        o[d0] = __builtin_amdgcn_mfma_f32_32x32x16_bf16(pa0, (bf16x8){l0[0], l0[1], l0[2], l0[3], h0[0], h0[1], h0[2], h0[3]}, o[d0], 0, 0, 0);   \
        o[d0] = __builtin_amdgcn_mfma_f32_32x32x16_bf16(pa1, (bf16x8){l1[0], l1[1], l1[2], l1[3], h1[0], h1[1], h1[2], h1[3]}, o[d0], 0, 0, 0);   \
        o[d0] = __builtin_amdgcn_mfma_f32_32x32x16_bf16(pa2, (bf16x8){l2[0], l2[1], l2[2], l2[3], h2[0], h2[1], h2[2], h2[3]}, o[d0], 0, 0, 0);   \
        o[d0] = __builtin_amdgcn_mfma_f32_32x32x16_bf16(pa3, (bf16x8){l3[0], l3[1], l3[2], l3[3], h3[0], h3[1], h3[2], h3[3]}, o[d0], 0, 0, 0); } while (0)
    PV_D0(0); PV_D0(1); PV_D0(2); PV_D0(3);
#undef PV_D0
#undef TRRD
}
struct BlockRef { const char* Q; const char* K; bf16_t* O; float* ML; const char* M; int NT; };
struct Seam { bf16x8 qr[8]; bf16x8 st_v0, st_v1, st_k0, st_k1; };
constexpr int VOFFB = (PC_VSA - PC_KSA) * 2;
#define VMW() asm volatile("s_waitcnt vmcnt(0)" ::: "memory")
#define VMWN(n) asm volatile("s_waitcnt vmcnt(%0)" :: "i"(n) : "memory")
#define LD8(p) (*reinterpret_cast<const bf16x8*>(p))
#define KVB(t) (Kh + (size_t)(t) * (KVBLK * PITCH * 2))
#define SLOAD_H(kvb) do { const char* b_ = (kvb); S.st_v0 = LD8(b_ + VOFFB + koff0); S.st_v1 = LD8(b_ + VOFFB + koff1); S.st_k0 = LD8(b_ + koff0); S.st_k1 = LD8(b_ + koff1); } while (0)
#define SWRITE_HK(bf) do { *(LAS bf16x8*)(K_lds + (bf) * SHM_K + kws) = S.st_k0; *(LAS bf16x8*)(K_lds + (bf) * SHM_K + kws + 32 * 256) = S.st_k1; } while (0)
#define SWRITE_HV(bf) do { *(LAS bf16x8*)(V_lds + (bf) * SHM_V + vst0) = S.st_v0; *(LAS bf16x8*)(V_lds + (bf) * SHM_V + vst1) = S.st_v1; } while (0)
#define SWRITE_H(bf) do { SWRITE_HV(bf); SWRITE_HK(bf); } while (0)
#define MLOAD(t) (*(const u32x2*)(cur.M + (size_t)(t) * 256 + moff))
__device__ __forceinline__ void prime(const BlockRef& cur, LAS char* lds, Seam& S, int tid) {
    const int wid = __builtin_amdgcn_readfirstlane(tid >> 6), lane = tid & 63, r32 = lane & 31, hi = lane >> 5;
    const int sr = tid >> 4, sc = (tid & 15) * 8, kws = KSWZ(sr, sc * 2); LAS char* K_lds = lds + 2 * SHM_V;
    const unsigned koff0 = (unsigned)(sr * PITCH + sc) * 2u, koff1 = (unsigned)((32 + sr) * PITCH + sc) * 2u, qoff = (unsigned)((wid * QBLK + r32) * PITCH + hi * 8) * 2u;
    for (int d0 = 0; d0 < 8; ++d0) S.qr[d0] = LD8(cur.Q + qoff + d0 * 32);
    const char* Kh = cur.K;
    SLOAD_H(KVB(0)); VMW(); SWRITE_HK(0);
    __syncthreads();
}
__device__ __forceinline__ void block(const BlockRef& cur, const BlockRef& nxt, LAS char* lds, Seam& S, int tid) {
    const int wid = __builtin_amdgcn_readfirstlane(tid >> 6), lane = tid & 63, r32 = lane & 31, hi = lane >> 5;
    const int NT = cur.NT;
    LAS char* V_lds = lds; LAS char* K_lds = lds + 2 * SHM_V;
    LAS float* wsf = (LAS float*)(lds + 2 * SHM_V + 2 * SHM_K) + wid * 64; LAS float* al_l = wsf + 32;
    float m_reg = -1e30f, l_reg = 0; f32x16 o[4] = {};
    const int sr = tid >> 4, sc = (tid & 15) * 8, vst0 = v_st(sr, sc), vst1 = v_st(32 + sr, sc), kws = KSWZ(sr, sc * 2);
    const unsigned koff0 = (unsigned)(sr * PITCH + sc) * 2u, koff1 = (unsigned)((32 + sr) * PITCH + sc) * 2u, qoff = (unsigned)((wid * QBLK + r32) * PITCH + hi * 8) * 2u;
    const unsigned moff = (unsigned)(wid * (128 * 64 * 4) + r32 * 8);
    const int vb0 = (int)(unsigned)(unsigned long long)V_lds + v_rd_base(lane);
    const char* Kh = cur.K;
#define RESC(a) do { if (__any((a) < 1.f)) { if (hi == 0) al_l[r32] = (a); asm volatile("s_waitcnt lgkmcnt(0)" ::: "memory");              \
                     for (int d_ = 0; d_ < 4; ++d_) for (int r = 0; r < 16; ++r) o[d_][r] *= al_l[crow(r, hi)]; } } while (0)
    constexpr int NQL = 8;
#define SEAM_K0() do { VMWN(NQL); SWRITE_HK(0); SBAR(); } while (0)
    f32x16 pA0, pA1, pB0, pB1; float mnA, mnB, alA, alB; bf16x8 pa0, pa1, pa2, pa3;
    u32x2 mw = MLOAD(0);
    SWRITE_HV(0); SBAR();
    if (NT > 1) SLOAD_H(KVB(1));
    SBAR(); qkt<0>(pA0, pA1, K_lds, r32, hi, S.qr, mw);
    if (NT > 1) mw = MLOAD(1);
    partialSM(pA0, pA1, m_reg, mnA, alA);
    if (NT > 1) { VMWN(1); SWRITE_H(1); }
    __syncthreads();
#define HALF_STEP(PX0, PX1, mnX, alX, PY0, PY1, alY, t, KB, VB, SB) do {                                                      \
        SBAR(); qkt<KB>(PX0, PX1, K_lds, r32, hi, S.qr, mw);                                             \
        finishSM(PY0, PY1, alY, l_reg, pa0, pa1, pa2, pa3); SBAR();                                                           \
        if ((t) + 1 < NT) { SLOAD_H(KVB((t) + 1)); mw = MLOAD((t) + 1); SBAR(); }                                               \
        pv_tile<VB>(o, vb0, pa0, pa1, pa2, pa3); partialSM(PX0, PX1, m_reg, mnX, alX);                                        \
        __syncthreads();                                                                                                      \
        if ((t) + 1 < NT) { VMWN(1); SWRITE_H(SB); }                                                                          \
        RESC(alX); __syncthreads(); } while (0)
    for (int t = 1; t + 1 < NT; t += 2) {
        HALF_STEP(pB0, pB1, mnB, alB, pA0, pA1, alA, t, 1, 0, 0);
        HALF_STEP(pA0, pA1, mnA, alA, pB0, pB1, alB, t + 1, 0, 1, 1);
    }
    const bool even = (NT & 1) == 0;
    if (even) { SBAR(); qkt<1>(pB0, pB1, K_lds, r32, hi, S.qr, mw); SBAR(); }
    { const char* Kh = nxt.K; SLOAD_H(KVB(0)); } SBAR();
#pragma unroll
    for (int d0 = 0; d0 < 8; ++d0) S.qr[d0] = LD8(nxt.Q + qoff + d0 * 32);
    SBAR();
    finishSM(pA0, pA1, alA, l_reg, pa0, pa1, pa2, pa3); SBAR();
    pv_tile<0>(o, vb0, pa0, pa1, pa2, pa3);
    if (even) { partialSM(pB0, pB1, m_reg, mnB, alB); __syncthreads(); RESC(alB);
        finishSM(pB0, pB1, alB, l_reg, pa0, pa1, pa2, pa3); SBAR(); pv_tile<1>(o, vb0, pa0, pa1, pa2, pa3); }
    SBAR(); SEAM_K0();
    int r32e = r32; asm volatile("" : "+v"(r32e));
    if (hi == 0) { f32x2 ml; ml.x = m_reg; ml.y = l_reg; *(f32x2*)((char*)cur.ML + (unsigned)(wid * QBLK + r32e) * 8u) = ml; }
    char* Ow = (char*)cur.O; const unsigned ooff = (unsigned)((wid * QBLK) * OPITCH + r32e) * 2u;
#pragma unroll
    for (int r = 0; r < 16; ++r) { const int orow = crow(r, hi);
#pragma unroll
        for (int d0 = 0; d0 < 4; ++d0) { const float v = o[d0][r];
            const float vn = __shfl_xor(v, 1);
            if ((r32 & 1) == 0) *(unsigned*)(Ow + ooff + (unsigned)(orow * OPITCH + d0 * 32) * 2u) = cvt_pk_bf16_asm(v, vn); } }
    __syncthreads();
#undef RESC
#undef SEAM_K0
#undef HALF_STEP
}
#undef KVB
#undef VMW
#undef VMWN
#undef LD8
#undef SLOAD_H
#undef SWRITE_HK
#undef SWRITE_HV
#undef SWRITE_H
#undef MLOAD
#undef KSWZ
#undef SBAR
}

constexpr int AT_NPARTS = 96;
__constant__ unsigned char AT_SCHED[32][3] = {{159,154,20}, {127,122,47}, {63,58,15}, {121,117,115}, {89,85,83}, {57,53,51}, {25,21,19}, {82,16,78}, {44,79,46}, {12,42,14}, {95,28,41}, {31,155,9}, {158,91,4}, {126,118,77}, {94,86,45}, {62,54,13}, {120,22,40}, {88,80,8}, {56,48,39}, {24,123,10}, {50,59,90}, {18,27,26}, {30,23,7}, {157,81,3}, {125,49,38}, {93,17,6}, {61,43,2}, {29,11,1}, {156,5,0}, {119,124,116}, {87,92,84}, {55,60,52}};
__constant__ unsigned char AT_NPART[32] = {1,1,1,1,1,1,2,2,2,2,2,2,2,3,3,3,3,3,3,4,4,4,4,4,4,4,5,5,5,5,5,5};
__constant__ unsigned char AT_PBASE[32] = {0,1,2,3,4,5,6,8,10,12,14,16,18,20,23,26,29,32,35,38,42,46,50,54,58,62,66,71,76,81,86,91};
constexpr size_t AT_PARTO_BYTES = (size_t)256 * 128 * 2, AT_ML_OFF = (size_t)DNH * AT_NPARTS * AT_PARTO_BYTES;
__device__ __forceinline__ void p_attn(const Ctx& c) {
    unsigned char* ws = c.ws;
    const bf16_t* PROJ = (const bf16_t*)(ws + WS_PROJ); const unsigned* MASKT = (const unsigned*)(ws + WS_MASK);
    const int h = c.bx & 7, slot = c.bx >> 3;
    if (slot >= 32) return;
    auto ref = [&](int j) { const int e = AT_SCHED[slot][j]; const int qb = e & 31, p = e >> 5, np = AT_NPART[qb], nt = 4 * (qb + 1), lo = (p * nt) / np, hi2 = ((p + 1) * nt) / np; att::BlockRef r;
        const size_t pi = (size_t)h * AT_NPARTS + AT_PBASE[qb] + p;
        r.Q = (const char*)(PROJ + (size_t)qb * att::QB * NPB + PC_QSA + h * 128); r.K = (const char*)(PROJ + (size_t)lo * 64 * NPB + PC_KSA + h * 128);
        r.O = (bf16_t*)(ws + WS_DNF + pi * AT_PARTO_BYTES); r.ML = (float*)(ws + WS_DNF + AT_ML_OFF + pi * 2048);
        r.M = (const char*)(MASKT + (size_t)qb * 8 * (128 * 64)) + (size_t)lo * 256; r.NT = hi2 - lo; return r; };
    int nit = 0;
    for (int j = 0; j < 3; ++j) nit += AT_SCHED[slot][j] != 255 ? 1 : 0;
    att::BlockRef cur = ref(0); att::Seam Sm;
    att::prime(cur, (LAS char*)c.lds, Sm, c.tid);
    for (int j = 0; j < nit; ++j) { const bool more = j + 1 < nit; const att::BlockRef nxt = more ? ref(j + 1) : cur;
        att::block(cur, nxt, (LAS char*)c.lds, Sm, c.tid);
        cur = nxt; }
}
__device__ __forceinline__ void p_attn_merge(const Ctx& c) {
    unsigned char* ws = c.ws; bf16_t* OSA = (bf16_t*)(ws + WS_OSA8);
    constexpr float C2 = 1.4426950408889634f * att::SCALE;
    for (int u = c.gw; u < DNH * 32 * 32; u += c.NGW) {
        const int rg = u & 31, qb = (u >> 5) & 31, h = u >> 10, np = AT_NPART[qb]; const size_t pi0 = (size_t)h * AT_NPARTS + AT_PBASE[qb];
        const int row = rg * 8 + (c.lane >> 3), cg = (c.lane & 7) * 16;
        float M = -1e30f;
        for (int p = 0; p < np; ++p) M = fmaxf(M, ((const float*)(ws + WS_DNF + AT_ML_OFF + (pi0 + p) * 2048))[2 * row]);
        float acc[16], den = 0.f;
#pragma unroll
        for (int e = 0; e < 16; ++e) acc[e] = 0.f;
        for (int p = 0; p < np; ++p) { const f32x2 ml = *(const f32x2*)(ws + WS_DNF + AT_ML_OFF + (pi0 + p) * 2048 + 8 * row); const float w = __builtin_amdgcn_exp2f((ml.x - M) * C2); den += w * ml.y;
            const bf16_t* op = (const bf16_t*)(ws + WS_DNF + (pi0 + p) * AT_PARTO_BYTES) + row * 128 + cg; float v[16]; unpack8(*(const u32x4*)op, v); unpack8(*(const u32x4*)(op + 8), v + 8);
#pragma unroll
            for (int e = 0; e < 16; ++e) acc[e] += w * v[e]; }
        const float rd = 1.f / den;
#pragma unroll
        for (int e = 0; e < 16; ++e) acc[e] *= rd;
#pragma unroll
        for (int e = 0; e < 16; ++e) acc[e] *= F8_OSA;
        unsigned char* o = (unsigned char*)OSA + (size_t)(qb * 256 + row) * 1024 + h * 128 + cg; u32x4 w; w.x = cvt4_fp8c(acc[0], acc[1], acc[2], acc[3]); w.y = cvt4_fp8c(acc[4], acc[5], acc[6], acc[7]); w.z = cvt4_fp8c(acc[8], acc[9], acc[10], acc[11]); w.w = cvt4_fp8c(acc[12], acc[13], acc[14], acc[15]); *(u32x4*)o = w;
    }
}

__device__ __forceinline__ void p_moe_dispatch(const Ctx& c) {
    unsigned char* ws = c.ws;
    const u32x4* SEL = (const u32x4*)(ws + WS_ROUTE + RT_SEL); int* TOKROW = (int*)(ws + WS_ROUTE + RT_TOKROW); float* ROWW = (float*)(ws + WS_ROUTE + RT_ROWW);
    const bf16_t* XN = (const bf16_t*)(ws + WS_XN); bf16_t* AS = (bf16_t*)(ws + WS_AS);
    LAS int* tot = (LAS int*)c.lds;
    LAS int* rowof = (LAS int*)(c.lds + 1024);
    const int ntok_blk = S / c.G;
    const int tb0 = c.bx * ntok_blk;
    if (c.tid < 16) tot[c.tid] = 0;
    __syncthreads();
    { int ct[NEXP], cb[NEXP];
#pragma unroll
        for (int e = 0; e < NEXP; ++e) { ct[e] = 0; cb[e] = 0; }
        for (int t = c.tid; t < S; t += 512) { const u32x4 r = SEL[t]; const bool before = t < tb0;
#pragma unroll
            for (int e = 0; e < NEXP; ++e) { const int hit = ((int)r.x == e) + ((int)r.y == e); ct[e] += hit; cb[e] += before ? hit : 0; } }
#pragma unroll
        for (int e = 0; e < NEXP; ++e) { int a = ct[e], b = cb[e];
#pragma unroll
            for (int o = 1; o < 64; o <<= 1) { a += __shfl_xor(a, o); b += __shfl_xor(b, o); }
            if (c.lane == 0) { __hip_atomic_fetch_add(&tot[e], a, __ATOMIC_RELAXED, __HIP_MEMORY_SCOPE_WORKGROUP); __hip_atomic_fetch_add(&tot[8 + e], b, __ATOMIC_RELAXED, __HIP_MEMORY_SCOPE_WORKGROUP); } } }
    __syncthreads();
    if (c.tid == 0) { int off = 0; for (int e = 0; e < NEXP; ++e) { tot[16 + e] = off; off += ((tot[e] + 255) >> 8) << 8; }
        int fill[NEXP]; for (int e = 0; e < NEXP; ++e) fill[e] = tot[16 + e] + tot[8 + e];
        for (int i = 0; i < ntok_blk; ++i) { const int t = tb0 + i; const u32x4 r = SEL[t]; const int r0 = fill[r.x]++; const int r1 = fill[r.y]++;
            rowof[2 * i] = r0; rowof[2 * i + 1] = r1; TOKROW[2 * t] = r0; TOKROW[2 * t + 1] = r1; ROWW[r0] = __uint_as_float(r.z); ROWW[r1] = __uint_as_float(r.w); } }
    __syncthreads();
    for (int s = c.wave; s < 2 * ntok_blk; s += 8) { const int t = tb0 + (s >> 1); const u32x4* src = (const u32x4*)((const unsigned char*)XN + (size_t)t * DM); u32x4* dst = (u32x4*)((unsigned char*)AS + (size_t)rowof[s] * DM);
#pragma unroll
        for (int j = 0; j < 2; ++j) dst[c.lane + 64 * j] = src[c.lane + 64 * j]; }
    if (c.bx == 0 && c.tid < NEXP) { const int e = c.tid; const int lo = tot[16 + e] + tot[e], hi = tot[16 + e] + (((tot[e] + 255) >> 8) << 8); for (int r = lo; r < hi; ++r) ROWW[r] = 0.f; }
    __syncthreads();
}
__device__ __forceinline__ int moe_tiles(const Ctx& c, LAS int* te) {
    const u32x4* SEL = (const u32x4*)(c.ws + WS_ROUTE + RT_SEL);
    LAS int* tot = te + 128;
    if (c.tid < 8) tot[c.tid] = 0;
    __syncthreads();
    { int ct[NEXP];
#pragma unroll
        for (int e = 0; e < NEXP; ++e) ct[e] = 0;
        for (int t = c.tid; t < S; t += 512) { const u32x4 r = SEL[t];
#pragma unroll
            for (int e = 0; e < NEXP; ++e) ct[e] += ((int)r.x == e) + ((int)r.y == e); }
#pragma unroll
        for (int e = 0; e < NEXP; ++e) { int a = ct[e];
#pragma unroll
            for (int o = 1; o < 64; o <<= 1) a += __shfl_xor(a, o);
            if (c.lane == 0) __hip_atomic_fetch_add(&tot[e], a, __ATOMIC_RELAXED, __HIP_MEMORY_SCOPE_WORKGROUP); } }
    __syncthreads();
    if (c.tid == 0) { int rt = 0; for (int e = 0; e < NEXP; ++e) { const int nt = (tot[e] + 255) >> 8; for (int i = 0; i < nt; ++i) te[rt++] = e; } tot[8] = rt; }
    __syncthreads();
    const int nrt = tot[8];
    return nrt;
}
__device__ __forceinline__ void p_final(const Ctx& c) {
    unsigned char* ws = c.ws;
    const float* X = (const float*)(ws + WS_X); const bf16_t* YS = (const bf16_t*)(ws + WS_YS); const int* TOKROW = (const int*)(ws + WS_ROUTE + RT_TOKROW);
    const float* fng = inptr<const float>(c, IN_FINAL_NORM); float* outp = inptr<float>(c, IN_OUT);
    for (int t = c.gw; t < S; t += c.NGW) {
        const int r0 = TOKROW[2 * t], r1 = TOKROW[2 * t + 1];
        float v[32]; float ss = 0.f;
#pragma unroll
        for (int j = 0; j < 4; ++j) { const int col = 512 * j + c.lane * 8; float a[8], b[8]; unpack8(*(const u32x4*)(YS + (size_t)r0 * DM + col), a); unpack8(*(const u32x4*)(YS + (size_t)r1 * DM + col), b);
            const f32x4 x0 = *(const f32x4*)(X + (size_t)t * DM + col), x1 = *(const f32x4*)(X + (size_t)t * DM + col + 4);
#pragma unroll
            for (int e = 0; e < 4; ++e) { v[8 * j + e] = x0[e] + a[e] + b[e]; v[8 * j + 4 + e] = x1[e] + a[4 + e] + b[4 + e]; }
#pragma unroll
            for (int e = 0; e < 8; ++e) ss += v[8 * j + e] * v[8 * j + e]; }
        const float rstd = rsqrtf(wave_sum(ss) * (1.f / DM) + RMS_EPS);
#pragma unroll
        for (int j = 0; j < 4; ++j) { const int col = 512 * j + c.lane * 8; const f32x4 g0 = *(const f32x4*)(fng + col), g1 = *(const f32x4*)(fng + col + 4); f32x4 o0, o1;
#pragma unroll
            for (int e = 0; e < 4; ++e) { o0[e] = v[8 * j + e] * rstd * g0[e]; o1[e] = v[8 * j + 4 + e] * rstd * g1[e]; }
            *(f32x4*)(outp + (size_t)t * DM + col) = o0; *(f32x4*)(outp + (size_t)t * DM + col + 4) = o1; }
    }
}

constexpr int PH_PER_LAYER = 12;
constexpr int N_PHASES = 1 + (PH_PER_LAYER - 3) + (PH_PER_LAYER - 1) + 1;
__global__ void __launch_bounds__(512, 2) mega_fwd(Params p) {
    extern __shared__ __attribute__((aligned(16))) unsigned char lds_raw[];
    Ctx c0; { Ctx& c = c0; c.lds = (LAS unsigned char*)lds_raw; c.tid = threadIdx.x; c.bx = blockIdx.x; c.lane = c.tid & 63; c.wave = __builtin_amdgcn_readfirstlane(c.tid >> 6);
    c.G = gridDim.x; c.gw = (int)blockIdx.x * 8 + c.wave; c.NGW = c.G * 8; c.ws = p.ws; }
    const Ctx& c = c0;
    for (int u = c.tid; u < (LDS_BYTES - LDSCTL_OFF) / 4; u += 512) ((LAS unsigned*)(c.lds + LDSCTL_OFF))[u] = 0u;
    __syncthreads();
    if (c.tid < IN_COUNT) { const unsigned long long v = (unsigned long long)p.in[c.tid]; LAS unsigned* tab = (LAS unsigned*)(c.lds + PTAB_OFF); tab[2 * c.tid] = (unsigned)v; tab[2 * c.tid + 1] = (unsigned)(v >> 32); }
    __syncthreads();
    XcdBarrier bar = xcd_barrier_post((unsigned*)(c.ws + WS_CTL) + CW_BAR, (volatile LAS unsigned*)(c.lds + MISC_OFF) + 8);
    const int lo = p.ph_lo, hi = p.ph_hi;
    int ph = 0;
#define PHASE_BEGIN if (ph >= lo && ph < hi) { const Ctx c = launder(c0);
#define PHASE_END   if (ph + 1 < hi) { XcdBarrier b2 = bar; unsigned long long bp = (unsigned long long)b2.bar; asm volatile("" : "+s"(bp), "+s"(b2.x)); b2.bar = (unsigned*)(GAS unsigned*)bp; xcd_barrier(b2); } } ++ph;
#define WSP(T, off) ((T*)(c.ws + (off)))

    PHASE_BEGIN p_prologue(c); { const Ctx c8 = launder(c0); p_norm<false, false, true>(c8, inptr<const float>(c8, IN_X), nullptr); } PHASE_END

#define LAYER_BODY(l) {\
        PHASE_BEGIN { pg8::StaticOrder so; so.init(WSP(const bf16_t, WS_XN), WSP(const bf16_t, WS_WIN) + (size_t)l * NPW * DM, S, NPH, DM, c.G, c.bx); \
            pg8::EpiProj E{WSP(bf16_t, WS_PROJ), 0, l == 0 ? nullptr : WSP(const unsigned long long, WS_ROUTE + RT_SS) + S}; pg8::gemm_phase<pg8::EpiProj, pg8::StaticOrder>(c.lds, c.tid, DM, so, E); } \
          { pg8::StaticOrder so; so.init(WSP(const bf16_t, WS_XN8), (const bf16_t*)(c.ws + WS_WIN + (size_t)l * NPW * DM * 2 + WIN8_OFF), S, NPB - NPH, DM / 2, c.G, c.bx); \
            pg8::EpiProj E{WSP(bf16_t, WS_PROJ), NPH, l == 0 ? nullptr : WSP(const unsigned long long, WS_ROUTE + RT_SS) + S}; pg8::gemm_phase<pg8::EpiProj, pg8::StaticOrder, true, true, true>(c.lds, c.tid, DM / 2, so, E, F8_SC_WIN, 127); } \
          { pg8::SplitKOrder so; so.nM = S / 256; so.nks = SMALL_KS; so.G = c.G; so.c = c.bx; so.A = (const char*)WSP(const bf16_t, WS_XN); so.Bt = (const char*)(WSP(const bf16_t, WS_WIN) + ((size_t)l * NPW + NPH) * DM); so.tstep = (size_t)256 * DM * 2; so.ksb = (DM / SMALL_KS) * 2; \
            pg8::EpiSmallPart E{WSP(float, WS_MERGED), l == 0 ? nullptr : WSP(const unsigned long long, WS_ROUTE + RT_SS) + S}; pg8::gemm_phase<pg8::EpiSmallPart, pg8::SplitKOrder>(c.lds, c.tid, DM / SMALL_KS, so, E, 127, 127, DM); } PHASE_END \
        PHASE_BEGIN if (c.wave >= 4) { const Ctx c5 = launder(c0); p_prep(c5, l, c5.bx * 4 + c5.wave - 4, c5.G * 4); } else { const Ctx c6 = launder(c0); p_dn_intra(c6, l); } PHASE_END \
        PHASE_BEGIN if (c.bx < 8) dn::scan_head(c, c.bx); else if (c.bx < 64) { const Ctx c7 = launder(c0); p_convert(c7, l == 0 ? 4 : 17, l == 0 ? 17 : 35, (c7.bx - 8) * 8 + c7.wave, 56 * 8); } { const Ctx c8 = launder(c0); p_select(c8, l); } PHASE_END \
        PHASE_BEGIN p_dn_post(c, l); { const Ctx c2 = launder(c0); p_attn(c2); } PHASE_END \
        PHASE_BEGIN p_attn_merge(c); PHASE_END \
        PHASE_BEGIN { pg8::StaticOrder so; so.init(WSP(const bf16_t, WS_ODN), WSP(const bf16_t, WS_WDN + (size_t)l * DM * DNW), S, DM, DNW / 2, c.G, c.bx); \
            pg8::EpiGate<false> E{WSP(bf16_t, WS_MERGED), nullptr, WSP(const bf16_t, WS_PROJ) + PC_GDN}; pg8::gemm_phase<pg8::EpiGate<false>, pg8::StaticOrder, true, true, true>(c.lds, c.tid, DNW / 2, so, E, F8_SC_WY, F8_SC_ODN); } \
          { pg8::StaticOrder so; so.init(WSP(const bf16_t, WS_OSA8), WSP(const bf16_t, WS_WSA + (size_t)l * DM * DNW), S, DM, DNW / 2, c.G, c.bx); \
            pg8::EpiGate<true> E{WSP(bf16_t, WS_MERGED), WSP(unsigned char, WS_M8), WSP(const bf16_t, WS_PROJ) + PC_GSA}; pg8::gemm_phase<pg8::EpiGate<true>, pg8::StaticOrder, true, true, true>(c.lds, c.tid, DNW / 2, so, E, F8_SC_WY, F8_SC_OSA); } PHASE_END \
        PHASE_BEGIN { pg8::StaticOrder so; so.init(WSP(const bf16_t, WS_M8), WSP(const bf16_t, WS_WO + (size_t)l * DM * DM), S, DM, DM / 2, c.G, c.bx); \
            if (l == 0) { pg8::EpiResidN<true> E{inptr<const float>(c, IN_X), WSP(float, WS_X), WSP(void, WS_XN), WSP(unsigned long long, WS_ROUTE + RT_SS), nullptr}; pg8::gemm_phase<pg8::EpiResidN<true>, pg8::StaticOrder, true, true, true>(c.lds, c.tid, DM / 2, so, E, F8_SC_WO, F8_SC_MRG); } \
            else { pg8::EpiResid E{WSP(const float, WS_X), WSP(float, WS_X)}; pg8::gemm_phase<pg8::EpiResid, pg8::StaticOrder, true, true, true>(c.lds, c.tid, DM / 2, so, E, F8_SC_WO, F8_SC_MRG); } } PHASE_END \
        if (l == 1) { PHASE_BEGIN p_norm<true, true>(c, WSP(const float, WS_X), inptr<const float>(c, IN_NORM_FFN) + DM); PHASE_END } \
        if (l == 1) { PHASE_BEGIN p_moe_dispatch(c); PHASE_END } \
        PHASE_BEGIN if (l == 0) { pg8::StaticOrder so; so.init(WSP(const bf16_t, WS_XN), WSP(const bf16_t, WS_WGU0), S, 2 * DFF, DM / 2, c.G, c.bx); \
                pg8::EpiSwiglu8 E{WSP(unsigned char, WS_HID), DFF, F8_HID, WSP(const unsigned long long, WS_ROUTE + RT_SS)}; pg8::gemm_phase<pg8::EpiSwiglu8, pg8::StaticOrder, true, true, true>(c.lds, c.tid, DM / 2, so, E, F8_SC_WGU, 127); } \
            else { LAS int* te = (LAS int*)(c.lds + MISC_OFF + 1024); const int nrt = moe_tiles(c, te); \
                pg8::GroupOrder go; go.so.init(WSP(const bf16_t, WS_AS), WSP(const bf16_t, WS_WGU1), nrt * 256, 2 * DFE, DM / 2, c.G, c.bx); go.te = te; go.estride = (size_t)2 * DFE * DM; \
                pg8::EpiSwiglu8 E{WSP(unsigned char, WS_HIDM), DFE, F8_HID, nullptr}; pg8::gemm_phase<pg8::EpiSwiglu8, pg8::GroupOrder, true, true, true>(c.lds, c.tid, DM / 2, go, E, F8_SC_WGU, 127); } PHASE_END \
        PHASE_BEGIN if (l == 0) { pg8::StaticOrder so; so.init(WSP(const bf16_t, WS_HID), WSP(const bf16_t, WS_WD0), S, DM, DFF / 2, c.G, c.bx); \
                pg8::EpiResidN<false> E{WSP(const float, WS_X), WSP(float, WS_X), WSP(void, WS_XN), WSP(unsigned long long, WS_ROUTE + RT_SS) + S, WSP(unsigned char, WS_XN8)}; pg8::gemm_phase<pg8::EpiResidN<false>, pg8::StaticOrder, true, true, true>(c.lds, c.tid, DFF / 2, so, E, F8_SC_WD, F8_SC_HID); } \
            else { LAS int* te = (LAS int*)(c.lds + MISC_OFF + 1024); const int nrt = moe_tiles(c, te); \
                pg8::GroupOrder go; go.so.init(WSP(const bf16_t, WS_HIDM), WSP(const bf16_t, WS_WD1), nrt * 256, DM, DFE / 2, c.G, c.bx); go.te = te; go.estride = (size_t)DM * DFE; \
                pg8::EpiMoeDown E{WSP(bf16_t, WS_YS), WSP(const float, WS_ROUTE + RT_ROWW)}; pg8::gemm_phase<pg8::EpiMoeDown, pg8::GroupOrder, true, true, true>(c.lds, c.tid, DFE / 2, go, E, F8_SC_WD, F8_SC_HID); } PHASE_END \
    }
    LAYER_BODY(0)
    LAYER_BODY(1)
#undef LAYER_BODY
    PHASE_BEGIN p_final(c); PHASE_END
#undef PHASE_BEGIN
#undef PHASE_END
#undef WSP
}

extern "C" void kernel_launch(void* const* d_in, const int* in_sizes, int n_in, void* d_out, int out_size, void* d_ws, size_t ws_size, hipStream_t stream) {
    static int grid = 0;
    if (grid == 0) {
        if (n_in != 20 || in_sizes[0] != S * DM || out_size != S * DM || ws_size < WS_END) { fprintf(stderr, "kernel_launch: unexpected shapes (n_in %d, in0 %d, out %d, ws %zu < %zu)\n", n_in, n_in > 0 ? in_sizes[0] : -1, out_size, ws_size, (size_t)WS_END); grid = -1; return; }
        int dev = 0, cus = 0, per_cu = 0;
        if (hipGetDevice(&dev) != hipSuccess || hipDeviceGetAttribute(&cus, hipDeviceAttributeMultiprocessorCount, dev) != hipSuccess) { grid = -1; return; }
        if (hipFuncSetAttribute((const void*)mega_fwd, hipFuncAttributeMaxDynamicSharedMemorySize, LDS_BYTES) != hipSuccess) { fprintf(stderr, "kernel_launch: hipFuncSetAttribute failed\n"); grid = -1; return; }
        if (hipOccupancyMaxActiveBlocksPerMultiprocessor(&per_cu, (const void*)mega_fwd, 512, LDS_BYTES) != hipSuccess || per_cu < 1) fprintf(stderr, "kernel_launch: occupancy query reports %d blocks per CU\n", per_cu);
        (void)hipGetLastError();
        grid = cus;
        if (grid != 256) { fprintf(stderr, "kernel_launch: %d CUs (this kernel is laid out for 256)\n", grid); grid = -1; return; }
    }
    if (grid < 0) return;
    (void)hipMemsetAsync((char*)d_ws + WS_CTL, 0, CTL_ZERO_BYTES, stream);
    Params p{};
    for (int i = 0; i < 20; ++i) p.in[i] = d_in[i];
    p.in[IN_OUT] = d_out; p.ws = (unsigned char*)d_ws; p.ph_lo = 0; p.ph_hi = N_PHASES;
    hipLaunchKernelGGL(mega_fwd, dim3(grid), dim3(512), LDS_BYTES, stream, p);
}
```

```cpp
#include <hip/hip_runtime.h>
#include <cstdio>
#include <cstdint>

#define GAS __attribute__((address_space(1)))
#define LAS __attribute__((address_space(3)))
typedef unsigned short bf16_t;
typedef short bf16x8 __attribute__((ext_vector_type(8)));
typedef float f32x2 __attribute__((ext_vector_type(2)));
typedef float f32x4 __attribute__((ext_vector_type(4)));
typedef float f32x16 __attribute__((ext_vector_type(16)));
typedef unsigned u32x2 __attribute__((ext_vector_type(2)));
typedef _Float16 h2_t __attribute__((ext_vector_type(2)));
typedef unsigned short u16x2_t __attribute__((ext_vector_type(2)));
typedef unsigned u32x4 __attribute__((ext_vector_type(4)));

constexpr int S = 8192, DM = 2048, NLAYER = 2;
constexpr int DNH = 8, HD = 128, DNW = 1024;
constexpr int IXH = 16, IXD = 64, TOPK = 256;
constexpr int DFF = 5632, NEXP = 8, DFE = 2816;
constexpr int NIN = 12384;
constexpr int NPB = 12288;
constexpr int NPW = 12544;
constexpr int NPH = 6144;
constexpr int PC_QKV = 0, PC_QSA = 3072, PC_KSA = 4096, PC_QIX = 5120, PC_Z = 6144, PC_VSA = 7168, PC_GDN = 8192, PC_GSA = 10240;
constexpr float F8_WIN = 32.f; constexpr int F8_SC_WIN = 127 - 5;
constexpr float F8_WY = 16.f, F8_WO = 32.f, F8_ODN = 4.f, F8_OSA = 16.f, F8_MRG = 8.f; constexpr int F8_SC_WY = 127 - 4, F8_SC_WO = 127 - 5, F8_SC_ODN = 127 - 2, F8_SC_OSA = 127 - 4, F8_SC_MRG = 127 - 3;
constexpr int SC_KIX = 0, SC_WIX = 64, SC_A = 80, SC_B = 88;
constexpr float RMS_EPS = 1e-6f, L2_EPS = 1e-6f;
constexpr float F8_WGU = 32.f, F8_WD = 64.f, F8_HID = 8.f; constexpr int F8_SC_WGU = 127 - 5, F8_SC_WD = 127 - 6, F8_SC_HID = 127 - 3;
constexpr int SMALL_KS = 4;
constexpr int MOE_ROWS = 2 * S + NEXP * 256;
constexpr int MOE_MAXT = MOE_ROWS / 256;

constexpr size_t MiB = 1u << 20;
constexpr size_t WS_CTL = 0, CTL_ZERO_BYTES = 1 * MiB;
constexpr size_t WS_WIN = 1 * MiB;
constexpr size_t WS_WDN = WS_WIN + 98 * MiB;
constexpr size_t WS_WSA = WS_WDN + 8 * MiB;
constexpr size_t WS_WO = WS_WSA + 8 * MiB;
constexpr size_t WS_WGU0 = WS_WO + 16 * MiB;
constexpr size_t WS_WD0 = WS_WGU0 + 44 * MiB;
constexpr size_t WS_WGU1 = WS_WD0 + 22 * MiB;
constexpr size_t WS_WD1 = WS_WGU1 + 176 * MiB;
constexpr size_t WS_X = WS_WD1 + 88 * MiB;
constexpr size_t WS_XN = WS_X + 64 * MiB;
constexpr size_t WS_PROJ = WS_XN + 32 * MiB;
constexpr size_t WS_SMALL = WS_PROJ + 192 * MiB;
constexpr size_t WS_DNQKV = WS_SMALL + 8 * MiB;
constexpr size_t WS_ODNRAW = WS_DNQKV + 48 * MiB;
constexpr size_t WS_ODN = WS_ODNRAW + 32 * MiB;
constexpr size_t WS_OSA = WS_ODN + 16 * MiB;
constexpr size_t WS_OSA8 = WS_ODN + 8 * MiB;
constexpr size_t WS_M8 = WS_ODN + 16 * MiB;
constexpr size_t WS_MASK = WS_OSA + 16 * MiB;
constexpr size_t WS_MERGED = WS_MASK + 8 * MiB;
constexpr size_t WS_KIX = WS_MERGED + 32 * MiB;
constexpr size_t WS_WIX = WS_KIX + 1 * MiB;
constexpr size_t WS_GB = WS_WIX + MiB / 2;
constexpr size_t WS_ROPE = WS_GB + MiB / 2;
constexpr size_t WS_ROUTE = WS_ROPE + 6 * MiB;
constexpr size_t WS_ODNRAW2 = WS_ROUTE + 1 * MiB;
constexpr size_t WS_GL = WS_ODNRAW2 + 32 * MiB;
constexpr size_t WS_XN8 = WS_GL + 1 * MiB;
constexpr size_t WS_END = WS_XN8 + 16 * MiB;
constexpr size_t WS_DNF = WS_DNQKV;
static_assert(1024 * 81920 == 80 * MiB, "DNF");
constexpr size_t WS_HID = WS_PROJ;
constexpr size_t WS_AS = WS_PROJ;
constexpr size_t WS_HIDM = WS_PROJ + 72 * MiB;
constexpr size_t WS_YS = WS_DNQKV;
static_assert(72 + 99 <= 192 && 72 <= 48 + 32, "overlays");
constexpr size_t RT_SEL = 0;
constexpr size_t RT_CNTB = 128 * 1024;
constexpr size_t RT_TOKROW = 160 * 1024;
constexpr size_t RT_ROWW = 256 * 1024;
constexpr size_t RT_SS = 512 * 1024;
constexpr int CW_BAR = 4096, CW_SELQ = 64;

constexpr int RING_BYTES = 131072;
constexpr int LDSCTL_OFF = RING_BYTES, MISC_OFF = LDSCTL_OFF + 320;
constexpr int LDS_BYTES = 147456;
constexpr int DN_TAB_OFF = LDSCTL_OFF + 4096;

__device__ __forceinline__ float bf2f(unsigned b) { return __uint_as_float(b << 16); }
typedef __bf16 bf16x2_t __attribute__((ext_vector_type(2)));
__device__ __forceinline__ unsigned cvt_pk_bf16_asm(float lo, float hi) { unsigned r; asm volatile("v_cvt_pk_bf16_f32 %0, %1, %2" : "=v"(r) : "v"(lo), "v"(hi)); return r; }
__device__ __forceinline__ unsigned cvt_pk_bf16(float lo, float hi) { const f32x2 v = {lo, hi}; const bf16x2_t b = __builtin_convertvector(v, bf16x2_t); return __builtin_bit_cast(unsigned, b); }
__device__ __forceinline__ unsigned cvt4_fp8(float a, float b, float c2, float d) { int w = 0; w = __builtin_amdgcn_cvt_pk_fp8_f32(a, b, w, false); w = __builtin_amdgcn_cvt_pk_fp8_f32(c2, d, w, true); return (unsigned)w; }
__device__ __forceinline__ float clamp448(float x) { return __builtin_amdgcn_fmed3f(x, -448.f, 448.f); }
__device__ __forceinline__ unsigned cvt4_fp8c(float a, float b, float c2, float d) { return cvt4_fp8(clamp448(a), clamp448(b), clamp448(c2), clamp448(d)); }
__device__ __forceinline__ bf16_t f2bf(float f) { return (bf16_t)(cvt_pk_bf16(f, 0.f) & 0xffffu); }
__device__ __forceinline__ void unpack8(const u32x4 w, float* f) {
    f[0] = __uint_as_float(w.x << 16); f[1] = __uint_as_float(w.x & 0xffff0000u); f[2] = __uint_as_float(w.y << 16); f[3] = __uint_as_float(w.y & 0xffff0000u);
    f[4] = __uint_as_float(w.z << 16); f[5] = __uint_as_float(w.z & 0xffff0000u); f[6] = __uint_as_float(w.w << 16); f[7] = __uint_as_float(w.w & 0xffff0000u); }
__device__ __forceinline__ u32x4 pack8(const float* f) { u32x4 w; w.x = cvt_pk_bf16(f[0], f[1]); w.y = cvt_pk_bf16(f[2], f[3]); w.z = cvt_pk_bf16(f[4], f[5]); w.w = cvt_pk_bf16(f[6], f[7]); return w; }
__device__ __forceinline__ float wave_sum(float v) {
#pragma unroll
    for (int o = 1; o < 64; o <<= 1) v += __shfl_xor(v, o);
    return v; }
__device__ __forceinline__ float wave_max(float v) {
#pragma unroll
    for (int o = 1; o < 64; o <<= 1) v = fmaxf(v, __shfl_xor(v, o));
    return v; }
template <int CTRL> __device__ __forceinline__ float dpp_f(float v) { return __builtin_bit_cast(float, __builtin_amdgcn_update_dpp(0, __builtin_bit_cast(int, v), CTRL, 0xF, 0xF, true)); }
__device__ __forceinline__ float row16_sum(float v) {
    v += dpp_f<0xB1>(v);
    v += dpp_f<0x4E>(v);
    v += dpp_f<0x141>(v);
    v += dpp_f<0x140>(v);
    return v; }
template <int CTRL, int RM> __device__ __forceinline__ int dpp_i(int v) { return __builtin_amdgcn_update_dpp(0, v, CTRL, RM, 0xF, false); }
__device__ __forceinline__ int wave_isum(int v) {
    v += dpp_i<0xB1, 0xF>(v); v += dpp_i<0x4E, 0xF>(v); v += dpp_i<0x141, 0xF>(v); v += dpp_i<0x140, 0xF>(v);
    v += dpp_i<0x142, 0xA>(v); v += dpp_i<0x143, 0xC>(v);
    return __builtin_amdgcn_readlane(v, 63); }
__device__ __forceinline__ float sigmoidf_(float x) { return __builtin_amdgcn_rcpf(1.f + __expf(-x)); }
__device__ __forceinline__ float siluf_(float x) { return x * sigmoidf_(x); }
#define LDS_WAIT() asm volatile("s_waitcnt lgkmcnt(0)" ::: "memory")
#define VM_WAIT() asm volatile("s_waitcnt vmcnt(0)" ::: "memory")

__constant__ double RF_SA[64] = {1.59154943091895346e-01, 1.37822502603982849e-01, 1.19349370211248862e-01, 1.03352296618434064e-01, 8.94994016088910133e-02, 7.75032887553740585e-02, 6.71150830052272551e-02, 5.81192674418762462e-02, 5.03292121044870353e-02, 4.35833021053073297e-02, 3.77415847174197711e-02, 3.26828658723569976e-02, 2.83021958306233987e-02, 2.45086918620698521e-02, 2.12236527647776604e-02, 1.83789261056796667e-02, 1.59154943091895339e-02, 1.37822502603982839e-02, 1.19349370211248862e-02, 1.03352296618434061e-02, 8.94994016088910063e-03, 7.75032887553740550e-03, 6.71150830052272534e-03, 5.81192674418762410e-03, 5.03292121044870370e-03, 4.35833021053073227e-03, 3.77415847174197719e-03, 3.26828658723569932e-03, 2.83021958306233987e-03, 2.45086918620698565e-03, 2.12236527647776578e-03, 1.83789261056796667e-03, 1.59154943091895356e-03, 1.37822502603982878e-03, 1.19349370211248871e-03, 1.03352296618434048e-03, 8.94994016088910237e-04, 7.75032887553740507e-04, 6.71150830052272490e-04, 5.81192674418762388e-04, 5.03292121044870326e-04, 4.35833021053073292e-04, 3.77415847174197687e-04, 3.26828658723569922e-04, 2.83021958306233954e-04, 2.45086918620698489e-04, 2.12236527647776578e-04, 1.83789261056796662e-04, 1.59154943091895351e-04, 1.37822502603982856e-04, 1.19349370211248862e-04, 1.03352296618434061e-04, 8.94994016088910047e-05, 7.75032887553740561e-05, 6.71150830052272545e-05, 5.81192674418762388e-05, 5.03292121044870354e-05, 4.35833021053073292e-05, 3.77415847174197768e-05, 3.26828658723569989e-05, 2.83021958306233995e-05, 2.45086918620698523e-05, 2.12236527647776592e-05, 1.83789261056796682e-05};

namespace pg8 {
constexpr int BM = 256, BK = 64, HALF = 128, HTB = HALF * BK * 2, STAGE_BYTES = 8 * HTB, NXCD = 8, WGM = 8;
__host__ __device__ __forceinline__ int lds_byte(int r, int c) { const int st = (r >> 4) * 2 + (c >> 5), rr = r & 15, cc = c & 31, ob = rr * 64 + cc * 2; return st * 1024 + (ob ^ (((ob >> 9) & 1) << 5)); }
__host__ __device__ __forceinline__ void stage_rc(int b, int& R, int& C) { const int st = b / 1024, sb = b % 1024, swz = sb ^ (((sb >> 9) & 1) << 5); R = (st >> 1) * 16 + swz / 64; C = (st & 1) * 32 + (swz % 64) / 2; }
__host__ __device__ __forceinline__ int perm32(int rho) { const int n = rho >> 4, i = rho & 15; return 8 * (i >> 2) + 4 * n + (i & 3); }

struct Unit { int pm, pn; const char* a; const char* b; };

struct StaticOrder {
    int nM, nN, nwg, G, c; const char* A; const char* Bt; size_t tstep;
    __device__ void init(const bf16_t* A_, const bf16_t* Bt_, int M, int N, int K, int G_, int c_) { nM = M / BM; nN = N / BM; nwg = nM * nN; G = G_; c = c_; A = (const char*)A_; Bt = (const char*)Bt_; tstep = (size_t)BM * K * 2; }
    __device__ bool tile(int i, int& pm, int& pn) const {
        const long L = (long)i * G + c; if (L >= nwg) return false;
        int wgid = (int)L; { const int q = nwg / NXCD, r = nwg % NXCD, xcd = wgid % NXCD, off = wgid / NXCD; wgid = (xcd < r ? xcd * (q + 1) : r * (q + 1) + (xcd - r) * q) + off; }
        const int nig = WGM * nN, gid = wgid / nig, fm = gid * WGM, gsz = (nM - fm) < WGM ? (nM - fm) : WGM;
        pm = fm + ((wgid % nig) % gsz); pn = (wgid % nig) / gsz; return true;
    }
    __device__ bool next(int i, Unit& u) const { if (!tile(i, u.pm, u.pn)) return false; u.a = A + (size_t)u.pm * tstep; u.b = Bt + (size_t)u.pn * tstep; return true; }
};
struct SplitKOrder {
    int nM, nks, G, c; const char* A; const char* Bt; size_t tstep; int ksb;
    __device__ bool next(int i, Unit& u) const { const long L = (long)i * G + c; if (L >= (long)nM * nks) return false; u.pm = (int)(L % nM); u.pn = (int)(L / nM);
        u.a = A + (size_t)u.pm * tstep + (size_t)u.pn * ksb; u.b = Bt + (size_t)u.pn * ksb; return true; }
};
struct GroupOrder {
    StaticOrder so; const LAS int* te; size_t estride;
    __device__ bool next(int i, Unit& u) const { if (!so.tile(i, u.pm, u.pn)) return false; u.a = so.A + (size_t)u.pm * so.tstep; u.b = so.Bt + (size_t)te[u.pm] * estride + (size_t)u.pn * so.tstep; return true; }
};

typedef int i32x4_t __attribute__((ext_vector_type(4)));
typedef int i32x8_t __attribute__((ext_vector_type(8)));
template <class Epi, class Sched, bool ALIGN_EPI = true, bool SP2 = true, bool F8 = false>
__device__ __forceinline__ void gemm_phase(LAS unsigned char* lds, const int tid, const int K, const Sched& S, const Epi& E, const int sW = 127, const int sX = 127, const int KP_ = 0) {
    const int wid = __builtin_amdgcn_readfirstlane(tid >> 6), lane = tid & 63, wr = wid >> 2, wc = wid & 3, fr = lane & 15, fq = lane >> 4;
    const int nt = K / BK, KP = KP_ ? KP_ : K;
    unsigned voffA[2], voffB[2];
#pragma unroll
    for (int i = 0; i < 2; ++i) { int R, C; stage_rc(tid * 16 + i * 8192, R, C); const int Rb = Epi::PERM ? ((R & ~31) + perm32(R & 31)) : R;
        voffA[i] = (unsigned)(R * KP + C) * 2u; voffB[i] = (unsigned)(Rb * KP + C) * 2u; }
    const size_t kstep = (size_t)(BK * 2);
    const size_t hstep = (size_t)HALF * KP * 2;
    const unsigned ldsw = (unsigned)wid * 1024u;
    const int aoff = lds_byte(wr * 64 + fr, fq * 8), boff = lds_byte(wc * 32 + fr, fq * 8);
#define PG8_SA(b, h) (((b) * 2 + (h)) * HTB)
#define PG8_SB(b, h) ((4 + (b) * 2 + (h)) * HTB)
#define PG8_STAGE(bufoff, gbase, voff) do { _Pragma("unroll") for (int _i = 0; _i < 2; ++_i) \
        __builtin_amdgcn_global_load_lds((const unsigned*)((const char*)(gbase) + (voff)[_i]), (LAS unsigned*)(lds + (bufoff) + ldsw + _i * 8192), 16, 0, 0); } while (0)
#define PG8_LD32(p_) PG8_CAT(*(const LAS i32x4_t*)(p_), *(const LAS i32x4_t*)((p_) + 1024))
#define PG8_LDA(dst, b, h) do { _Pragma("unroll") for (int m = 0; m < 4; ++m) dst[m] = PG8_LD32(lds + PG8_SA(b, h) + aoff + m * 2048); } while (0)
#define PG8_LDB(dst, b, h) do { _Pragma("unroll") for (int n = 0; n < 2; ++n) dst[n] = PG8_LD32(lds + PG8_SB(b, h) + boff + n * 2048); } while (0)
#define PG8_CAT(x0, x1) __builtin_shufflevector(x0, x1, 0, 1, 2, 3, 4, 5, 6, 7)
#define PG8_LO(x) __builtin_bit_cast(bf16x8, __builtin_shufflevector(x, x, 0, 1, 2, 3))
#define PG8_HI(x) __builtin_bit_cast(bf16x8, __builtin_shufflevector(x, x, 4, 5, 6, 7))
#define PG8_MMA(ai, bj, At, Bt) do { __builtin_amdgcn_s_setprio(1); _Pragma("unroll") for (int m = 0; m < 4; ++m) _Pragma("unroll") for (int n = 0; n < 2; ++n) { \
        if constexpr (F8) asm("v_mfma_scale_f32_16x16x128_f8f6f4 %0, %1, %2, %0, %3, %4 op_sel_hi:[0,0,0]" : "+v"(acc[ai][bj][m][n]) : "v"(Bt[n]), "v"(At[m]), "v"(sW), "v"(sX));   \
        else { acc[ai][bj][m][n] = __builtin_amdgcn_mfma_f32_16x16x32_bf16(PG8_LO(Bt[n]), PG8_LO(At[m]), acc[ai][bj][m][n], 0, 0, 0); acc[ai][bj][m][n] = __builtin_amdgcn_mfma_f32_16x16x32_bf16(PG8_HI(Bt[n]), PG8_HI(At[m]), acc[ai][bj][m][n], 0, 0, 0); } } __builtin_amdgcn_s_setprio(0); } while (0)
#define PG8_WAIT_V(n) asm volatile("s_waitcnt vmcnt(" #n ")" ::: "memory")
#define PG8_WAIT_L(n) asm volatile("s_waitcnt lgkmcnt(" #n ")" ::: "memory")
#define PG8_BAR __builtin_amdgcn_s_barrier()
#define PG8_SCHED __builtin_amdgcn_sched_barrier(0)
    Unit cur, nxt; int ui = 0;
    if (!S.next(0, cur)) return;
    f32x4 acc[2][2][4][2];
#pragma unroll
    for (int a = 0; a < 2; ++a)
#pragma unroll
        for (int b = 0; b < 2; ++b)
#pragma unroll
            for (int m = 0; m < 4; ++m)
#pragma unroll
                for (int n = 0; n < 2; ++n) acc[a][b][m][n] = (f32x4){0.f, 0.f, 0.f, 0.f};
    i32x8_t At[4], B0[2], B1[2];
    const char* cA = cur.a; const char* cB = cur.b;
    if constexpr (SP2) {
        PG8_STAGE(PG8_SB(0, 0), cB, voffB); PG8_STAGE(PG8_SB(0, 1), cB + hstep, voffB); PG8_STAGE(PG8_SA(0, 0), cA, voffA); PG8_STAGE(PG8_SA(0, 1), cA + hstep, voffA);
        if (wr == 1) PG8_BAR;
        PG8_WAIT_V(2); PG8_BAR;
        PG8_STAGE(PG8_SB(1, 0), cB + kstep, voffB); PG8_STAGE(PG8_SA(1, 0), cA + kstep, voffA); PG8_STAGE(PG8_SB(1, 1), cB + hstep + kstep, voffB);
        PG8_WAIT_V(6); PG8_BAR;
    } else {
        PG8_STAGE(PG8_SB(0, 0), cB, voffB); PG8_STAGE(PG8_SA(0, 0), cA, voffA); PG8_STAGE(PG8_SB(0, 1), cB + hstep, voffB); PG8_STAGE(PG8_SA(0, 1), cA + hstep, voffA);
        if (wr == 1) PG8_BAR;
        PG8_WAIT_V(4); PG8_BAR;
        PG8_STAGE(PG8_SB(1, 0), cB + kstep, voffB); PG8_STAGE(PG8_SA(1, 0), cA + kstep, voffA); PG8_STAGE(PG8_SB(1, 1), cB + hstep + kstep, voffB);
        PG8_WAIT_V(6); PG8_BAR;
    }
    for (;;) {
        const bool has_next = S.next(ui + 1, nxt);
        const char* nA = has_next ? nxt.a : cA; const char* nB = has_next ? nxt.b : cB;
        for (int t = 0; t < nt; t += 2) {
            const bool last = (t == nt - 2);
            const char* a1 = cA + (size_t)(t + 1) * kstep;
            const char* a2 = last ? nA : cA + (size_t)(t + 2) * kstep; const char* b2 = last ? nB : cB + (size_t)(t + 2) * kstep;
            const char* a3 = a2 + kstep; const char* b3 = b2 + kstep;
            if constexpr (SP2) {
            PG8_LDB(B0, 0, 0); PG8_LDB(B1, 0, 1); PG8_SCHED; PG8_LDA(At, 0, 0); PG8_STAGE(PG8_SA(1, 1), a1 + hstep, voffA);
            PG8_WAIT_V(8); PG8_WAIT_L(0); PG8_BAR; PG8_MMA(0, 0, At, B0); PG8_MMA(0, 1, At, B1); PG8_BAR; PG8_SCHED;
            PG8_LDA(At, 0, 1); PG8_STAGE(PG8_SB(0, 0), b2, voffB); PG8_STAGE(PG8_SB(0, 1), b2 + hstep, voffB); PG8_STAGE(PG8_SA(0, 0), a2, voffA);
            PG8_WAIT_V(8); PG8_WAIT_L(0); PG8_BAR; PG8_MMA(1, 0, At, B0); PG8_MMA(1, 1, At, B1); PG8_BAR; PG8_SCHED;
            PG8_LDB(B0, 1, 0); PG8_LDB(B1, 1, 1); PG8_SCHED; PG8_LDA(At, 1, 0); PG8_STAGE(PG8_SA(0, 1), a2 + hstep, voffA);
            PG8_WAIT_V(8); PG8_WAIT_L(0); PG8_BAR; PG8_MMA(0, 0, At, B0); PG8_MMA(0, 1, At, B1); PG8_BAR; PG8_SCHED;
            PG8_LDA(At, 1, 1); PG8_STAGE(PG8_SB(1, 0), b3, voffB); PG8_STAGE(PG8_SB(1, 1), b3 + hstep, voffB); PG8_STAGE(PG8_SA(1, 0), a3, voffA);
            PG8_WAIT_V(8); PG8_WAIT_L(0); PG8_BAR; PG8_MMA(1, 0, At, B0); PG8_MMA(1, 1, At, B1); PG8_BAR; PG8_SCHED;
            } else {
            PG8_LDB(B0, 0, 0); PG8_SCHED; PG8_LDA(At, 0, 0); PG8_STAGE(PG8_SA(1, 1), a1 + hstep, voffA);
            PG8_WAIT_L(8); PG8_BAR; PG8_WAIT_L(0); PG8_MMA(0, 0, At, B0); PG8_BAR; PG8_SCHED;
            PG8_LDB(B1, 0, 1); PG8_STAGE(PG8_SB(0, 0), b2, voffB);
            PG8_BAR; PG8_WAIT_L(0); PG8_MMA(0, 1, At, B1); PG8_BAR;
            PG8_LDA(At, 0, 1); PG8_STAGE(PG8_SA(0, 0), a2, voffA);
            PG8_BAR; PG8_WAIT_L(0); PG8_MMA(1, 0, At, B0); PG8_BAR; PG8_SCHED;
            PG8_STAGE(PG8_SB(0, 1), b2 + hstep, voffB);
            PG8_WAIT_V(6); PG8_BAR; PG8_MMA(1, 1, At, B1); PG8_BAR;
            PG8_LDB(B0, 1, 0); PG8_SCHED; PG8_LDA(At, 1, 0); PG8_STAGE(PG8_SA(0, 1), a2 + hstep, voffA);
            PG8_WAIT_L(8); PG8_BAR; PG8_WAIT_L(0); PG8_MMA(0, 0, At, B0); PG8_BAR; PG8_SCHED;
            PG8_LDB(B1, 1, 1); PG8_STAGE(PG8_SB(1, 0), b3, voffB);
            PG8_BAR; PG8_WAIT_L(0); PG8_MMA(0, 1, At, B1); PG8_BAR;
            PG8_LDA(At, 1, 1); PG8_STAGE(PG8_SA(1, 0), a3, voffA);
            PG8_BAR; PG8_WAIT_L(0); PG8_MMA(1, 0, At, B0); PG8_BAR; PG8_SCHED;
            PG8_STAGE(PG8_SB(1, 1), b3 + hstep, voffB);
            PG8_WAIT_V(6); PG8_BAR; PG8_MMA(1, 1, At, B1); PG8_BAR;
            }
        }
        if constexpr (ALIGN_EPI) { if (wr == 0) PG8_BAR; }
        if constexpr (F8) asm volatile("s_nop 15\n\ts_nop 15" ::: "memory");
        E(acc, cur, wr, wc, fr, fq);
        if (!has_next) break;
#pragma unroll
        for (int a = 0; a < 2; ++a)
#pragma unroll
            for (int b = 0; b < 2; ++b)
#pragma unroll
                for (int m = 0; m < 4; ++m)
#pragma unroll
                    for (int n = 0; n < 2; ++n) acc[a][b][m][n] = (f32x4){0.f, 0.f, 0.f, 0.f};
        cur = nxt; cA = nA; cB = nB; ++ui;
        if constexpr (ALIGN_EPI) { if (wr == 1) PG8_BAR; }
    }
    PG8_WAIT_V(0);
    if constexpr (!ALIGN_EPI) { if (wr == 0) PG8_BAR; }
    PG8_BAR;
#undef PG8_SA
#undef PG8_SB
#undef PG8_STAGE
#undef PG8_LDA
#undef PG8_LDB
#undef PG8_MMA
#undef PG8_CAT
#undef PG8_LO
#undef PG8_HI
#undef PG8_LD32
#undef PG8_WAIT_V
#undef PG8_WAIT_L
#undef PG8_BAR
#undef PG8_SCHED
}

typedef const f32x4 (&AccRef)[2][2][4][2];
struct EpiProj {
    static constexpr bool PERM = true;
    bf16_t* P; int coff; const unsigned long long* SS;
    __device__ __forceinline__ void operator()(AccRef acc, const Unit& u, int wr, int wc, int fr, int fq) const {
        asm volatile("" : "+v"(fr), "+v"(fq));
        const int row0 = u.pm * BM + wr * 64 + fr, cl = wc * 32 + 8 * fq;
#pragma unroll
        for (int ai = 0; ai < 2; ++ai)
#pragma unroll
            for (int m = 0; m < 4; ++m) { const int rr = row0 + ai * HALF + m * 16; const float rs = SS ? rsqrtf((float)SS[rr] * (1.f / (1048576.f * DM)) + RMS_EPS) : 1.f; bf16_t* rowp = P + (size_t)rr * NPB + coff + u.pn * BM + cl;
#pragma unroll
                for (int bj = 0; bj < 2; ++bj) { const f32x4 v0 = acc[ai][bj][m][0] * rs, v1 = acc[ai][bj][m][1] * rs;
                    u32x4 w; w.x = cvt_pk_bf16(v0[0], v0[1]); w.y = cvt_pk_bf16(v0[2], v0[3]); w.z = cvt_pk_bf16(v1[0], v1[1]); w.w = cvt_pk_bf16(v1[2], v1[3]);
                    *(u32x4*)(rowp + bj * HALF) = w; } }
    }
};
struct EpiSmallPart {
    static constexpr bool PERM = true;
    float* SP; const unsigned long long* SS;
    __device__ __forceinline__ void operator()(AccRef acc, const Unit& u, int wr, int wc, int fr, int fq) const {
        asm volatile("" : "+v"(fr), "+v"(fq));
        const int row0 = u.pm * BM + wr * 64 + fr, cl = wc * 32 + 8 * fq;
#pragma unroll
        for (int ai = 0; ai < 2; ++ai)
#pragma unroll
            for (int m = 0; m < 4; ++m) { const int rr = row0 + ai * HALF + m * 16; const float rs = SS ? rsqrtf((float)SS[rr] * (1.f / (1048576.f * DM)) + RMS_EPS) : 1.f;
                float* rowp = SP + ((size_t)u.pn * S + rr) * 128 + cl; *(f32x4*)rowp = acc[ai][0][m][0] * rs; *(f32x4*)(rowp + 4) = acc[ai][0][m][1] * rs; }
    }
};
template <bool ADD> struct EpiGate {
    static constexpr bool PERM = true;
    bf16_t* MT; unsigned char* M8; const bf16_t* Gt;
    __device__ __forceinline__ void operator()(AccRef acc, const Unit& u, int wr, int wc, int fr, int fq) const {
        asm volatile("" : "+v"(fr), "+v"(fq));
        const int row0 = u.pm * BM + wr * 64 + fr, col0 = u.pn * BM + wc * 32 + 8 * fq;
#pragma unroll
        for (int ai = 0; ai < 2; ++ai)
#pragma unroll
            for (int m = 0; m < 4; ++m) { const size_t r = (size_t)(row0 + ai * HALF + m * 16);
#pragma unroll
                for (int bj = 0; bj < 2; ++bj) {
                    float g[8], o[8]; unpack8(*(const u32x4*)(Gt + r * NPB + col0 + bj * HALF), g);
                    const f32x4 v0 = acc[ai][bj][m][0], v1 = acc[ai][bj][m][1];
                    bf16_t* op = MT + r * DM + col0 + bj * HALF;
                    if (ADD) unpack8(*(const u32x4*)op, o); else { for (int j = 0; j < 8; ++j) o[j] = 0.f; }
#pragma unroll
                    for (int j = 0; j < 4; ++j) { o[j] += sigmoidf_(g[j]) * v0[j]; o[4 + j] += sigmoidf_(g[4 + j]) * v1[j]; }
                    if (ADD) { u32x2 w; w.x = cvt4_fp8c(F8_MRG * o[0], F8_MRG * o[1], F8_MRG * o[2], F8_MRG * o[3]); w.y = cvt4_fp8c(F8_MRG * o[4], F8_MRG * o[5], F8_MRG * o[6], F8_MRG * o[7]); *(u32x2*)(M8 + r * DM + col0 + bj * HALF) = w; }
                    else *(u32x4*)op = pack8(o); } }
    }
};
struct EpiResid {
    static constexpr bool PERM = false;
    const float* Xin; float* Xout;
    __device__ __forceinline__ void operator()(AccRef acc, const Unit& u, int wr, int wc, int fr, int fq) const {
        asm volatile("" : "+v"(fr), "+v"(fq));
        const int row0 = u.pm * BM + wr * 64 + fr, col0 = u.pn * BM + wc * 32 + 4 * fq;
#pragma unroll
        for (int ai = 0; ai < 2; ++ai)
#pragma unroll
            for (int m = 0; m < 4; ++m) { const size_t off = (size_t)(row0 + ai * HALF + m * 16) * DM + col0;
#pragma unroll
                for (int bj = 0; bj < 2; ++bj)
#pragma unroll
                    for (int n = 0; n < 2; ++n) { const f32x4 b = *(const f32x4*)(Xin + off + bj * HALF + n * 16); *(f32x4*)(Xout + off + bj * HALF + n * 16) = b + acc[ai][bj][m][n]; } }
    }
};
template <bool F8OUT> struct EpiResidN {
    static constexpr bool PERM = false;
    const float* Xin; float* Xout; void* XL; unsigned long long* SS; unsigned char* XL8;
    __device__ __forceinline__ void operator()(AccRef acc, const Unit& u, int wr, int wc, int fr, int fq) const {
        asm volatile("" : "+v"(fr), "+v"(fq));
        const int row0 = u.pm * BM + wr * 64 + fr, col0 = u.pn * BM + wc * 32 + 4 * fq;
#pragma unroll
        for (int ai = 0; ai < 2; ++ai)
#pragma unroll
            for (int m = 0; m < 4; ++m) { const int rr = row0 + ai * HALF + m * 16; const size_t off = (size_t)rr * DM + col0; float ss = 0.f;
#pragma unroll
                for (int bj = 0; bj < 2; ++bj)
#pragma unroll
                    for (int n = 0; n < 2; ++n) { const f32x4 b = *(const f32x4*)(Xin + off + bj * HALF + n * 16); const f32x4 v = b + acc[ai][bj][m][n]; *(f32x4*)(Xout + off + bj * HALF + n * 16) = v;
                        ss += (v[0] * v[0] + v[1] * v[1]) + (v[2] * v[2] + v[3] * v[3]);
                        if (F8OUT) *(unsigned*)((unsigned char*)XL + off + bj * HALF + n * 16) = cvt4_fp8c(v[0], v[1], v[2], v[3]);
                        else { u32x2 w; w.x = cvt_pk_bf16(v[0], v[1]); w.y = cvt_pk_bf16(v[2], v[3]); *(u32x2*)((bf16_t*)XL + off + bj * HALF + n * 16) = w; if (XL8) *(unsigned*)(XL8 + off + bj * HALF + n * 16) = cvt4_fp8c(v[0], v[1], v[2], v[3]); } }
                ss += __shfl_xor(ss, 16); ss += __shfl_xor(ss, 32);
                if (fq == 0) atomicAdd(SS + rr, (unsigned long long)(ss * 1048576.f)); }
    }
};
struct EpiSwiglu {
    static constexpr bool PERM = true;
    bf16_t* H; int ldh;
    __device__ __forceinline__ void operator()(AccRef acc, const Unit& u, int wr, int wc, int fr, int fq) const {
        asm volatile("" : "+v"(fr), "+v"(fq));
        const int row0 = u.pm * BM + wr * 64 + fr, col0 = u.pn * HALF + wc * 32 + 8 * fq;
#pragma unroll
        for (int ai = 0; ai < 2; ++ai)
#pragma unroll
            for (int m = 0; m < 4; ++m) { float o[8];
#pragma unroll
                for (int n = 0; n < 2; ++n)
#pragma unroll
                    for (int j = 0; j < 4; ++j) o[4 * n + j] = siluf_(acc[ai][0][m][n][j]) * acc[ai][1][m][n][j];
                *(u32x4*)(H + (size_t)(row0 + ai * HALF + m * 16) * ldh + col0) = pack8(o); }
    }
};
struct EpiSwiglu8 {
    static constexpr bool PERM = true;
    unsigned char* H; int ldh; float hs; const unsigned long long* SS;
    __device__ __forceinline__ void operator()(AccRef acc, const Unit& u, int wr, int wc, int fr, int fq) const {
        asm volatile("" : "+v"(fr), "+v"(fq));
        const int row0 = u.pm * BM + wr * 64 + fr, col0 = u.pn * HALF + wc * 32 + 8 * fq;
#pragma unroll
        for (int ai = 0; ai < 2; ++ai)
#pragma unroll
            for (int m = 0; m < 4; ++m) { float o[8]; const float rs = SS ? rsqrtf((float)SS[row0 + ai * HALF + m * 16] * (1.f / (1048576.f * DM)) + RMS_EPS) : 1.f;
#pragma unroll
                for (int n = 0; n < 2; ++n)
#pragma unroll
                    for (int j = 0; j < 4; ++j) o[4 * n + j] = hs * siluf_(acc[ai][0][m][n][j] * rs) * (acc[ai][1][m][n][j] * rs);
                u32x2 w; w.x = cvt4_fp8c(o[0], o[1], o[2], o[3]); w.y = cvt4_fp8c(o[4], o[5], o[6], o[7]);
                *(u32x2*)(H + (size_t)(row0 + ai * HALF + m * 16) * ldh + col0) = w; }
    }
};
struct EpiMoeDown {
    static constexpr bool PERM = true;
    bf16_t* Y; const float* roww;
    __device__ __forceinline__ void operator()(AccRef acc, const Unit& u, int wr, int wc, int fr, int fq) const {
        asm volatile("" : "+v"(fr), "+v"(fq));
        const int row0 = u.pm * BM + wr * 64 + fr, col0 = u.pn * BM + wc * 32 + 8 * fq;
#pragma unroll
        for (int ai = 0; ai < 2; ++ai)
#pragma unroll
            for (int m = 0; m < 4; ++m) { const size_t r = (size_t)(row0 + ai * HALF + m * 16); const float w = roww[r];
#pragma unroll
                for (int bj = 0; bj < 2; ++bj) { float o[8];
#pragma unroll
                    for (int j = 0; j < 4; ++j) { o[j] = w * acc[ai][bj][m][0][j]; o[4 + j] = w * acc[ai][bj][m][1][j]; }
                    *(u32x4*)(Y + r * DM + col0 + bj * HALF) = pack8(o); } }
    }
};
}

#define XB_TMO      128
#define XB_XCNT(j)  (256  + 64 * (j))
#define XB_XSUB(j)  (1280 + 64 * (j))
#define XB_XGEN(j)  (2304 + 64 * (j))
#define XB_TOP      3328
#define XB_TOPGEN   3392
#define XCD_BAR_WORDS 3456
#define XB_SPIN_CAP (1u << 22)
__device__ __forceinline__ unsigned xb_ld(unsigned* p)              { return __hip_atomic_load(p, __ATOMIC_RELAXED, __HIP_MEMORY_SCOPE_AGENT); }
__device__ __forceinline__ unsigned xb_add(unsigned* p, unsigned v) { return __hip_atomic_fetch_add(p, v, __ATOMIC_RELAXED, __HIP_MEMORY_SCOPE_AGENT); }
__device__ __forceinline__ unsigned xb_xcc_id() { return (unsigned)__builtin_amdgcn_s_getreg((3 << 11) | 20) & 0xFu; }
#define XB_SPIN(cond, bar) do { unsigned _sp = 0; while (cond) { __builtin_amdgcn_s_sleep(1); \
    if ((++_sp & 255u) == 0u) { if (xb_ld(&(bar)[XB_TMO])) break; if (_sp > XB_SPIN_CAP) { atomicAdd(&(bar)[XB_TMO], 1u); break; } } } } while (0)
struct XcdBarrier { unsigned* bar; unsigned x; volatile LAS unsigned* st; };
__device__ __forceinline__ XcdBarrier xcd_barrier_post(unsigned* bar, volatile LAS unsigned* st) {
    XcdBarrier b; b.bar = bar; b.x = xb_xcc_id(); b.st = st;
    if (threadIdx.x == 0) (void)xb_add(&bar[XB_XCNT(b.x)], 1u);
    return b;
}
__device__ __forceinline__ void xcd_barrier_complete(unsigned* bar, unsigned x, unsigned& nloc, unsigned& nx) {
    const unsigned G = gridDim.x * gridDim.y * gridDim.z;
    unsigned sum, cnt, mine, sp = 0u;
    for (;;) {
        sum = 0u; cnt = 0u; mine = 0u;
#pragma unroll
        for (unsigned j = 0; j < 16; ++j) { const unsigned c = xb_ld(&bar[XB_XCNT(j)]); sum += c; cnt += (c > 0u) ? 1u : 0u; mine = (j == x) ? c : mine; }
        if (sum == G) break;
        __builtin_amdgcn_s_sleep(1);
        if ((++sp & 255u) == 0u) { if (xb_ld(&bar[XB_TMO])) break; if (sp > XB_SPIN_CAP) { atomicAdd(&bar[XB_TMO], 1u); break; } }
    }
    nloc = mine > 0u ? mine : 1u; nx = cnt > 0u ? cnt : 1u;
}
__device__ __forceinline__ void xcd_barrier(const XcdBarrier& b) {
    asm volatile("s_waitcnt vmcnt(0)" ::: "memory");
    __syncthreads();
    if (threadIdx.x == 0) {
        unsigned* bar = b.bar;
        __builtin_amdgcn_s_waitcnt(0);
        unsigned nloc = b.st[0], nx = b.st[1];
        if (nloc == 0u) { xcd_barrier_complete(bar, b.x, nloc, nx); b.st[0] = nloc; b.st[1] = nx; }
        const unsigned old = xb_add(&bar[XB_XSUB(b.x)], 1u);
        const unsigned gen = old / nloc;
        if (old + 1u == (gen + 1u) * nloc) {
            __builtin_amdgcn_fence(__ATOMIC_RELEASE, "agent");
            asm volatile("s_waitcnt vmcnt(0)" ::: "memory");
            const unsigned og = xb_add(&bar[XB_TOP], 1u);
            const unsigned tg = og / nx;
            if (og + 1u == (tg + 1u) * nx) xb_add(&bar[XB_TOPGEN], 1u);
            else XB_SPIN(xb_ld(&bar[XB_TOPGEN]) == tg, bar);
            __builtin_amdgcn_fence(__ATOMIC_ACQUIRE, "agent");
            xb_add(&bar[XB_XGEN(b.x)], 1u);
            asm volatile("s_waitcnt vmcnt(0)" ::: "memory");
        } else {
            XB_SPIN(xb_ld(&bar[XB_XGEN(b.x)]) == gen, bar);
            __builtin_amdgcn_fence(__ATOMIC_ACQUIRE, "agent");
            asm volatile("s_waitcnt vmcnt(0)" ::: "memory");
        }
    }
    __syncthreads();
}

struct Ctx { LAS unsigned char* lds; unsigned char* ws; int tid, lane, wave, G, gw, NGW, bx; };
enum { IN_X = 0, IN_POS, IN_NORM_MIX, IN_W_IN, IN_CONV_W, IN_A_LOG, IN_DT_BIAS, IN_DN_NORM, IN_W_DN_OUT, IN_W_SA_OUT, IN_W_O, IN_NORM_FFN, IN_DW_GATE, IN_DW_UP, IN_DW_DOWN,
       IN_ROUTER, IN_MW_GATE, IN_MW_UP, IN_MW_DOWN, IN_FINAL_NORM, IN_OUT, IN_COUNT };
constexpr int PTAB_OFF = 131072 + 512;
__device__ __forceinline__ Ctx launder(const Ctx& c0) { Ctx c = c0; int wv = c0.wave; asm volatile("" : "+s"(wv)); c.wave = wv;
    c.lane = (int)__builtin_amdgcn_mbcnt_hi(~0u, __builtin_amdgcn_mbcnt_lo(~0u, 0u)); asm volatile("" : "+v"(c.lane)); c.tid = c.wave * 64 + c.lane;
    asm volatile("" : "+s"(c.G)); { unsigned la = (unsigned)(unsigned long long)c.lds; asm volatile("" : "+s"(la)); c.lds = (LAS unsigned char*)(unsigned long long)la; } unsigned long long w = (unsigned long long)c.ws; asm volatile("" : "+s"(w)); c.ws = (unsigned char*)(GAS unsigned char*)w; int bx = c0.bx; asm volatile("" : "+s"(bx)); c.bx = bx; c.gw = bx * 8 + c.wave; c.NGW = c.G * 8; return c; }
template <class T> __device__ __forceinline__ T* inptr(const Ctx& c, int i) {
    const LAS unsigned* tab = (const LAS unsigned*)(c.lds + PTAB_OFF); unsigned lo = tab[2 * i], hi = tab[2 * i + 1];
    lo = __builtin_amdgcn_readfirstlane(lo); hi = __builtin_amdgcn_readfirstlane(hi); return (T*)(GAS T*)(((unsigned long long)hi << 32) | lo); }
struct Params { const void* in[IN_COUNT]; unsigned char* ws; int ph_lo, ph_hi; };

__device__ __forceinline__ int map_win(int n) {
    if (n < 3072) return PC_QKV + n;
    if (n < 4096) return PC_Z + (n - 3072);
    if (n < 4104) return NPB + SC_A + (n - 4096);
    if (n < 4112) return NPB + SC_B + (n - 4104);
    if (n < 5136) return PC_QSA + (n - 4112);
    if (n < 6160) return PC_KSA + (n - 5136);
    if (n < 7184) return PC_VSA + (n - 6160);
    if (n < 8208) return PC_QIX + (n - 7184);
    if (n < 8272) return NPB + SC_KIX + (n - 8208);
    if (n < 8288) return NPB + SC_WIX + (n - 8272);
    return PC_GDN + (n - 8288);
}
constexpr size_t WIN8_OFF = (size_t)(NPH + 256) * DM * 2;
__device__ __forceinline__ void ti_load(const float* W, int N, const float* gain, int nblk, int item, int lane, float (&v_)[32], f32x4 (&gv)[2]) {
    const int kb = item / nblk, nb = item % nblk, k0 = 64 * kb, n0 = 32 * nb;
#pragma unroll
    for (int i = 0; i < 32; ++i) v_[i] = __builtin_nontemporal_load(W + (size_t)(k0 + 2 * i + (lane >> 5)) * N + n0 + (lane & 31));
    if (gain) { const float* g = gain + k0 + 8 * (lane & 7); gv[0] = *(const f32x4*)g; gv[1] = *(const f32x4*)(g + 4); }
    else { const f32x4 o1 = {1.f, 1.f, 1.f, 1.f}; gv[0] = o1; gv[1] = o1; }
}
__device__ __forceinline__ void ti_store(const float (&v_)[32], const f32x4 (&gv)[2], int K, bf16_t* WT, int mode, LAS float* scr, int nblk, int item, int lane, const float f8s) {
    const int kb = item / nblk, nb = item % nblk, k0 = 64 * kb, n0 = 32 * nb;
#pragma unroll
    for (int i = 0; i < 32; ++i) scr[(2 * i + (lane >> 5)) * 33 + (lane & 31)] = v_[i];
    LDS_WAIT(); asm volatile("" ::: "memory");
    const int c = lane & 7;
#pragma unroll
    for (int j = 0; j < 4; ++j) { const int nl = (lane >> 3) + 8 * j, n = n0 + nl; const LAS float* s0_ = scr + (8 * c) * 33 + nl;
        float e[8];
#pragma unroll
        for (int q = 0; q < 8; ++q) e[q] = s0_[q * 33] * (q < 4 ? gv[0][q & 3] : gv[1][q & 3]);
        int row = n; float f8r = f8s; unsigned char* W8 = (unsigned char*)WT;
        if (mode == 1) { const int R = map_win(n); if (R >= NPH && R < NPB) { row = R - NPH; f8r = F8_WIN; W8 = (unsigned char*)WT + WIN8_OFF; } else row = R < NPH ? R : NPH + (R - NPB); }
        else if (mode == 2) row = (n >> 7) * 256 + (n & 127); else if (mode == 3) row = (n >> 7) * 256 + 128 + (n & 127);
        if (f8r != 0.f) { const float f8s = f8r; unsigned char* WTb = W8; u32x2 o; o.x = cvt4_fp8(f8s * e[0], f8s * e[1], f8s * e[2], f8s * e[3]); o.y = cvt4_fp8(f8s * e[4], f8s * e[5], f8s * e[6], f8s * e[7]);
            *(u32x2*)(WTb + (size_t)row * K + k0 + 8 * c) = o; }
        else { u32x4 o; o.x = cvt_pk_bf16(e[0], e[1]); o.y = cvt_pk_bf16(e[2], e[3]); o.z = cvt_pk_bf16(e[4], e[5]); o.w = cvt_pk_bf16(e[6], e[7]);
            *(u32x4*)(WT + (size_t)row * K + k0 + 8 * c) = o; } }
    LDS_WAIT(); asm volatile("" ::: "memory");
}
__device__ __forceinline__ void p_convert(const Ctx& c, const int j0, const int j1, const int wk, const int nwk) {
    unsigned char* ws = c.ws;
    LAS float* scr = (LAS float*)(c.lds + c.wave * 16384);
    for (int j = j0; j < j1; ++j) {
        const float* src; bf16_t* dst; const float* gain = nullptr; int K, N, mode = 0; float f8s = 0.f;
        if (j < 8) { const int l = j >> 2, k = j & 3;
            if (k == 0) { src = inptr<const float>(c, IN_W_IN) + (size_t)l * DM * NIN; dst = (bf16_t*)(ws + WS_WIN) + (size_t)l * NPW * DM; gain = inptr<const float>(c, IN_NORM_MIX) + l * DM; K = DM; N = NIN; mode = 1; }
            else if (k == 1) { src = inptr<const float>(c, IN_W_DN_OUT) + (size_t)l * DNW * DM; dst = (bf16_t*)(ws + WS_WDN + (size_t)l * DM * DNW); K = DNW; N = DM; f8s = F8_WY; }
            else if (k == 2) { src = inptr<const float>(c, IN_W_SA_OUT) + (size_t)l * DNW * DM; dst = (bf16_t*)(ws + WS_WSA + (size_t)l * DM * DNW); K = DNW; N = DM; f8s = F8_WY; }
            else { src = inptr<const float>(c, IN_W_O) + (size_t)l * DM * DM; dst = (bf16_t*)(ws + WS_WO + (size_t)l * DM * DM); K = DM; N = DM; f8s = F8_WO; }
        } else if (j < 11) { const int k = j - 8;
            if (k == 0) { src = inptr<const float>(c, IN_DW_GATE); dst = (bf16_t*)(ws + WS_WGU0); gain = inptr<const float>(c, IN_NORM_FFN); K = DM; N = DFF; mode = 2; f8s = F8_WGU; }
            else if (k == 1) { src = inptr<const float>(c, IN_DW_UP); dst = (bf16_t*)(ws + WS_WGU0); gain = inptr<const float>(c, IN_NORM_FFN); K = DM; N = DFF; mode = 3; f8s = F8_WGU; }
            else { src = inptr<const float>(c, IN_DW_DOWN); dst = (bf16_t*)(ws + WS_WD0); K = DFF; N = DM; f8s = F8_WD; }
        } else { const int e = (j - 11) / 3, k = (j - 11) % 3;
            if (k == 0) { src = inptr<const float>(c, IN_MW_GATE) + (size_t)e * DM * DFE; dst = (bf16_t*)(ws + WS_WGU1 + (size_t)e * 2 * DFE * DM); gain = inptr<const float>(c, IN_NORM_FFN) + DM; K = DM; N = DFE; mode = 2; f8s = F8_WGU; }
            else if (k == 1) { src = inptr<const float>(c, IN_MW_UP) + (size_t)e * DM * DFE; dst = (bf16_t*)(ws + WS_WGU1 + (size_t)e * 2 * DFE * DM); gain = inptr<const float>(c, IN_NORM_FFN) + DM; K = DM; N = DFE; mode = 3; f8s = F8_WGU; }
            else { src = inptr<const float>(c, IN_MW_DOWN) + (size_t)e * DFE * DM; dst = (bf16_t*)(ws + WS_WD1 + (size_t)e * DM * DFE); K = DFE; N = DM; f8s = F8_WD; }
        }
        const int nitems = (K / 64) * (N / 32), nblk = N / 32;
        for (int it = wk; it < nitems; it += 2 * nwk) { float va[32], vb[32]; f32x4 ga[2], gb[2]; const int itb = it + nwk;
            ti_load(src, N, gain, nblk, it, c.lane, va, ga); if (itb < nitems) ti_load(src, N, gain, nblk, itb, c.lane, vb, gb);
            ti_store(va, ga, K, dst, mode, scr, nblk, it, c.lane, f8s); if (itb < nitems) ti_store(vb, gb, K, dst, mode, scr, nblk, itb, c.lane, f8s); }
    }
}
__device__ __forceinline__ void p_prologue(const Ctx& c) {
    unsigned char* ws = c.ws;
    p_convert(c, 0, 4, c.gw, c.NGW);
    for (int l = 0; l < NLAYER; ++l) { u32x4* z = (u32x4*)((bf16_t*)(ws + WS_WIN) + ((size_t)l * NPW + NPH + 96) * DM); const int n16 = (256 - 96) * DM / 8;
        for (int i = c.gw * 64 + c.lane; i < n16; i += c.NGW * 64) z[i] = (u32x4){0u, 0u, 0u, 0u}; }
    { unsigned long long* ss = (unsigned long long*)(ws + WS_ROUTE + RT_SS); for (int i = c.gw * 64 + c.lane; i < 2 * S; i += c.NGW * 64) ss[i] = 0ull; }
    float* rope = (float*)(ws + WS_ROPE); const int* posp = inptr<const int>(c, IN_POS);
    for (int i = c.gw * 64 + c.lane; i < S * 96; i += c.NGW * 64) { const int t = i / 96, k = i % 96;
        const double rf = k < 64 ? RF_SA[k] : RF_SA[2 * (k - 64)];
        double fr = (double)posp[t] * rf; fr -= __builtin_rint(fr); const float ff = (float)fr;
        const float cs = __builtin_amdgcn_cosf(ff), sn = __builtin_amdgcn_sinf(ff);
        if (k < 64) { rope[(size_t)t * 192 + k] = cs; rope[(size_t)t * 192 + 64 + k] = sn; } else { rope[(size_t)t * 192 + 128 + (k - 64)] = cs; rope[(size_t)t * 192 + 160 + (k - 64)] = sn; } }
}

template <bool ROUTER, bool F8OUT, bool BOTH = false>
__device__ __forceinline__ void p_norm(const Ctx& c, const float* X, const float* gain_r) {
    bf16_t* XN = (bf16_t*)(c.ws + WS_XN); const float* router = ROUTER ? inptr<const float>(c, IN_ROUTER) : nullptr;
    LAS int* lsel = (LAS int*)(c.lds);
    for (int it = 0; it < S / (8 * c.G) + 1; ++it) {
        const int t = (it * c.G + c.bx) * 8 + c.wave;
        if (t >= S) break;
        const f32x4* xr = (const f32x4*)(X + (size_t)t * DM) + c.lane;
        f32x4 v[8]; float ss = 0.f;
#pragma unroll
        for (int j = 0; j < 8; ++j) { v[j] = xr[64 * j]; ss += (v[j].x * v[j].x + v[j].y * v[j].y) + (v[j].z * v[j].z + v[j].w * v[j].w); }
        const float rstd = rsqrtf(wave_sum(ss) * (1.f / DM) + RMS_EPS);
        if constexpr (F8OUT) { unsigned* o4 = (unsigned*)((unsigned char*)XN + (size_t)t * DM) + c.lane;
#pragma unroll
            for (int j = 0; j < 8; ++j) o4[64 * j] = cvt4_fp8c(v[j].x * rstd, v[j].y * rstd, v[j].z * rstd, v[j].w * rstd); }
        else { u32x2* o8 = (u32x2*)(XN + (size_t)t * DM) + c.lane;
#pragma unroll
            for (int j = 0; j < 8; ++j) { u32x2 w; w.x = cvt_pk_bf16(v[j].x * rstd, v[j].y * rstd); w.y = cvt_pk_bf16(v[j].z * rstd, v[j].w * rstd); o8[64 * j] = w; }
            if constexpr (BOTH) { unsigned* o4 = (unsigned*)(c.ws + WS_XN8 + (size_t)t * DM) + c.lane;
#pragma unroll
                for (int j = 0; j < 8; ++j) o4[64 * j] = cvt4_fp8c(v[j].x * rstd, v[j].y * rstd, v[j].z * rstd, v[j].w * rstd); } }
        if constexpr (ROUTER) {
            float lg[NEXP];
#pragma unroll
            for (int e = 0; e < NEXP; ++e) lg[e] = 0.f;
#pragma unroll
            for (int j = 0; j < 8; ++j)
#pragma unroll
                for (int q = 0; q < 4; ++q) { const int k = 256 * j + 4 * c.lane + q; const float xv = v[j][q] * gain_r[k]; const f32x4* wr = (const f32x4*)(router + (size_t)k * NEXP); const f32x4 w0 = wr[0], w1 = wr[1];
                    lg[0] += xv * w0.x; lg[1] += xv * w0.y; lg[2] += xv * w0.z; lg[3] += xv * w0.w; lg[4] += xv * w1.x; lg[5] += xv * w1.y; lg[6] += xv * w1.z; lg[7] += xv * w1.w; }
#pragma unroll
            for (int e = 0; e < NEXP; ++e) lg[e] = wave_sum(lg[e]) * rstd;
            int e0 = 0; float v0 = lg[0];
#pragma unroll
            for (int e = 1; e < NEXP; ++e) if (lg[e] > v0) { v0 = lg[e]; e0 = e; }
            int e1 = -1; float v1 = -__builtin_inff();
#pragma unroll
            for (int e = 0; e < NEXP; ++e) if (e != e0 && lg[e] > v1) { v1 = lg[e]; e1 = e; }
            const float w0 = 1.f / (1.f + __expf(v1 - v0)), w1 = 1.f - w0;
            if (c.lane == 0) { u32x4 r; r.x = (unsigned)e0; r.y = (unsigned)e1; r.z = __float_as_uint(w0); r.w = __float_as_uint(w1); *(u32x4*)(c.ws + WS_ROUTE + RT_SEL + (size_t)t * 16) = r; }
        }
    }
}

__device__ __forceinline__ void p_prep(const Ctx& c, int layer, const int w0, const int nw) {
    unsigned char* ws = c.ws;
    const bf16_t* PROJ = (const bf16_t*)(ws + WS_PROJ); bf16_t* PROJw = (bf16_t*)(ws + WS_PROJ);
    const float* SM = (const float*)(ws + WS_MERGED);
    const float* rope = (const float*)(ws + WS_ROPE);
    bf16_t* KIX = (bf16_t*)(ws + WS_KIX); float* WIX = (float*)(ws + WS_WIX);
    for (int t = w0; t < S; t += nw) {
        const float* rt = rope + (size_t)t * 192;
        { const int hh = c.lane >> 3, i8 = (c.lane & 7) * 8;
            float cs[8], sn[8]; *(f32x4*)cs = *(const f32x4*)(rt + i8); *(f32x4*)(cs + 4) = *(const f32x4*)(rt + i8 + 4); *(f32x4*)sn = *(const f32x4*)(rt + 64 + i8); *(f32x4*)(sn + 4) = *(const f32x4*)(rt + 64 + i8 + 4);
#pragma unroll
            for (int qk = 0; qk < 2; ++qk) { bf16_t* b = PROJw + (size_t)t * NPB + (qk ? PC_KSA : PC_QSA) + hh * 128 + i8; float a1[8], a2[8], o1[8], o2[8]; unpack8(*(const u32x4*)b, a1); unpack8(*(const u32x4*)(b + 64), a2);
#pragma unroll
                for (int e = 0; e < 8; ++e) { o1[e] = a1[e] * cs[e] - a2[e] * sn[e]; o2[e] = a2[e] * cs[e] + a1[e] * sn[e]; }
                *(u32x4*)b = pack8(o1); *(u32x4*)(b + 64) = pack8(o2); } }
        { const int hh = c.lane >> 2, i8 = (c.lane & 3) * 8;
            float cs[8], sn[8]; *(f32x4*)cs = *(const f32x4*)(rt + 128 + i8); *(f32x4*)(cs + 4) = *(const f32x4*)(rt + 128 + i8 + 4); *(f32x4*)sn = *(const f32x4*)(rt + 160 + i8); *(f32x4*)(sn + 4) = *(const f32x4*)(rt + 160 + i8 + 4);
            bf16_t* b = PROJw + (size_t)t * NPB + PC_QIX + hh * 64 + i8; float a1[8], a2[8], o1[8], o2[8]; unpack8(*(const u32x4*)b, a1); unpack8(*(const u32x4*)(b + 32), a2);
#pragma unroll
            for (int e = 0; e < 8; ++e) { o1[e] = a1[e] * cs[e] - a2[e] * sn[e]; o2[e] = a2[e] * cs[e] + a1[e] * sn[e]; }
            *(u32x4*)b = pack8(o1); *(u32x4*)(b + 32) = pack8(o2); }
        const float* sm = SM + (size_t)t * 128;
#define SMSUM(col) ({ float a_ = 0.f; _Pragma("unroll") for (int ks_ = 0; ks_ < SMALL_KS; ++ks_) a_ += sm[(size_t)ks_ * S * 128 + (col)]; a_; })
        if (c.lane < 32) { const float a1 = SMSUM(SC_KIX + c.lane), a2 = SMSUM(SC_KIX + 32 + c.lane), cs = rt[128 + c.lane], sn = rt[160 + c.lane];
            KIX[(size_t)t * 64 + c.lane] = f2bf(a1 * cs - a2 * sn); KIX[(size_t)t * 64 + 32 + c.lane] = f2bf(a2 * cs + a1 * sn); }
        else if (c.lane < 48) { const int i = c.lane - 32; WIX[(size_t)t * 16 + i] = SMSUM(SC_WIX + i) * 0.03125f; }
#undef SMSUM
    }
}

__device__ __forceinline__ void p_dn_scan(const Ctx& c) {
    unsigned char* ws = c.ws;
    const bf16_t* DQ = (const bf16_t*)(ws + WS_DNQKV); const float* GB = (const float*)(ws + WS_GB); float* OR = (float*)(ws + WS_ODNRAW);
    if (c.wave != 0) return;
    for (int u = c.bx; u < 256; u += c.G) {
        const int h = u >> 5, j = (u & 31) * 4 + (c.lane >> 4), li = c.lane & 15;
        float s[8];
#pragma unroll
        for (int e = 0; e < 8; ++e) s[e] = 0.f;
        const bf16_t* qp = DQ + h * 128 + li * 8; const bf16_t* kp = DQ + 1024 + h * 128 + li * 8; const bf16_t* vp = DQ + 2048 + h * 128 + j;
#pragma unroll 2
        for (int t = 0; t < S; ++t) {
            float k[8], q[8]; unpack8(*(const u32x4*)(kp + (size_t)t * 3072), k); unpack8(*(const u32x4*)(qp + (size_t)t * 3072), q);
            const float v = bf2f(vp[(size_t)t * 3072]); const float a = __expf(GB[(size_t)t * 8 + h]), beta = GB[(size_t)S * 8 + (size_t)t * 8 + h];
            float d = 0.f;
#pragma unroll
            for (int e = 0; e < 8; ++e) { s[e] *= a; d += k[e] * s[e]; }
            d = row16_sum(d);
            const float dl = beta * (v - d); float o = 0.f;
#pragma unroll
            for (int e = 0; e < 8; ++e) { s[e] += dl * k[e]; o += q[e] * s[e]; }
            o = row16_sum(o);
            if (li == 0) OR[(size_t)t * 1024 + h * 128 + j] = o;
        }
    }
}
__device__ __forceinline__ void p_dn_post(const Ctx& c, int layer) {
    unsigned char* ws = c.ws;
    const float* OR = (const float*)(ws + WS_ODNRAW2); const bf16_t* PROJ = (const bf16_t*)(ws + WS_PROJ); bf16_t* ODN = (bf16_t*)(ws + WS_ODN);
    const float* gn = inptr<const float>(c, IN_DN_NORM) + layer * HD;
    for (int u = c.gw; u < S * 2; u += c.NGW) { const int t = u >> 1, col = (u & 1) * 512 + c.lane * 8, d0 = (c.lane & 15) * 8;
        float o[8], z[8]; *(f32x4*)o = *(const f32x4*)(OR + (size_t)t * 1024 + col); *(f32x4*)(o + 4) = *(const f32x4*)(OR + (size_t)t * 1024 + col + 4);
        unpack8(*(const u32x4*)(PROJ + (size_t)t * NPB + PC_Z + col), z);
        float ss = 0.f;
#pragma unroll
        for (int e = 0; e < 8; ++e) ss += o[e] * o[e];
        ss = row16_sum(ss); const float r = rsqrtf(ss * (1.f / HD) + RMS_EPS);
#pragma unroll
        for (int e = 0; e < 8; ++e) o[e] = o[e] * r * gn[d0 + e] * siluf_(z[e]);
        { u32x2 w; w.x = cvt4_fp8c(F8_ODN * o[0], F8_ODN * o[1], F8_ODN * o[2], F8_ODN * o[3]); w.y = cvt4_fp8c(F8_ODN * o[4], F8_ODN * o[5], F8_ODN * o[6], F8_ODN * o[7]); *(u32x2*)((unsigned char*)ODN + (size_t)t * 1024 + col) = w; } }
}


namespace dn {
typedef const f32x4 cf4;
#define OPQ(p) ({ unsigned long long t_ = (unsigned long long)(p); asm volatile("" : "+s"(t_)); (unsigned char*)(GAS unsigned char*)t_; })
constexpr int UNIT_BYTES = 81920, OFF_WF = 0, OFF_KF = 16384, OFF_QF = 32768, OFF_UF = 49152, OFF_OF = 65536;
__device__ __forceinline__ f32x4 mma(bf16x8 a, bf16x8 b, f32x4 c) { return __builtin_amdgcn_mfma_f32_16x16x32_bf16(a, b, c, 0, 0, 0); }
__device__ __forceinline__ bf16x8 pack2(f32x4 a, f32x4 b) { u32x4 w; w.x = cvt_pk_bf16(a[0], a[1]); w.y = cvt_pk_bf16(a[2], a[3]); w.z = cvt_pk_bf16(b[0], b[1]); w.w = cvt_pk_bf16(b[2], b[3]); return __builtin_bit_cast(bf16x8, w); }
__device__ __forceinline__ u32x2 pack4(f32x4 a) { u32x2 w; w.x = cvt_pk_bf16(a[0], a[1]); w.y = cvt_pk_bf16(a[2], a[3]); return w; }
__device__ __forceinline__ f32x4 unpack4(u32x2 w) { f32x4 r; r[0] = __uint_as_float(w.x << 16); r[1] = __uint_as_float(w.x & 0xffff0000u); r[2] = __uint_as_float(w.y << 16); r[3] = __uint_as_float(w.y & 0xffff0000u); return r; }
__device__ __forceinline__ float conv_rows(const char* PROJb, const char* cwb, int n, int h, int tsel, int it, int c16, unsigned xoff, unsigned woff, float (&y)[4][8]) {
    const int t = 64 * n + 16 * it + c16; float ss = 0.f;
    const char* Pb = (const char*)OPQ(PROJb) - 3 * NPB * 2; const char* Cb = (const char*)OPQ(cwb);
    u32x4 xr[4][4];
#pragma unroll
    for (int s = 0; s < 4; ++s)
#pragma unroll
        for (int j = 0; j < 4; ++j) xr[s][j] = *(const u32x4*)(Pb + (xoff + (unsigned)((64 * n + 16 * it + j) * NPB + tsel * 1024 + h * 128 + 32 * s) * 2u));
#pragma unroll
    for (int s = 0; s < 4; ++s) { const int chu = tsel * 1024 + h * 128 + 32 * s;
        float acc[8];
#pragma unroll
        for (int e = 0; e < 8; ++e) acc[e] = 0.f;
#pragma unroll
        for (int j = 0; j < 4; ++j) { float x[8]; unpack8(xr[s][j], x);
            const bool ok = t - 3 + j >= 0;
            const unsigned wo = (unsigned)(j * 3072 + chu) * 4u;
            const f32x4 w0 = *(const f32x4*)(Cb + (woff + wo)), w1 = *(const f32x4*)(Cb + (woff + wo) + 16);
#pragma unroll
            for (int e = 0; e < 4; ++e) { acc[e] += w0[e] * (ok ? x[e] : 0.f); acc[4 + e] += w1[e] * (ok ? x[4 + e] : 0.f); } }
#pragma unroll
        for (int e = 0; e < 8; ++e) { const float v = siluf_(acc[e]); y[s][e] = v; ss += v * v; } }
    asm volatile("" ::: "memory");
    return ss;
}
__device__ __forceinline__ void conv_rows_s4(const char* PROJb, const char* cwb, int n, int h, int tsel, int s, int c16, unsigned xoff, unsigned woff, float (&y)[4][8]) {
    const int chu = tsel * 1024 + h * 128 + 32 * s; const char* Pb = (const char*)OPQ(PROJb) - 3 * NPB * 2; const char* Cb = (const char*)OPQ(cwb);
    u32x4 xr[4][4]; f32x4 w0[4], w1[4];
#pragma unroll
    for (int it = 0; it < 4; ++it)
#pragma unroll
        for (int j = 0; j < 4; ++j) xr[it][j] = *(const u32x4*)(Pb + (xoff + (unsigned)((64 * n + 16 * it + j) * NPB + chu) * 2u));
#pragma unroll
    for (int j = 0; j < 4; ++j) { const unsigned wo = (unsigned)(j * 3072 + chu) * 4u; w0[j] = *(const f32x4*)(Cb + (woff + wo)); w1[j] = *(const f32x4*)(Cb + (woff + wo) + 16); }
#pragma unroll
    for (int it = 0; it < 4; ++it) { const int t = 64 * n + 16 * it + c16; float acc[8];
#pragma unroll
        for (int e = 0; e < 8; ++e) acc[e] = 0.f;
#pragma unroll
        for (int j = 0; j < 4; ++j) { float x[8]; unpack8(xr[it][j], x); const bool ok = t - 3 + j >= 0;
#pragma unroll
            for (int e = 0; e < 4; ++e) { acc[e] += w0[j][e] * (ok ? x[e] : 0.f); acc[4 + e] += w1[j][e] * (ok ? x[4 + e] : 0.f); } }
#pragma unroll
        for (int e = 0; e < 8; ++e) y[it][e] = siluf_(acc[e]); }
}
__device__ __forceinline__ void intra_unit(const Ctx& c, LAS unsigned char* wl, int n, int h, int layer) {
    unsigned char* ws = c.ws;
    const char* PROJb = (const char*)(ws + WS_PROJ); const float* SM = (const float*)(ws + WS_MERGED);
    const char* cwb = (const char*)(inptr<const float>(c, IN_CONV_W) + (size_t)layer * 4 * 3072);
    const int lane = c.lane, c16 = lane & 15, g = lane >> 4;
    const unsigned xoff = (unsigned)(c16 * NPB + 8 * g) * 2u, woff = (unsigned)(8 * g) * 4u, lane16 = (unsigned)lane * 16u, lane8 = (unsigned)lane * 8u;
    unsigned char* ub = ws + WS_DNF + (size_t)(n * DNH + h) * UNIT_BYTES;
    float gtok, beta;
    { const float* sm = SM + (size_t)(64 * n + lane) * 128; float av = 0.f, bv = 0.f;
#pragma unroll
      for (int ks = 0; ks < SMALL_KS; ++ks) { av += sm[(size_t)ks * S * 128 + SC_A + h]; bv += sm[(size_t)ks * S * 128 + SC_B + h]; }
      const float xx = av + inptr<const float>(c, IN_DT_BIAS)[layer * DNH + h];
      const float sp = xx > 20.f ? xx : log1pf(__expf(xx)); gtok = -__expf(inptr<const float>(c, IN_A_LOG)[layer * DNH + h]) * sp; beta = sigmoidf_(bv); }
    LAS float* tgc = (LAS float*)(c.lds + DN_TAB_OFF + c.wave * 1024); LAS float* tbeta = tgc + 64; LAS float* tg = tgc + 128;
    tg[lane] = gtok; tbeta[lane] = beta; LDS_WAIT();
    float gc = 0.f;
#pragma unroll
    for (int m = 0; m < 16; ++m) { const f32x4 v = *(const LAS f32x4*)(tg + 4 * m);
#pragma unroll
        for (int q = 0; q < 4; ++q) gc += (4 * m + q <= lane) ? v[q] : 0.f; }
    tgc[lane] = gc; LDS_WAIT();
    const float gc63 = tgc[63];
    if (lane == 0) ((float*)(ws + WS_GL))[n * DNH + h] = __expf(gc63);
#define LOAD_GC() float gcR[16], gcC[4]; _Pragma("unroll") for (int jt_ = 0; jt_ < 4; ++jt_) { gcC[jt_] = tgc[16 * jt_ + c16]; *(f32x4*)(&gcR[4 * jt_]) = *(const LAS f32x4*)(tgc + 16 * jt_ + 4 * g); }
    const f32x4 Z4 = {0.f, 0.f, 0.f, 0.f};
    LAS float* AT = (LAS float*)wl;
    bf16x8 AF[4][2];
    { bf16x8 Kf[4][4];
#pragma unroll
      for (int it = 0; it < 4; ++it) { float y[4][8];
          float ss = conv_rows(PROJb, cwb, n, h, 1, it, c16, xoff, woff, y); ss += __shfl_xor(ss, 16); ss += __shfl_xor(ss, 32);
          const float r = rsqrtf(ss + L2_EPS);
#pragma unroll
          for (int s = 0; s < 4; ++s) { float z[8];
#pragma unroll
              for (int e = 0; e < 8; ++e) z[e] = y[s][e] * r;
              Kf[it][s] = __builtin_bit_cast(bf16x8, pack8(z)); *(bf16x8*)(OPQ(ub) + (OFF_OF + (it * 4 + s) * 1024) + lane16) = Kf[it][s]; }
          asm volatile("" ::: "memory"); }
      { LOAD_GC(); float betaR[16];
#pragma unroll
        for (int jt = 0; jt < 4; ++jt) *(f32x4*)(&betaR[4 * jt]) = *(const LAS f32x4*)(tbeta + 16 * jt + 4 * g);
#pragma unroll
        for (int ct = 0; ct < 4; ++ct)
#pragma unroll
            for (int jt = ct; jt < 4; ++jt) { f32x4 acc = Z4;
#pragma unroll
                for (int s = 0; s < 4; ++s) acc = mma(Kf[jt][s], Kf[ct][s], acc);
                const int cc = 16 * ct + c16; f32x4 o;
#pragma unroll
                for (int r = 0; r < 4; ++r) { const int j = 16 * jt + 4 * g + r; o[r] = j > cc ? betaR[4 * jt + r] * acc[r] * __expf(gcR[4 * jt + r] - gcC[ct]) : 0.f; }
                *(LAS f32x4*)(AT + cc * 64 + 16 * jt + 4 * g) = o; } }
      asm volatile("" ::: "memory"); }
#pragma unroll
    for (int it = 0; it < 4; ++it) { float y[4][8];
        float ss = conv_rows(PROJb, cwb, n, h, 0, it, c16, xoff, woff, y); ss += __shfl_xor(ss, 16); ss += __shfl_xor(ss, 32);
        const float r = rsqrtf(ss + L2_EPS) * 0.08838834764831845f;
#pragma unroll
        for (int s = 0; s < 4; ++s) { float z[8];
#pragma unroll
            for (int e = 0; e < 8; ++e) z[e] = y[s][e] * r;
            *(bf16x8*)(OPQ(ub) + (OFF_UF + (it * 4 + s) * 1024) + lane16) = __builtin_bit_cast(bf16x8, pack8(z)); }
        asm volatile("" ::: "memory"); }
    asm volatile("s_waitcnt vmcnt(0)" ::: "memory");
    { bf16x8 Kf[4][4];
#pragma unroll
      for (int it = 0; it < 4; ++it)
#pragma unroll
          for (int s = 0; s < 4; ++s) Kf[it][s] = *(const bf16x8*)(OPQ(ub) + (OFF_OF + (it * 4 + s) * 1024) + lane16);
      LOAD_GC();
      bf16x8 Qa[4][4];
#pragma unroll
      for (int it = 0; it < 4; ++it)
#pragma unroll
          for (int s = 0; s < 4; ++s) Qa[it][s] = *(const bf16x8*)(OPQ(ub) + (OFF_UF + (it * 4 + s) * 1024) + lane16);
#pragma unroll
      for (int it = 0; it < 4; ++it) { const bf16x8 (&Qr)[4] = Qa[it];
#pragma unroll
          for (int s = 0; s < 2; ++s) { f32x4 t2[2];
#pragma unroll
              for (int q = 0; q < 2; ++q) { const int jt = 2 * s + q; f32x4 acc = Z4;
                  if (it >= jt) {
#pragma unroll
                      for (int ks = 0; ks < 4; ++ks) acc = mma(Kf[jt][ks], Qr[ks], acc);
                      const int i = 16 * it + c16;
#pragma unroll
                      for (int r = 0; r < 4; ++r) { const int j = 16 * jt + 4 * g + r; acc[r] = i >= j ? acc[r] * __expf(gcC[it] - gcR[4 * jt + r]) : 0.f; } }
                  t2[q] = acc; }
              AF[it][s] = pack2(t2[0], t2[1]); } }
      asm volatile("" ::: "memory"); }
    LDS_WAIT();
    { float T[64];
#pragma unroll
      for (int cc = 63; cc >= 0; --cc) { float a0 = lane == cc ? 1.f : 0.f, a1 = 0.f;
#pragma unroll
          for (int m = (cc + 1) >> 2; m < 16; ++m) { const f32x4 av = *(const LAS f32x4*)(AT + cc * 64 + 4 * m);
#pragma unroll
              for (int q = 0; q < 4; ++q) { const int j = 4 * m + q; if (j > cc) { if (j & 1) a1 -= T[j] * av[q]; else a0 -= T[j] * av[q]; } } }
          T[cc] = a0 + a1; asm volatile("" : "+v"(T[cc])); }
      LDS_WAIT();
#pragma unroll
      for (int m = 0; m < 16; ++m) { u32x2 w; w.x = cvt_pk_bf16(T[4 * m], T[4 * m + 1]); w.y = cvt_pk_bf16(T[4 * m + 2], T[4 * m + 3]); *(LAS u32x2*)(wl + lane * 136 + 8 * m) = w; } }
    LDS_WAIT();
    bf16x8 TF[4][2];
#pragma unroll
    for (int it = 0; it < 4; ++it)
#pragma unroll
        for (int s = 0; s < 2; ++s) { const int i = 16 * it + c16; const u32x2 lo = *(const LAS u32x2*)(wl + i * 136 + (32 * s + 4 * g) * 2), hi2 = *(const LAS u32x2*)(wl + i * 136 + (32 * s + 16 + 4 * g) * 2);
            u32x4 w; w.x = lo.x; w.y = lo.y; w.z = hi2.x; w.w = hi2.y; TF[it][s] = __builtin_bit_cast(bf16x8, w); }
    bf16x8 ID0, ID1;
    { u32x4 w0 = {0u, 0u, 0u, 0u}, w1 = {0u, 0u, 0u, 0u}; const int e0 = c16 - 8 * g, e1 = c16 + 16 - 8 * g;
#pragma unroll
      for (int e = 0; e < 8; ++e) { const unsigned one = (e & 1) ? 0x3F800000u : 0x00003F80u; if (e == e0) w0[e >> 1] |= one; if (e == e1) w1[e >> 1] |= one; }
      ID0 = __builtin_bit_cast(bf16x8, w0); ID1 = __builtin_bit_cast(bf16x8, w1); }
    { asm volatile("" ::: "memory"); LOAD_GC(); float sc1[16], sc2[16];
#pragma unroll
      for (int jt = 0; jt < 4; ++jt)
#pragma unroll
          for (int r = 0; r < 4; ++r) { const float b = tbeta[16 * jt + 4 * g + r]; sc1[4 * jt + r] = b * __expf(gcR[4 * jt + r]); sc2[4 * jt + r] = __expf(gc63 - gcR[4 * jt + r]); }
      float egC[4];
#pragma unroll
      for (int it = 0; it < 4; ++it) egC[it] = __expf(gcC[it]);
      bf16x8 Kfn[4], Qfn[4];
#pragma unroll
      for (int it = 0; it < 4; ++it) { Kfn[it] = *(const bf16x8*)(OPQ(ub) + (OFF_OF + (it * 4) * 1024) + lane16); Qfn[it] = *(const bf16x8*)(OPQ(ub) + (OFF_UF + (it * 4) * 1024) + lane16); }
#pragma unroll
      for (int s4 = 0; s4 < 4; ++s4) { bf16x8 Kfs[4], Qfs[4];
#pragma unroll
          for (int it = 0; it < 4; ++it) { Kfs[it] = Kfn[it]; Qfs[it] = Qfn[it]; }
          if (s4 < 3) {
#pragma unroll
              for (int it = 0; it < 4; ++it) { Kfn[it] = *(const bf16x8*)(OPQ(ub) + (OFF_OF + (it * 4 + s4 + 1) * 1024) + lane16); Qfn[it] = *(const bf16x8*)(OPQ(ub) + (OFF_UF + (it * 4 + s4 + 1) * 1024) + lane16); } }
#pragma unroll
          for (int par = 0; par < 2; ++par) { const int dt = 2 * s4 + par; const bf16x8 ID = par ? ID1 : ID0;
              f32x4 Kc[4];
#pragma unroll
              for (int jt = 0; jt < 4; ++jt) Kc[jt] = mma(Kfs[jt], ID, Z4);
              bf16x8 B1A[2];
#pragma unroll
              for (int s = 0; s < 2; ++s) { f32x4 a, b, a2, b2;
#pragma unroll
                  for (int r = 0; r < 4; ++r) { a[r] = Kc[2 * s][r] * sc1[8 * s + r]; b[r] = Kc[2 * s + 1][r] * sc1[8 * s + 4 + r]; a2[r] = Kc[2 * s][r] * sc2[8 * s + r]; b2[r] = Kc[2 * s + 1][r] * sc2[8 * s + 4 + r]; }
                  B1A[s] = pack2(a, b);
                  *(bf16x8*)(OPQ(ub) + (OFF_KF + (dt * 2 + s) * 1024) + lane16) = pack2(a2, b2); }
#pragma unroll
              for (int it = 0; it < 4; ++it) { f32x4 acc = Z4;
#pragma unroll
                  for (int s = 0; s < 2; ++s) acc = mma(B1A[s], TF[it][s], acc);
                  *(u32x2*)(OPQ(ub) + (OFF_WF + (it * 4 + s4) * 1024 + 8 * par) + lane16) = pack4(acc); }
              f32x4 Wc[4];
#pragma unroll
              for (int jt = 0; jt < 4; ++jt) { f32x4 acc = Z4;
#pragma unroll
                  for (int s = 0; s < 2; ++s) acc = mma(TF[jt][s], B1A[s], acc);
                  Wc[jt] = -acc; }
              bf16x8 WA[2];
#pragma unroll
              for (int s = 0; s < 2; ++s) WA[s] = pack2(Wc[2 * s], Wc[2 * s + 1]);
#pragma unroll
              for (int it = 0; it < 4; ++it) { f32x4 acc = mma(ID, Qfs[it], Z4); acc = acc * egC[it];
#pragma unroll
                  for (int s = 0; s < 2; ++s) acc = mma(WA[s], AF[it][s], acc);
                  *(u32x2*)(OPQ(ub) + (OFF_QF + (it * 4 + s4) * 1024 + 8 * par) + lane16) = pack4(acc); }
              asm volatile("" ::: "memory"); } } }
    asm volatile("s_waitcnt vmcnt(0)" ::: "memory");
    { float betaR[16];
#pragma unroll
      for (int jt = 0; jt < 4; ++jt) *(f32x4*)(&betaR[4 * jt]) = *(const LAS f32x4*)(tbeta + 16 * jt + 4 * g);
#pragma unroll
      for (int s4 = 0; s4 < 4; ++s4) { bf16x8 Vfs[4];
          { float y[4][8]; conv_rows_s4(PROJb, cwb, n, h, 2, s4, c16, xoff, woff, y);
#pragma unroll
            for (int it = 0; it < 4; ++it) Vfs[it] = __builtin_bit_cast(bf16x8, pack8(y[it])); }
#pragma unroll
        for (int par = 0; par < 2; ++par) { const int dvt = 2 * s4 + par; const bf16x8 ID = par ? ID1 : ID0;
          f32x4 Vc[4];
#pragma unroll
          for (int jt = 0; jt < 4; ++jt) { Vc[jt] = mma(Vfs[jt], ID, Z4);
#pragma unroll
              for (int r = 0; r < 4; ++r) Vc[jt][r] *= betaR[4 * jt + r]; }
          bf16x8 B2F[2] = {pack2(Vc[0], Vc[1]), pack2(Vc[2], Vc[3])};
          f32x4 Uc[4];
#pragma unroll
          for (int it = 0; it < 4; ++it) { f32x4 acc = Z4;
#pragma unroll
              for (int s = 0; s < 2; ++s) acc = mma(TF[it][s], B2F[s], acc);
              Uc[it] = acc; *(u32x2*)(OPQ(ub) + (OFF_UF + (dvt * 4 + it) * 512) + lane8) = pack4(acc); }
          bf16x8 UB[2] = {pack2(Uc[0], Uc[1]), pack2(Uc[2], Uc[3])};
#pragma unroll
          for (int it = 0; it < 4; ++it) { f32x4 acc = Z4;
#pragma unroll
              for (int s = 0; s < 2; ++s) acc = mma(AF[it][s], UB[s], acc);
              *(u32x2*)(OPQ(ub) + (OFF_OF + (dvt * 4 + it) * 512) + lane8) = pack4(acc); }
          asm volatile("" ::: "memory"); } } }
    LDS_WAIT();
}
__device__ __forceinline__ void scan_head(const Ctx& c, int h) {
    unsigned char* ws = c.ws; const int lane = c.lane, ns = c.wave; const unsigned lane16 = (unsigned)lane * 16u, lane8 = (unsigned)lane * 8u;
    const float* GL = (const float*)(ws + WS_GL);
    const f32x4 Z4 = {0.f, 0.f, 0.f, 0.f};
    f32x4 Sc[8]; bf16x8 SB[4];
#pragma unroll
    for (int m = 0; m < 8; ++m) Sc[m] = Z4;
#pragma unroll
    for (int s = 0; s < 4; ++s) SB[s] = pack2(Z4, Z4);
    const unsigned char* base = ws + WS_DNF + (size_t)h * UNIT_BYTES;
    LAS unsigned char* lds = c.lds;
#define SCAN_DMA(n_, b_) do { const unsigned char* ug_ = OPQ(base + (size_t)(n_) * (DNH * UNIT_BYTES)); _Pragma("unroll") for (int i_ = 0; i_ < 6; ++i_) \
        __builtin_amdgcn_global_load_lds((const unsigned*)(ug_ + (ns * 6 + i_) * 1024 + lane16), (LAS unsigned*)(lds + (b_) * 49152 + (ns * 6 + i_) * 1024), 16, 0, 0); } while (0)
#define SCAN_UO(n_, U_, O_) do { const unsigned char* ug_ = OPQ(base + (size_t)(n_) * (DNH * UNIT_BYTES)); _Pragma("unroll") for (int it = 0; it < 4; ++it) { \
        U_[it] = *(const u32x2*)(ug_ + (OFF_UF + (ns * 4 + it) * 512) + lane8); O_[it] = *(const u32x2*)(ug_ + (OFF_OF + (ns * 4 + it) * 512) + lane8); } } while (0)
#define SCAN_STEP(n_, b_, U_, O_, GL_, UN_, ON_, GLN_) do { const int nn_ = (n_) + 1 < S / 64 ? (n_) + 1 : (n_); \
        __builtin_amdgcn_s_waitcnt(0x0F70);                         \
        asm volatile("" ::: "memory"); \
        __builtin_amdgcn_s_barrier();                               \
        asm volatile("" ::: "memory"); \
        if ((n_) + 1 < S / 64) SCAN_DMA((n_) + 1, (b_) ^ 1); \
        SCAN_UO(nn_, UN_, ON_); GLN_ = GL[nn_ * DNH + h];           \
        const LAS unsigned char* fb = lds + (b_) * 49152 + lane16; \
        unsigned char* ob = OPQ(ws + WS_ODNRAW2 + ((size_t)(64 * (n_)) * 1024 + h * 128 + 16 * ns) * 4); int ln_ = lane; asm volatile("" : "+v"(ln_)); const unsigned lo_ = (unsigned)(4 * (ln_ >> 4) * 1024 + (ln_ & 15)) * 4u; \
        _Pragma("unroll") for (int it = 0; it < 4; ++it) { f32x4 acc = unpack4(O_[it]);                  \
            _Pragma("unroll") for (int s4 = 0; s4 < 4; ++s4) acc = mma(*(const LAS bf16x8*)(fb + OFF_QF + (it * 4 + s4) * 1024), SB[s4], acc); \
            _Pragma("unroll") for (int r = 0; r < 4; ++r) *(float*)(ob + (size_t)(16 * it + r) * 4096 + lo_) = acc[r]; } \
        f32x4 R[4]; \
        _Pragma("unroll") for (int it = 0; it < 4; ++it) { f32x4 acc = Z4; \
            _Pragma("unroll") for (int s4 = 0; s4 < 4; ++s4) acc = mma(*(const LAS bf16x8*)(fb + OFF_WF + (it * 4 + s4) * 1024), SB[s4], acc); \
            R[it] = unpack4(U_[it]) - acc; } \
        const bf16x8 RB0 = pack2(R[0], R[1]), RB1 = pack2(R[2], R[3]); \
        _Pragma("unroll") for (int m = 0; m < 8; ++m) { f32x4 acc = Sc[m] * GL_; acc = mma(*(const LAS bf16x8*)(fb + OFF_KF + (m * 2) * 1024), RB0, acc); acc = mma(*(const LAS bf16x8*)(fb + OFF_KF + (m * 2 + 1) * 1024), RB1, acc); Sc[m] = acc; } \
        _Pragma("unroll") for (int s = 0; s < 4; ++s) SB[s] = pack2(Sc[2 * s], Sc[2 * s + 1]); } while (0)
    u32x2 Ua[4], Oa[4], Ub[4], Ob[4]; float gla, glb;
    SCAN_DMA(0, 0); SCAN_UO(0, Ua, Oa); gla = GL[h];
    for (int n = 0; n < S / 64; n += 2) {
        SCAN_STEP(n, 0, Ua, Oa, gla, Ub, Ob, glb);
        SCAN_STEP(n + 1, 1, Ub, Ob, glb, Ua, Oa, gla);
    }
    asm volatile("s_waitcnt vmcnt(0)" ::: "memory");
#undef SCAN_STEP
#undef SCAN_DMA
#undef SCAN_UO
}
#undef LOAD_GC
}

__device__ __forceinline__ void p_dn_intra(const Ctx& c, int layer) {
    LAS unsigned char* wl = c.lds + c.wave * 16384;
    for (int u = c.bx * 4 + c.wave; u < (S / 64) * DNH; u += c.G * 4) { Ctx cu = c; asm volatile("" : "+v"(cu.lane)); dn::intra_unit(cu, wl, u >> 3, u & 7, layer); }
}

constexpr int PKN = 32;
__device__ __forceinline__ unsigned fkey(float f) { const unsigned b = __float_as_uint(f); return b ^ ((unsigned)((int)b >> 31) | 0x80000000u); }
__device__ __forceinline__ void p_select(const Ctx& c, const int layer) {
    unsigned char* ws = c.ws;
    const bf16_t* PROJ = (const bf16_t*)(ws + WS_PROJ); const bf16_t* KIX = (const bf16_t*)(ws + WS_KIX); const float* WIX = (const float*)(ws + WS_WIX);
    unsigned* MASK = (unsigned*)(ws + WS_MASK);
    LAS float* SC = (LAS float*)c.lds;
    const int nunits = S / 4;
    unsigned* ctr = (unsigned*)(ws + WS_CTL) + CW_SELQ + layer * 64;
    LAS int* nx = (LAS int*)(c.lds + MISC_OFF + 512);
    const bool scorer = c.wave >= 4;
    auto score_unit = [&](int tk) {
        const int r = c.lane & 31, hi = c.lane >> 5, sw = c.wave - 4;
        const int u = nunits - 1 - tk, t0 = u * 4, ntile = (t0 + 4 + 31) >> 5;
        bf16x8 A[2][4]; h2_t wq[2][8];
#pragma unroll
        for (int m = 0; m < 2; ++m) { const int tq = t0 + 2 * m + ((r >> 2) & 1), hd = (r & 3) + 4 * (r >> 3);
#pragma unroll
            for (int s = 0; s < 4; ++s) A[m][s] = *(const bf16x8*)(PROJ + (size_t)tq * NPB + PC_QIX + hd * 64 + 16 * s + 8 * hi);
            const float* wp = WIX + (size_t)(t0 + 2 * m + hi) * 16;
#pragma unroll
            for (int q4 = 0; q4 < 4; ++q4) { const f32x4 wv = *(const f32x4*)(wp + 4 * q4); wq[m][2 * q4] = __builtin_bit_cast(h2_t, __builtin_amdgcn_cvt_pkrtz(wv[0], wv[1])); wq[m][2 * q4 + 1] = __builtin_bit_cast(h2_t, __builtin_amdgcn_cvt_pkrtz(wv[2], wv[3])); } }
        const bf16_t* kb = KIX + (size_t)r * 64 + 8 * hi;
        bf16x8 B0[4], B1[4], B2[4];
        int tl = sw;
#define LDB(dst, t_) do { const int tt_ = (t_) < ntile ? (t_) : ntile - 1; _Pragma("unroll") for (int s = 0; s < 4; ++s) dst[s] = *(const bf16x8*)(kb + (size_t)tt_ * 2048 + 16 * s); } while (0)
        asm volatile("" ::: "memory"); LDB(B0, tl); asm volatile("" ::: "memory"); LDB(B1, tl + 4); asm volatile("" ::: "memory"); LDB(B2, tl + 8); asm volatile("" ::: "memory");
#define SC_STEP(BX) do { const int key = (tl < ntile ? tl : ntile - 1) * 32 + r;     \
            _Pragma("unroll") for (int m = 0; m < 2; ++m) { f32x16 acc = {}; \
                _Pragma("unroll") for (int s = 0; s < 4; ++s) acc = __builtin_amdgcn_mfma_f32_32x32x16_bf16(A[m][s], BX[s], acc, 0, 0, 0); \
                float sc = 0.f; const h2_t hz = {(_Float16)0, (_Float16)0}; \
                _Pragma("unroll") for (int e = 0; e < 8; ++e) { h2_t x = __builtin_bit_cast(h2_t, __builtin_amdgcn_cvt_pkrtz(acc[2 * e], acc[2 * e + 1])); x = __builtin_elementwise_max(x, hz); sc = __builtin_amdgcn_fdot2(x, wq[m][e], sc, false); } \
                const int tq = t0 + 2 * m + hi; \
                ((LAS unsigned*)SC)[(2 * m + hi) * 8192 + key] = key <= tq ? fkey(sc) : 0u; } \
            __builtin_amdgcn_sched_barrier(0); LDB(BX, tl + 12); __builtin_amdgcn_sched_barrier(0); tl += 4; } while (0)
        while (tl < ntile) { SC_STEP(B0); SC_STEP(B1); SC_STEP(B2); }
        { const int Rz = ntile * 32, Rg = (Rz + 1023) & ~1023;
          for (int kk = Rz + c.lane; kk < Rg; kk += 64) ((LAS unsigned*)SC)[sw * 8192 + kk] = 0u; }
#undef SC_STEP
#undef LDB
    };
    if (c.tid == 0) { nx[0] = (int)__hip_atomic_fetch_add(ctr, 1u, __ATOMIC_RELAXED, __HIP_MEMORY_SCOPE_AGENT); nx[1] = (int)__hip_atomic_fetch_add(ctr, 1u, __ATOMIC_RELAXED, __HIP_MEMORY_SCOPE_AGENT); }
    __syncthreads();
    int tcur = nx[0];
    if (scorer) {
        if (tcur < nunits) score_unit(tcur);
        __syncthreads();
        for (int k = 0; tcur < nunits; ++k) { const int tnext = nx[(k + 1) & 1]; __syncthreads(); if (tnext < nunits) score_unit(tnext); __syncthreads(); tcur = tnext; }
    } else {
        __syncthreads();
        for (int k = 0; tcur < nunits; ++k) {
        const int tnext = nx[(k + 1) & 1];
        const int u = nunits - 1 - tcur, t0 = u * 4, ntile = (t0 + 4 + 31) >> 5;
        int ln = c.lane; asm volatile("" : "+v"(ln));
        const int q = c.wave & 3, tq = t0 + q, n = tq + 1, R = ntile * 32;
        unsigned key[128];
        { const LAS unsigned* sq = (const LAS unsigned*)SC + q * 8192 + ln;
#pragma unroll
            for (int gq = 0; gq < 8; ++gq) {
                if (gq * 1024 < R) {
#pragma unroll
                    for (int jj = 0; jj < 16; ++jj) key[gq * 16 + jj] = sq[(gq * 16 + jj) * 64];
                    __builtin_amdgcn_sched_barrier(0); }
                else {
#pragma unroll
                    for (int jj = 0; jj < 16; ++jj) key[gq * 16 + jj] = 0u; } }
            LDS_WAIT(); }
        __syncthreads();
        unsigned tk2 = 0u; if (c.tid == 0) tk2 = __hip_atomic_fetch_add(ctr, 1u, __ATOMIC_RELAXED, __HIP_MEMORY_SCOPE_AGENT);
        {
#define CNT_ALL(OP, V) ({ int c0_ = 0, c1_ = 0, c2_ = 0, c3_ = 0; _Pragma("unroll") for (int gq_ = 0; gq_ < 8; ++gq_) if (gq_ * 1024 < R) { _Pragma("unroll") for (int jj_ = 0; jj_ < 16; jj_ += 4) { \
    c0_ += (key[gq_ * 16 + jj_] OP (V)) ? 1 : 0; c1_ += (key[gq_ * 16 + jj_ + 1] OP (V)) ? 1 : 0; c2_ += (key[gq_ * 16 + jj_ + 2] OP (V)) ? 1 : 0; c3_ += (key[gq_ * 16 + jj_ + 3] OP (V)) ? 1 : 0; } } wave_isum((c0_ + c1_) + (c2_ + c3_)); })
#define CNT_CK(OP, V) ({ int c0_ = 0, c1_ = 0; _Pragma("unroll") for (int jj_ = 0; jj_ < 8; jj_ += 2) { c0_ += (ck[jj_] OP (V)) ? 1 : 0; c1_ += (ck[jj_ + 1] OP (V)) ? 1 : 0; } wave_isum(c0_ + c1_); })
            unsigned thr = 0u; int need_eq = 0; bool simple = true;
            if (n > TOPK) {
                u16x2_t pk[PKN];
#define PK_OF(i_) __builtin_bit_cast(u16x2_t, __builtin_amdgcn_perm(key[2 * (i_) + 1], key[2 * (i_)], sel_))
#pragma unroll
                for (int i = 0; i < PKN; ++i) { const unsigned sel_ = 0x07060302u; pk[i] = PK_OF(i); }
#define PK_GE(x_) ({ u16x2_t t_; asm("v_pk_sub_u16 %0, %1, %2 clamp\n\tv_pk_min_u16 %0, %0, %3" : "=&v"(t_) : "v"(x_), "s"(cv_), "s"(one_)); t_; })
#define PK_AT(i_) ((i_) < PKN ? pk[(i_) < PKN ? (i_) : 0] : PK_OF(i_))
#define CNT_PK(C16) ({ unsigned sel_ = 0x07060302u; asm volatile("" : "+s"(sel_));     \
    const unsigned cv_ = ((unsigned)(C16) - 1u) * 0x10001u, one_ = 0x10001u; u16x2_t a0_ = {0, 0}, a1_ = {0, 0}; \
    _Pragma("unroll") for (int gq_ = 0; gq_ < 8; ++gq_) if (gq_ * 1024 < R) { _Pragma("unroll") for (int jj_ = 0; jj_ < 8; jj_ += 2) { \
        a0_ += PK_GE(PK_AT(gq_ * 8 + jj_)); a1_ += PK_GE(PK_AT(gq_ * 8 + jj_ + 1)); } } \
    const unsigned s_ = __builtin_bit_cast(unsigned, a0_ + a1_); wave_isum((int)((s_ & 0xffffu) + (s_ >> 16))); })
                for (int bit = 31; bit >= 16; --bit) { const unsigned cand = thr | (1u << bit); if (CNT_PK(cand >> 16) >= TOPK) thr = cand; }
                const unsigned P = thr >> 16; const int c_hi = P == 0xFFFFu ? 0 : CNT_PK(P + 1u);
#undef CNT_PK
#undef PK_AT
#undef PK_OF
#undef PK_GE
                LAS unsigned* cl = (LAS unsigned*)(c.lds + DN_TAB_OFF + q * 2048); int nb = 0;
#pragma unroll
                for (int gq = 0; gq < 8; ++gq) if (gq * 1024 < R) {
#pragma unroll
                    for (int jj = 0; jj < 16; ++jj) { const unsigned kv = key[gq * 16 + jj]; const bool inb = (kv >> 16) == P && kv != 0u; const unsigned long long m = __ballot(inb);
                        if (inb) { const int o = nb + (int)__builtin_amdgcn_mbcnt_hi((unsigned)(m >> 32), __builtin_amdgcn_mbcnt_lo((unsigned)m, 0u)); if (o < 512) cl[o] = kv; } nb += __popcll(m); } }
                LDS_WAIT();
                if (nb <= 512) { unsigned ck[8];
#pragma unroll
                    for (int jj = 0; jj < 8; ++jj) ck[jj] = (jj * 64 + ln) < nb ? cl[jj * 64 + ln] : 0u;
                    for (int bit = 15; bit >= 0; --bit) { const unsigned cand = thr | (1u << bit); if (c_hi + CNT_CK(>=, cand) >= TOPK) thr = cand; }
                    need_eq = TOPK - (c_hi + CNT_CK(>, thr)); simple = CNT_CK(==, thr) == need_eq; }
                else {
                    for (int bit = 15; bit >= 0; --bit) { const unsigned cand = thr | (1u << bit); if (CNT_ALL(>=, cand) >= TOPK) thr = cand; }
                    need_eq = TOPK - CNT_ALL(>, thr); simple = CNT_ALL(==, thr) == need_eq; }
            }
            int tie_seen = 0; int mA0 = 0, mA1 = 0, mB0 = 0, mB1 = 0;
#pragma unroll
            for (int gq = 0; gq < 8; ++gq) if (gq * 1024 < R) {
#pragma unroll
                for (int jj = 0; jj < 16; ++jj) { const int j = gq * 16 + jj, kk = j * 64 + ln; bool sel;
                    if (n <= TOPK) sel = kk < n;
                    else if (simple) sel = key[j] >= thr;
                    else { const unsigned ku = key[j]; const bool inr = true; const bool tie = ku == thr; const unsigned long long tm = __ballot(tie);
                        const int rank = tie_seen + __popcll(tm & ((1ull << ln) - 1ull)); sel = inr && ((ku > thr) || (tie && rank < need_eq)); tie_seen += __popcll(tm); }
                    const unsigned long long bm = __ballot(sel);
                    if (j < 64) { const bool me = ln == j; mA0 = me ? (int)(unsigned)bm : mA0; mA1 = me ? (int)(unsigned)(bm >> 32) : mA1; }
                    else { const bool me = ln == j - 64; mB0 = me ? (int)(unsigned)bm : mB0; mB1 = me ? (int)(unsigned)(bm >> 32) : mB1; } } }
#undef CNT_ALL
#undef CNT_CK
            unsigned* mrow = MASK + ((size_t)(tq >> 5) * 128 * 32 + (tq & 31)) * 2;
            { u32x2 w; w.x = (unsigned)mA0; w.y = (unsigned)mA1; *(u32x2*)(mrow + (size_t)ln * 64) = w; w.x = (unsigned)mB0; w.y = (unsigned)mB1; *(u32x2*)(mrow + (size_t)(64 + ln) * 64) = w; }
        }
        if (c.tid == 0) nx[k & 1] = (int)tk2;
        __syncthreads();
        tcur = tnext;
        }
    }
}

__device__ __forceinline__ void p_attn_naive(const Ctx& c) {
    unsigned char* ws = c.ws;
    const bf16_t* PROJ = (const bf16_t*)(ws + WS_PROJ); const unsigned* MASK = (const unsigned*)(ws + WS_MASK); bf16_t* OSA = (bf16_t*)(ws + WS_OSA);
    LAS int* idx = (LAS int*)c.lds;
    LAS int* wtot = (LAS int*)(c.lds + 4096);
    LAS float* lg = (LAS float*)(c.lds + 8192) + c.wave * 512;
    const int h = c.wave, g4 = c.lane >> 4, li = c.lane & 15;
    for (int t = c.bx; t < S; t += c.G) {
        int cntw = 0; unsigned wbits = 0;
        if (c.tid < 256) { wbits = MASK[(size_t)t * 256 + c.tid]; cntw = __popc(wbits); }
        int incl = cntw;
#pragma unroll
        for (int o = 1; o < 64; o <<= 1) { const int y = __shfl_up(incl, o); if (c.lane >= o) incl += y; }
        if (c.tid < 256 && c.lane == 63) wtot[c.wave] = incl;
        __syncthreads();
        int base = 0, nsel = wtot[0] + wtot[1] + wtot[2] + wtot[3];
        for (int w = 0; w < 4; ++w) if (w < c.wave) base += wtot[w];
        if (c.tid < 256) { int pos = base + incl - cntw; unsigned b = wbits; while (b) { const int bit = __builtin_ctz(b); b &= b - 1; if (pos < 512) idx[pos] = c.tid * 32 + bit; ++pos; } }
        __syncthreads();
        if (nsel > 512) nsel = 512;
        float q[8]; unpack8(*(const u32x4*)(PROJ + (size_t)t * NPB + PC_QSA + h * 128 + li * 8), q);
#pragma unroll
        for (int e = 0; e < 8; ++e) q[e] *= 0.08838834764831845f;
        float mx = -__builtin_inff();
        for (int j0 = 0; j0 < nsel; j0 += 16) {
            float d[4];
#pragma unroll
            for (int uu = 0; uu < 4; ++uu) { const int j = j0 + uu * 4 + g4; d[uu] = 0.f;
                if (j < nsel) { float k[8]; unpack8(*(const u32x4*)(PROJ + (size_t)idx[j] * NPB + PC_KSA + h * 128 + li * 8), k);
#pragma unroll
                    for (int e = 0; e < 8; ++e) d[uu] += q[e] * k[e]; } }
#pragma unroll
            for (int uu = 0; uu < 4; ++uu) { const int j = j0 + uu * 4 + g4; const float dd = row16_sum(d[uu]); if (j < nsel) { if (li == 0) lg[j] = dd; mx = fmaxf(mx, dd); } }
        }
        mx = wave_max(mx);
        LDS_WAIT();
        float o[8], den = 0.f;
#pragma unroll
        for (int e = 0; e < 8; ++e) o[e] = 0.f;
        for (int j0 = 0; j0 < nsel; j0 += 16) {
#pragma unroll
            for (int uu = 0; uu < 4; ++uu) { const int j = j0 + uu * 4 + g4;
                if (j < nsel) { const float pj = __expf(lg[j] - mx); den += pj; float v[8]; unpack8(*(const u32x4*)(PROJ + (size_t)idx[j] * NPB + PC_VSA + h * 128 + li * 8), v);
#pragma unroll
                    for (int e = 0; e < 8; ++e) o[e] += pj * v[e]; } }
        }
        den += __shfl_xor(den, 16); den += __shfl_xor(den, 32);
#pragma unroll
        for (int e = 0; e < 8; ++e) { o[e] += __shfl_xor(o[e], 16); o[e] += __shfl_xor(o[e], 32); }
        const float rd = 1.f / den;
#pragma unroll
        for (int e = 0; e < 8; ++e) o[e] *= rd;
        if (g4 == 0) *(u32x4*)(OSA + (size_t)t * 1024 + h * 128 + li * 8) = pack8(o);
        __syncthreads();
    }
}


namespace att {
constexpr int NW = 8, QBLK = 32, KVBLK = 64, QB = NW * QBLK, D = 128;
constexpr int SHM_V = KVBLK * D * 2, SHM_K = KVBLK * D * 2;
constexpr int LDS_NEED = 2 * SHM_V + 2 * SHM_K + NW * 64 * 4;
constexpr int PITCH = NPB, OPITCH = 128;
constexpr float SCALE = 0.08838834764831845f, THR = 8.f;
typedef short s16x4 __attribute__((ext_vector_type(4)));
#define KSWZ(row, colB) ((row) * 256 + ((colB) ^ (((row) & 7) << 4)))
#define SBAR() __builtin_amdgcn_sched_barrier(0)
__device__ __forceinline__ int v_st(int k, int c) { const int kk = (k & ~0xC) | ((k & 4) << 1) | ((k & 8) >> 1); return ((kk >> 3) * 4 + (c >> 5)) * 512 + ((kk & 7) * 32 + (c & 31)) * 2; }
__device__ __forceinline__ int v_rd_base(int lane) { return ((lane & 3) << 3) | (((lane >> 2) & 3) << 6) | (((lane >> 4) & 1) << 5) | (((lane >> 5) & 1) << 8); }
constexpr int v_rd_off(int d0, int ks, int half) { return d0 * 512 + ks * 4096 + half * 2048; }
__device__ __forceinline__ int crow(int r, int hi) { return (r & 3) + 8 * (r >> 2) + 4 * hi; }
__device__ __forceinline__ void partialSM(f32x16& p0, f32x16& p1, float& m_reg, float& mn, float& alpha) {
    float pmax = p0[0]; for (int r = 1; r < 16; ++r) pmax = fmaxf(pmax, p0[r]); for (int r = 0; r < 16; ++r) pmax = fmaxf(pmax, p1[r]);
    { auto rr = __builtin_amdgcn_permlane32_swap(__float_as_uint(pmax), __float_as_uint(pmax), false, false);
      pmax = fmaxf(__uint_as_float(rr[0]), __uint_as_float(rr[1])); }
    constexpr float C2 = 1.4426950408889634f * SCALE;
    if (__builtin_expect(__all((pmax - m_reg) * SCALE <= THR), 1)) { mn = m_reg; alpha = 1.f; }
    else { mn = fmaxf(m_reg, pmax); alpha = __builtin_amdgcn_exp2f((m_reg - mn) * C2); m_reg = mn; }
    const float mnL = -mn * C2;
    for (int r = 0; r < 16; ++r) p0[r] = fmaf(p0[r], C2, mnL); for (int r = 0; r < 16; ++r) p1[r] = fmaf(p1[r], C2, mnL);
    for (int r = 0; r < 16; ++r) p0[r] = __builtin_amdgcn_exp2f(p0[r]);
}
__device__ __forceinline__ void finishSM(f32x16& p0, f32x16& p1, float alpha, float& l_reg, bf16x8& pa0, bf16x8& pa1, bf16x8& pa2, bf16x8& pa3) {
    for (int r = 0; r < 16; ++r) p1[r] = __builtin_amdgcn_exp2f(p1[r]);
    float ps = 0; for (int r = 0; r < 16; ++r) ps += p0[r]; for (int r = 0; r < 16; ++r) ps += p1[r];
    { auto rr = __builtin_amdgcn_permlane32_swap(__float_as_uint(ps), __float_as_uint(ps), false, false);
      ps = __uint_as_float(rr[0]) + __uint_as_float(rr[1]); }
    l_reg = l_reg * alpha + ps;
#define PK4(P, B_, OUT) do { unsigned a0 = cvt_pk_bf16_asm(P[B_+0], P[B_+1]), a1 = cvt_pk_bf16_asm(P[B_+2], P[B_+3]);                          \
        unsigned b0 = cvt_pk_bf16_asm(P[B_+4], P[B_+5]), b1 = cvt_pk_bf16_asm(P[B_+6], P[B_+7]);                                             \
        auto r0 = __builtin_amdgcn_permlane32_swap(a0, b0, false, false); auto r1 = __builtin_amdgcn_permlane32_swap(a1, b1, false, false); \
        u32x4 w = {r0[0], r1[0], r0[1], r1[1]}; OUT = *reinterpret_cast<bf16x8*>(&w); } while (0)
    PK4(p0, 0, pa0); PK4(p0, 8, pa1); PK4(p1, 0, pa2); PK4(p1, 8, pa3);
#undef PK4
}
__device__ __forceinline__ void mask_init(f32x16& p0, f32x16& p1, u32x2 mw, int hi) {
    const int i0 = (int)~(mw.x >> (4 * hi)), i1 = (int)~(mw.y >> (4 * hi));
#pragma unroll
    for (int r = 0; r < 16; ++r) { const unsigned c = (r & 3) + 8 * (r >> 2);
        p0[r] = __uint_as_float((unsigned)__builtin_amdgcn_sbfe(i0, c, 1u) & 0xFF800000u);
        p1[r] = __uint_as_float((unsigned)__builtin_amdgcn_sbfe(i1, c, 1u) & 0xFF800000u); }
}
template <int KB>
__device__ __forceinline__ void qkt(f32x16& p0, f32x16& p1, const LAS char* K_lds, int r32, int hi, const bf16x8* qr, u32x2 mw) {
    mask_init(p0, p1, mw, hi);
    const LAS char* kb[4];
#pragma unroll
    for (int dd = 0; dd < 4; ++dd) kb[dd] = K_lds + KB * SHM_K + KSWZ(r32, (dd * 16 + hi * 8) * 2);
#pragma unroll
    for (int d0 = 0; d0 < 8; ++d0) { const LAS char* a = kb[d0 & 3] + (d0 >> 2) * 128;
        bf16x8 b0 = *(const LAS bf16x8*)(a);
        bf16x8 b1 = *(const LAS bf16x8*)(a + 32 * 256);
        p0 = __builtin_amdgcn_mfma_f32_32x32x16_bf16(b0, qr[d0], p0, 0, 0, 0);
        p1 = __builtin_amdgcn_mfma_f32_32x32x16_bf16(b1, qr[d0], p1, 0, 0, 0); }
}
template <int VB>
__device__ __forceinline__ void pv_tile(f32x16* o, int vb0, bf16x8 pa0, bf16x8 pa1, bf16x8 pa2, bf16x8 pa3) {
#define TRRD(dst, off) asm volatile("ds_read_b64_tr_b16 %0, %1 offset:%2" : "=&v"(dst) : "v"(vb0), "i"(off) : "memory")
#define PV_D0(d0) do { s16x4 l0, l1, l2, l3, h0, h1, h2, h3; constexpr int b_ = VB * SHM_V + v_rd_off(d0, 0, 0); \
        TRRD(l0, b_); TRRD(h0, b_ + 2048); TRRD(l1, b_ + 4096); TRRD(h1, b_ + 6144); TRRD(l2, b_ + 8192); TRRD(h2, b_ + 10240); TRRD(l3, b_ + 12288); TRRD(h3, b_ + 14336); \
        asm volatile("s_waitcnt lgkmcnt(0)" ::: "memory"); SBAR();   \
        o[d0] = __builtin_amdgcn_mfma_f32_32x32x16_bf16(pa0, (bf16x8){l0[0], l0[1], l0[2], l0[3], h0[0], h0[1], h0[2], h0[3]}, o[d0], 0, 0, 0);   \
        o[d0] = __builtin_amdgcn_mfma_f32_32x32x16_bf16(pa1, (bf16x8){l1[0], l1[1], l1[2], l1[3], h1[0], h1[1], h1[2], h1[3]}, o[d0], 0, 0, 0);   \
        o[d0] = __builtin_amdgcn_mfma_f32_32x32x16_bf16(pa2, (bf16x8){l2[0], l2[1], l2[2], l2[3], h2[0], h2[1], h2[2], h2[3]}, o[d0], 0, 0, 0);   \
        o[d0] = __builtin_amdgcn_mfma_f32_32x32x16_bf16(pa3, (bf16x8){l3[0], l3[1], l3[2], l3[3], h3[0], h3[1], h3[2], h3[3]}, o[d0], 0, 0, 0); } while (0)
    PV_D0(0); PV_D0(1); PV_D0(2); PV_D0(3);
#undef PV_D0
#undef TRRD
}
struct BlockRef { const char* Q; const char* K; bf16_t* O; float* ML; const char* M; int NT; };
struct Seam { bf16x8 qr[8]; bf16x8 st_v0, st_v1, st_k0, st_k1; };
constexpr int VOFFB = (PC_VSA - PC_KSA) * 2;
#define VMW() asm volatile("s_waitcnt vmcnt(0)" ::: "memory")
#define VMWN(n) asm volatile("s_waitcnt vmcnt(%0)" :: "i"(n) : "memory")
#define LD8(p) (*reinterpret_cast<const bf16x8*>(p))
#define KVB(t) (Kh + (size_t)(t) * (KVBLK * PITCH * 2))
#define SLOAD_H(kvb) do { const char* b_ = (kvb); S.st_v0 = LD8(b_ + VOFFB + koff0); S.st_v1 = LD8(b_ + VOFFB + koff1); S.st_k0 = LD8(b_ + koff0); S.st_k1 = LD8(b_ + koff1); } while (0)
#define SWRITE_HK(bf) do { *(LAS bf16x8*)(K_lds + (bf) * SHM_K + kws) = S.st_k0; *(LAS bf16x8*)(K_lds + (bf) * SHM_K + kws + 32 * 256) = S.st_k1; } while (0)
#define SWRITE_HV(bf) do { *(LAS bf16x8*)(V_lds + (bf) * SHM_V + vst0) = S.st_v0; *(LAS bf16x8*)(V_lds + (bf) * SHM_V + vst1) = S.st_v1; } while (0)
#define SWRITE_H(bf) do { SWRITE_HV(bf); SWRITE_HK(bf); } while (0)
#define MLOAD(t) (*(const u32x2*)(cur.M + (size_t)(t) * 256 + moff))
__device__ __forceinline__ void prime(const BlockRef& cur, LAS char* lds, Seam& S, int tid) {
    const int wid = __builtin_amdgcn_readfirstlane(tid >> 6), lane = tid & 63, r32 = lane & 31, hi = lane >> 5;
    const int sr = tid >> 4, sc = (tid & 15) * 8, kws = KSWZ(sr, sc * 2); LAS char* K_lds = lds + 2 * SHM_V;
    const unsigned koff0 = (unsigned)(sr * PITCH + sc) * 2u, koff1 = (unsigned)((32 + sr) * PITCH + sc) * 2u, qoff = (unsigned)((wid * QBLK + r32) * PITCH + hi * 8) * 2u;
    for (int d0 = 0; d0 < 8; ++d0) S.qr[d0] = LD8(cur.Q + qoff + d0 * 32);
    const char* Kh = cur.K;
    SLOAD_H(KVB(0)); VMW(); SWRITE_HK(0);
    __syncthreads();
}
__device__ __forceinline__ void block(const BlockRef& cur, const BlockRef& nxt, LAS char* lds, Seam& S, int tid) {
    const int wid = __builtin_amdgcn_readfirstlane(tid >> 6), lane = tid & 63, r32 = lane & 31, hi = lane >> 5;
    const int NT = cur.NT;
    LAS char* V_lds = lds; LAS char* K_lds = lds + 2 * SHM_V;
    LAS float* wsf = (LAS float*)(lds + 2 * SHM_V + 2 * SHM_K) + wid * 64; LAS float* al_l = wsf + 32;
    float m_reg = -1e30f, l_reg = 0; f32x16 o[4] = {};
    const int sr = tid >> 4, sc = (tid & 15) * 8, vst0 = v_st(sr, sc), vst1 = v_st(32 + sr, sc), kws = KSWZ(sr, sc * 2);
    const unsigned koff0 = (unsigned)(sr * PITCH + sc) * 2u, koff1 = (unsigned)((32 + sr) * PITCH + sc) * 2u, qoff = (unsigned)((wid * QBLK + r32) * PITCH + hi * 8) * 2u;
    const unsigned moff = (unsigned)(wid * (128 * 64 * 4) + r32 * 8);
    const int vb0 = (int)(unsigned)(unsigned long long)V_lds + v_rd_base(lane);
    const char* Kh = cur.K;
#define RESC(a) do { if (__any((a) < 1.f)) { if (hi == 0) al_l[r32] = (a); asm volatile("s_waitcnt lgkmcnt(0)" ::: "memory");              \
                     for (int d_ = 0; d_ < 4; ++d_) for (int r = 0; r < 16; ++r) o[d_][r] *= al_l[crow(r, hi)]; } } while (0)
    constexpr int NQL = 8;
#define SEAM_K0() do { VMWN(NQL); SWRITE_HK(0); SBAR(); } while (0)
    f32x16 pA0, pA1, pB0, pB1; float mnA, mnB, alA, alB; bf16x8 pa0, pa1, pa2, pa3;
    u32x2 mw = MLOAD(0);
    SWRITE_HV(0); SBAR();
    if (NT > 1) SLOAD_H(KVB(1));
    SBAR(); qkt<0>(pA0, pA1, K_lds, r32, hi, S.qr, mw);
    if (NT > 1) mw = MLOAD(1);
    partialSM(pA0, pA1, m_reg, mnA, alA);
    if (NT > 1) { VMWN(1); SWRITE_H(1); }
    __syncthreads();
#define HALF_STEP(PX0, PX1, mnX, alX, PY0, PY1, alY, t, KB, VB, SB) do {                                                      \
        SBAR(); qkt<KB>(PX0, PX1, K_lds, r32, hi, S.qr, mw);                                             \
        finishSM(PY0, PY1, alY, l_reg, pa0, pa1, pa2, pa3); SBAR();                                                           \
        if ((t) + 1 < NT) { SLOAD_H(KVB((t) + 1)); mw = MLOAD((t) + 1); SBAR(); }                                               \
        pv_tile<VB>(o, vb0, pa0, pa1, pa2, pa3); partialSM(PX0, PX1, m_reg, mnX, alX);                                        \
        __syncthreads();                                                                                                      \
        if ((t) + 1 < NT) { VMWN(1); SWRITE_H(SB); }                                                                          \
        RESC(alX); __syncthreads(); } while (0)
    for (int t = 1; t + 1 < NT; t += 2) {
        HALF_STEP(pB0, pB1, mnB, alB, pA0, pA1, alA, t, 1, 0, 0);
        HALF_STEP(pA0, pA1, mnA, alA, pB0, pB1, alB, t + 1, 0, 1, 1);
    }
    const bool even = (NT & 1) == 0;
    if (even) { SBAR(); qkt<1>(pB0, pB1, K_lds, r32, hi, S.qr, mw); SBAR(); }
    { const char* Kh = nxt.K; SLOAD_H(KVB(0)); } SBAR();
#pragma unroll
    for (int d0 = 0; d0 < 8; ++d0) S.qr[d0] = LD8(nxt.Q + qoff + d0 * 32);
    SBAR();
    finishSM(pA0, pA1, alA, l_reg, pa0, pa1, pa2, pa3); SBAR();
    pv_tile<0>(o, vb0, pa0, pa1, pa2, pa3);
    if (even) { partialSM(pB0, pB1, m_reg, mnB, alB); __syncthreads(); RESC(alB);
        finishSM(pB0, pB1, alB, l_reg, pa0, pa1, pa2, pa3); SBAR(); pv_tile<1>(o, vb0, pa0, pa1, pa2, pa3); }
    SBAR(); SEAM_K0();
    int r32e = r32; asm volatile("" : "+v"(r32e));
    if (hi == 0) { f32x2 ml; ml.x = m_reg; ml.y = l_reg; *(f32x2*)((char*)cur.ML + (unsigned)(wid * QBLK + r32e) * 8u) = ml; }
    char* Ow = (char*)cur.O; const unsigned ooff = (unsigned)((wid * QBLK) * OPITCH + r32e) * 2u;
#pragma unroll
    for (int r = 0; r < 16; ++r) { const int orow = crow(r, hi);
#pragma unroll
        for (int d0 = 0; d0 < 4; ++d0) { const float v = o[d0][r];
            const float vn = __shfl_xor(v, 1);
            if ((r32 & 1) == 0) *(unsigned*)(Ow + ooff + (unsigned)(orow * OPITCH + d0 * 32) * 2u) = cvt_pk_bf16_asm(v, vn); } }
    __syncthreads();
#undef RESC
#undef SEAM_K0
#undef HALF_STEP
}
#undef KVB
#undef VMW
#undef VMWN
#undef LD8
#undef SLOAD_H
#undef SWRITE_HK
#undef SWRITE_HV
#undef SWRITE_H
#undef MLOAD
#undef KSWZ
#undef SBAR
}

constexpr int AT_NPARTS = 96;
__constant__ unsigned char AT_SCHED[32][3] = {{159,154,20}, {127,122,47}, {63,58,15}, {121,117,115}, {89,85,83}, {57,53,51}, {25,21,19}, {82,16,78}, {44,79,46}, {12,42,14}, {95,28,41}, {31,155,9}, {158,91,4}, {126,118,77}, {94,86,45}, {62,54,13}, {120,22,40}, {88,80,8}, {56,48,39}, {24,123,10}, {50,59,90}, {18,27,26}, {30,23,7}, {157,81,3}, {125,49,38}, {93,17,6}, {61,43,2}, {29,11,1}, {156,5,0}, {119,124,116}, {87,92,84}, {55,60,52}};
__constant__ unsigned char AT_NPART[32] = {1,1,1,1,1,1,2,2,2,2,2,2,2,3,3,3,3,3,3,4,4,4,4,4,4,4,5,5,5,5,5,5};
__constant__ unsigned char AT_PBASE[32] = {0,1,2,3,4,5,6,8,10,12,14,16,18,20,23,26,29,32,35,38,42,46,50,54,58,62,66,71,76,81,86,91};
constexpr size_t AT_PARTO_BYTES = (size_t)256 * 128 * 2, AT_ML_OFF = (size_t)DNH * AT_NPARTS * AT_PARTO_BYTES;
__device__ __forceinline__ void p_attn(const Ctx& c) {
    unsigned char* ws = c.ws;
    const bf16_t* PROJ = (const bf16_t*)(ws + WS_PROJ); const unsigned* MASKT = (const unsigned*)(ws + WS_MASK);
    const int h = c.bx & 7, slot = c.bx >> 3;
    if (slot >= 32) return;
    auto ref = [&](int j) { const int e = AT_SCHED[slot][j]; const int qb = e & 31, p = e >> 5, np = AT_NPART[qb], nt = 4 * (qb + 1), lo = (p * nt) / np, hi2 = ((p + 1) * nt) / np; att::BlockRef r;
        const size_t pi = (size_t)h * AT_NPARTS + AT_PBASE[qb] + p;
        r.Q = (const char*)(PROJ + (size_t)qb * att::QB * NPB + PC_QSA + h * 128); r.K = (const char*)(PROJ + (size_t)lo * 64 * NPB + PC_KSA + h * 128);
        r.O = (bf16_t*)(ws + WS_DNF + pi * AT_PARTO_BYTES); r.ML = (float*)(ws + WS_DNF + AT_ML_OFF + pi * 2048);
        r.M = (const char*)(MASKT + (size_t)qb * 8 * (128 * 64)) + (size_t)lo * 256; r.NT = hi2 - lo; return r; };
    int nit = 0;
    for (int j = 0; j < 3; ++j) nit += AT_SCHED[slot][j] != 255 ? 1 : 0;
    att::BlockRef cur = ref(0); att::Seam Sm;
    att::prime(cur, (LAS char*)c.lds, Sm, c.tid);
    for (int j = 0; j < nit; ++j) { const bool more = j + 1 < nit; const att::BlockRef nxt = more ? ref(j + 1) : cur;
        att::block(cur, nxt, (LAS char*)c.lds, Sm, c.tid);
        cur = nxt; }
}
__device__ __forceinline__ void p_attn_merge(const Ctx& c) {
    unsigned char* ws = c.ws; unsigned char* OSA = ws + WS_OSA8;
    constexpr float C2 = 1.4426950408889634f * att::SCALE;
    constexpr int MAXP = 5;
    for (int u = c.gw; u < DNH * 32 * 32; u += c.NGW) {
        const int rg = u & 31, h = u >> 10, qb = (((u >> 5) & 31) + 8 * (h >> 1)) & 31, np = AT_NPART[qb]; const size_t pi0 = (size_t)h * AT_NPARTS + AT_PBASE[qb];
        const int row = rg * 8 + (c.lane >> 3), cg = (c.lane & 7) * 16;
        f32x2 ml[MAXP]; u32x4 o0[MAXP], o1[MAXP];
#pragma unroll
        for (int p = 0; p < MAXP; ++p) { const size_t pi = pi0 + (p < np ? p : np - 1);
            ml[p] = *(const f32x2*)(ws + WS_DNF + AT_ML_OFF + pi * 2048 + 8 * row);
            const bf16_t* op = (const bf16_t*)(ws + WS_DNF + pi * AT_PARTO_BYTES) + row * 128 + cg; o0[p] = *(const u32x4*)op; o1[p] = *(const u32x4*)(op + 8); }
        float M = -1e30f;
#pragma unroll
        for (int p = 0; p < MAXP; ++p) M = fmaxf(M, ml[p].x);
        float acc[16], den = 0.f;
#pragma unroll
        for (int e = 0; e < 16; ++e) acc[e] = 0.f;
#pragma unroll
        for (int p = 0; p < MAXP; ++p) { const float w = p < np ? __builtin_amdgcn_exp2f((ml[p].x - M) * C2) : 0.f; den += w * ml[p].y;
            float v[16]; unpack8(o0[p], v); unpack8(o1[p], v + 8);
#pragma unroll
            for (int e = 0; e < 16; ++e) acc[e] += w * v[e]; }
        const float rd = F8_OSA / den;
#pragma unroll
        for (int e = 0; e < 16; ++e) acc[e] *= rd;
        unsigned char* o = OSA + (size_t)(qb * 256 + row) * 1024 + h * 128 + cg; u32x4 w; w.x = cvt4_fp8c(acc[0], acc[1], acc[2], acc[3]); w.y = cvt4_fp8c(acc[4], acc[5], acc[6], acc[7]); w.z = cvt4_fp8c(acc[8], acc[9], acc[10], acc[11]); w.w = cvt4_fp8c(acc[12], acc[13], acc[14], acc[15]); *(u32x4*)o = w;
    }
}

__device__ __forceinline__ void p_moe_dispatch(const Ctx& c) {
    unsigned char* ws = c.ws;
    const u32x4* SEL = (const u32x4*)(ws + WS_ROUTE + RT_SEL); int* TOKROW = (int*)(ws + WS_ROUTE + RT_TOKROW); float* ROWW = (float*)(ws + WS_ROUTE + RT_ROWW);
    const bf16_t* XN = (const bf16_t*)(ws + WS_XN); bf16_t* AS = (bf16_t*)(ws + WS_AS);
    LAS int* tot = (LAS int*)c.lds;
    LAS int* rowof = (LAS int*)(c.lds + 1024);
    const int ntok_blk = S / c.G;
    const int tb0 = c.bx * ntok_blk;
    if (c.tid < 16) tot[c.tid] = 0;
    __syncthreads();
    { int ct[NEXP], cb[NEXP];
#pragma unroll
        for (int e = 0; e < NEXP; ++e) { ct[e] = 0; cb[e] = 0; }
        for (int t = c.tid; t < S; t += 512) { const u32x4 r = SEL[t]; const bool before = t < tb0;
#pragma unroll
            for (int e = 0; e < NEXP; ++e) { const int hit = ((int)r.x == e) + ((int)r.y == e); ct[e] += hit; cb[e] += before ? hit : 0; } }
#pragma unroll
        for (int e = 0; e < NEXP; ++e) { int a = ct[e], b = cb[e];
#pragma unroll
            for (int o = 1; o < 64; o <<= 1) { a += __shfl_xor(a, o); b += __shfl_xor(b, o); }
            if (c.lane == 0) { __hip_atomic_fetch_add(&tot[e], a, __ATOMIC_RELAXED, __HIP_MEMORY_SCOPE_WORKGROUP); __hip_atomic_fetch_add(&tot[8 + e], b, __ATOMIC_RELAXED, __HIP_MEMORY_SCOPE_WORKGROUP); } } }
    __syncthreads();
    if (c.tid == 0) { int off = 0; for (int e = 0; e < NEXP; ++e) { tot[16 + e] = off; off += ((tot[e] + 255) >> 8) << 8; }
        int fill[NEXP]; for (int e = 0; e < NEXP; ++e) fill[e] = tot[16 + e] + tot[8 + e];
        for (int i = 0; i < ntok_blk; ++i) { const int t = tb0 + i; const u32x4 r = SEL[t]; const int r0 = fill[r.x]++; const int r1 = fill[r.y]++;
            rowof[2 * i] = r0; rowof[2 * i + 1] = r1; TOKROW[2 * t] = r0; TOKROW[2 * t + 1] = r1; ROWW[r0] = __uint_as_float(r.z); ROWW[r1] = __uint_as_float(r.w); } }
    __syncthreads();
    for (int s = c.wave; s < 2 * ntok_blk; s += 8) { const int t = tb0 + (s >> 1); const u32x4* src = (const u32x4*)((const unsigned char*)XN + (size_t)t * DM); u32x4* dst = (u32x4*)((unsigned char*)AS + (size_t)rowof[s] * DM);
#pragma unroll
        for (int j = 0; j < 2; ++j) dst[c.lane + 64 * j] = src[c.lane + 64 * j]; }
    if (c.bx == 0 && c.tid < NEXP) { const int e = c.tid; const int lo = tot[16 + e] + tot[e], hi = tot[16 + e] + (((tot[e] + 255) >> 8) << 8); for (int r = lo; r < hi; ++r) ROWW[r] = 0.f; }
    __syncthreads();
}
__device__ __forceinline__ int moe_tiles(const Ctx& c, LAS int* te) {
    const u32x4* SEL = (const u32x4*)(c.ws + WS_ROUTE + RT_SEL);
    LAS int* tot = te + 128;
    if (c.tid < 8) tot[c.tid] = 0;
    __syncthreads();
    { int ct[NEXP];
#pragma unroll
        for (int e = 0; e < NEXP; ++e) ct[e] = 0;
        for (int t = c.tid; t < S; t += 512) { const u32x4 r = SEL[t];
#pragma unroll
            for (int e = 0; e < NEXP; ++e) ct[e] += ((int)r.x == e) + ((int)r.y == e); }
#pragma unroll
        for (int e = 0; e < NEXP; ++e) { int a = ct[e];
#pragma unroll
            for (int o = 1; o < 64; o <<= 1) a += __shfl_xor(a, o);
            if (c.lane == 0) __hip_atomic_fetch_add(&tot[e], a, __ATOMIC_RELAXED, __HIP_MEMORY_SCOPE_WORKGROUP); } }
    __syncthreads();
    if (c.tid == 0) { int rt = 0; for (int e = 0; e < NEXP; ++e) { const int nt = (tot[e] + 255) >> 8; for (int i = 0; i < nt; ++i) te[rt++] = e; } tot[8] = rt; }
    __syncthreads();
    const int nrt = tot[8];
    return nrt;
}
__device__ __forceinline__ void p_final(const Ctx& c) {
    unsigned char* ws = c.ws;
    const float* X = (const float*)(ws + WS_X); const bf16_t* YS = (const bf16_t*)(ws + WS_YS); const int* TOKROW = (const int*)(ws + WS_ROUTE + RT_TOKROW);
    const float* fng = inptr<const float>(c, IN_FINAL_NORM); float* outp = inptr<float>(c, IN_OUT);
    for (int t = c.gw; t < S; t += c.NGW) {
        const int r0 = TOKROW[2 * t], r1 = TOKROW[2 * t + 1];
        float v[32]; float ss = 0.f;
#pragma unroll
        for (int j = 0; j < 4; ++j) { const int col = 512 * j + c.lane * 8; float a[8], b[8]; unpack8(*(const u32x4*)(YS + (size_t)r0 * DM + col), a); unpack8(*(const u32x4*)(YS + (size_t)r1 * DM + col), b);
            const f32x4 x0 = *(const f32x4*)(X + (size_t)t * DM + col), x1 = *(const f32x4*)(X + (size_t)t * DM + col + 4);
#pragma unroll
            for (int e = 0; e < 4; ++e) { v[8 * j + e] = x0[e] + a[e] + b[e]; v[8 * j + 4 + e] = x1[e] + a[4 + e] + b[4 + e]; }
#pragma unroll
            for (int e = 0; e < 8; ++e) ss += v[8 * j + e] * v[8 * j + e]; }
        const float rstd = rsqrtf(wave_sum(ss) * (1.f / DM) + RMS_EPS);
#pragma unroll
        for (int j = 0; j < 4; ++j) { const int col = 512 * j + c.lane * 8; const f32x4 g0 = *(const f32x4*)(fng + col), g1 = *(const f32x4*)(fng + col + 4); f32x4 o0, o1;
#pragma unroll
            for (int e = 0; e < 4; ++e) { o0[e] = v[8 * j + e] * rstd * g0[e]; o1[e] = v[8 * j + 4 + e] * rstd * g1[e]; }
            *(f32x4*)(outp + (size_t)t * DM + col) = o0; *(f32x4*)(outp + (size_t)t * DM + col + 4) = o1; }
    }
}

constexpr int PH_PER_LAYER = 12;
constexpr int N_PHASES = 1 + (PH_PER_LAYER - 3) + (PH_PER_LAYER - 1) + 1;
__global__ void __launch_bounds__(512, 2) mega_fwd(Params p) {
    extern __shared__ __attribute__((aligned(16))) unsigned char lds_raw[];
    Ctx c0; { Ctx& c = c0; c.lds = (LAS unsigned char*)lds_raw; c.tid = threadIdx.x; c.bx = blockIdx.x; c.lane = c.tid & 63; c.wave = __builtin_amdgcn_readfirstlane(c.tid >> 6);
    c.G = gridDim.x; c.gw = (int)blockIdx.x * 8 + c.wave; c.NGW = c.G * 8; c.ws = p.ws; }
    const Ctx& c = c0;
    for (int u = c.tid; u < (LDS_BYTES - LDSCTL_OFF) / 4; u += 512) ((LAS unsigned*)(c.lds + LDSCTL_OFF))[u] = 0u;
    __syncthreads();
    if (c.tid < IN_COUNT) { const unsigned long long v = (unsigned long long)p.in[c.tid]; LAS unsigned* tab = (LAS unsigned*)(c.lds + PTAB_OFF); tab[2 * c.tid] = (unsigned)v; tab[2 * c.tid + 1] = (unsigned)(v >> 32); }
    __syncthreads();
    XcdBarrier bar = xcd_barrier_post((unsigned*)(c.ws + WS_CTL) + CW_BAR, (volatile LAS unsigned*)(c.lds + MISC_OFF) + 8);
    const int lo = p.ph_lo, hi = p.ph_hi;
    int ph = 0;
#define PHASE_BEGIN if (ph >= lo && ph < hi) { const Ctx c = launder(c0);
#define PHASE_END   if (ph + 1 < hi) { XcdBarrier b2 = bar; unsigned long long bp = (unsigned long long)b2.bar; asm volatile("" : "+s"(bp), "+s"(b2.x)); b2.bar = (unsigned*)(GAS unsigned*)bp; xcd_barrier(b2); } } ++ph;
#define WSP(T, off) ((T*)(c.ws + (off)))

    PHASE_BEGIN p_prologue(c); { const Ctx c8 = launder(c0); p_norm<false, false, true>(c8, inptr<const float>(c8, IN_X), nullptr); } PHASE_END

#define LAYER_BODY(l) {\
        PHASE_BEGIN { pg8::StaticOrder so; so.init(WSP(const bf16_t, WS_XN), WSP(const bf16_t, WS_WIN) + (size_t)l * NPW * DM, S, NPH, DM, c.G, c.bx); \
            pg8::EpiProj E{WSP(bf16_t, WS_PROJ), 0, l == 0 ? nullptr : WSP(const unsigned long long, WS_ROUTE + RT_SS) + S}; pg8::gemm_phase<pg8::EpiProj, pg8::StaticOrder>(c.lds, c.tid, DM, so, E); } \
          { pg8::StaticOrder so; so.init(WSP(const bf16_t, WS_XN8), (const bf16_t*)(c.ws + WS_WIN + (size_t)l * NPW * DM * 2 + WIN8_OFF), S, NPB - NPH, DM / 2, c.G, c.bx); \
            pg8::EpiProj E{WSP(bf16_t, WS_PROJ), NPH, l == 0 ? nullptr : WSP(const unsigned long long, WS_ROUTE + RT_SS) + S}; pg8::gemm_phase<pg8::EpiProj, pg8::StaticOrder, true, true, true>(c.lds, c.tid, DM / 2, so, E, F8_SC_WIN, 127); } \
          { pg8::SplitKOrder so; so.nM = S / 256; so.nks = SMALL_KS; so.G = c.G; so.c = c.bx; so.A = (const char*)WSP(const bf16_t, WS_XN); so.Bt = (const char*)(WSP(const bf16_t, WS_WIN) + ((size_t)l * NPW + NPH) * DM); so.tstep = (size_t)256 * DM * 2; so.ksb = (DM / SMALL_KS) * 2; \
            pg8::EpiSmallPart E{WSP(float, WS_MERGED), l == 0 ? nullptr : WSP(const unsigned long long, WS_ROUTE + RT_SS) + S}; pg8::gemm_phase<pg8::EpiSmallPart, pg8::SplitKOrder>(c.lds, c.tid, DM / SMALL_KS, so, E, 127, 127, DM); } PHASE_END \
        PHASE_BEGIN if (c.wave >= 4) { const Ctx c5 = launder(c0); p_prep(c5, l, c5.bx * 4 + c5.wave - 4, c5.G * 4); } else { const Ctx c6 = launder(c0); p_dn_intra(c6, l); } PHASE_END \
        PHASE_BEGIN if (c.bx < 8) dn::scan_head(c, c.bx); else if (c.bx < 64) { const Ctx c7 = launder(c0); p_convert(c7, l == 0 ? 4 : 17, l == 0 ? 17 : 35, (c7.bx - 8) * 8 + c7.wave, 56 * 8); } { const Ctx c8 = launder(c0); p_select(c8, l); } PHASE_END \
        PHASE_BEGIN p_dn_post(c, l); { const Ctx c2 = launder(c0); p_attn(c2); } PHASE_END \
        PHASE_BEGIN p_attn_merge(c); PHASE_END \
        PHASE_BEGIN { pg8::StaticOrder so; so.init(WSP(const bf16_t, WS_ODN), WSP(const bf16_t, WS_WDN + (size_t)l * DM * DNW), S, DM, DNW / 2, c.G, c.bx); \
            pg8::EpiGate<false> E{WSP(bf16_t, WS_MERGED), nullptr, WSP(const bf16_t, WS_PROJ) + PC_GDN}; pg8::gemm_phase<pg8::EpiGate<false>, pg8::StaticOrder, true, true, true>(c.lds, c.tid, DNW / 2, so, E, F8_SC_WY, F8_SC_ODN); } \
          { pg8::StaticOrder so; so.init(WSP(const bf16_t, WS_OSA8), WSP(const bf16_t, WS_WSA + (size_t)l * DM * DNW), S, DM, DNW / 2, c.G, c.bx); \
            pg8::EpiGate<true> E{WSP(bf16_t, WS_MERGED), WSP(unsigned char, WS_M8), WSP(const bf16_t, WS_PROJ) + PC_GSA}; pg8::gemm_phase<pg8::EpiGate<true>, pg8::StaticOrder, true, true, true>(c.lds, c.tid, DNW / 2, so, E, F8_SC_WY, F8_SC_OSA); } PHASE_END \
        PHASE_BEGIN { pg8::StaticOrder so; so.init(WSP(const bf16_t, WS_M8), WSP(const bf16_t, WS_WO + (size_t)l * DM * DM), S, DM, DM / 2, c.G, c.bx); \
            if (l == 0) { pg8::EpiResidN<true> E{inptr<const float>(c, IN_X), WSP(float, WS_X), WSP(void, WS_XN), WSP(unsigned long long, WS_ROUTE + RT_SS), nullptr}; pg8::gemm_phase<pg8::EpiResidN<true>, pg8::StaticOrder, true, true, true>(c.lds, c.tid, DM / 2, so, E, F8_SC_WO, F8_SC_MRG); } \
            else { pg8::EpiResid E{WSP(const float, WS_X), WSP(float, WS_X)}; pg8::gemm_phase<pg8::EpiResid, pg8::StaticOrder, true, true, true>(c.lds, c.tid, DM / 2, so, E, F8_SC_WO, F8_SC_MRG); } } PHASE_END \
        if (l == 1) { PHASE_BEGIN p_norm<true, true>(c, WSP(const float, WS_X), inptr<const float>(c, IN_NORM_FFN) + DM); PHASE_END } \
        if (l == 1) { PHASE_BEGIN p_moe_dispatch(c); PHASE_END } \
        PHASE_BEGIN if (l == 0) { pg8::StaticOrder so; so.init(WSP(const bf16_t, WS_XN), WSP(const bf16_t, WS_WGU0), S, 2 * DFF, DM / 2, c.G, c.bx); \
                pg8::EpiSwiglu8 E{WSP(unsigned char, WS_HID), DFF, F8_HID, WSP(const unsigned long long, WS_ROUTE + RT_SS)}; pg8::gemm_phase<pg8::EpiSwiglu8, pg8::StaticOrder, true, true, true>(c.lds, c.tid, DM / 2, so, E, F8_SC_WGU, 127); } \
            else { LAS int* te = (LAS int*)(c.lds + MISC_OFF + 1024); const int nrt = moe_tiles(c, te); \
                pg8::GroupOrder go; go.so.init(WSP(const bf16_t, WS_AS), WSP(const bf16_t, WS_WGU1), nrt * 256, 2 * DFE, DM / 2, c.G, c.bx); go.te = te; go.estride = (size_t)2 * DFE * DM; \
                pg8::EpiSwiglu8 E{WSP(unsigned char, WS_HIDM), DFE, F8_HID, nullptr}; pg8::gemm_phase<pg8::EpiSwiglu8, pg8::GroupOrder, true, true, true>(c.lds, c.tid, DM / 2, go, E, F8_SC_WGU, 127); } PHASE_END \
        PHASE_BEGIN if (l == 0) { pg8::StaticOrder so; so.init(WSP(const bf16_t, WS_HID), WSP(const bf16_t, WS_WD0), S, DM, DFF / 2, c.G, c.bx); \
                pg8::EpiResidN<false> E{WSP(const float, WS_X), WSP(float, WS_X), WSP(void, WS_XN), WSP(unsigned long long, WS_ROUTE + RT_SS) + S, WSP(unsigned char, WS_XN8)}; pg8::gemm_phase<pg8::EpiResidN<false>, pg8::StaticOrder, true, true, true>(c.lds, c.tid, DFF / 2, so, E, F8_SC_WD, F8_SC_HID); } \
            else { LAS int* te = (LAS int*)(c.lds + MISC_OFF + 1024); const int nrt = moe_tiles(c, te); \
                pg8::GroupOrder go; go.so.init(WSP(const bf16_t, WS_HIDM), WSP(const bf16_t, WS_WD1), nrt * 256, DM, DFE / 2, c.G, c.bx); go.te = te; go.estride = (size_t)DM * DFE; \
                pg8::EpiMoeDown E{WSP(bf16_t, WS_YS), WSP(const float, WS_ROUTE + RT_ROWW)}; pg8::gemm_phase<pg8::EpiMoeDown, pg8::GroupOrder, true, true, true>(c.lds, c.tid, DFE / 2, go, E, F8_SC_WD, F8_SC_HID); } PHASE_END \
    }
    LAYER_BODY(0)
    LAYER_BODY(1)
#undef LAYER_BODY
    PHASE_BEGIN p_final(c); PHASE_END
#undef PHASE_BEGIN
#undef PHASE_END
#undef WSP
}

extern "C" void kernel_launch(void* const* d_in, const int* in_sizes, int n_in, void* d_out, int out_size, void* d_ws, size_t ws_size, hipStream_t stream) {
    static int grid = 0;
    if (grid == 0) {
        if (n_in != 20 || in_sizes[0] != S * DM || out_size != S * DM || ws_size < WS_END) { fprintf(stderr, "kernel_launch: unexpected shapes (n_in %d, in0 %d, out %d, ws %zu < %zu)\n", n_in, n_in > 0 ? in_sizes[0] : -1, out_size, ws_size, (size_t)WS_END); grid = -1; return; }
        int dev = 0, cus = 0, per_cu = 0;
        if (hipGetDevice(&dev) != hipSuccess || hipDeviceGetAttribute(&cus, hipDeviceAttributeMultiprocessorCount, dev) != hipSuccess) { grid = -1; return; }
        if (hipFuncSetAttribute((const void*)mega_fwd, hipFuncAttributeMaxDynamicSharedMemorySize, LDS_BYTES) != hipSuccess) { fprintf(stderr, "kernel_launch: hipFuncSetAttribute failed\n"); grid = -1; return; }
        if (hipOccupancyMaxActiveBlocksPerMultiprocessor(&per_cu, (const void*)mega_fwd, 512, LDS_BYTES) != hipSuccess || per_cu < 1) fprintf(stderr, "kernel_launch: occupancy query reports %d blocks per CU\n", per_cu);
        (void)hipGetLastError();
        grid = cus;
        if (grid != 256) { fprintf(stderr, "kernel_launch: %d CUs (this kernel is laid out for 256)\n", grid); grid = -1; return; }
    }
    if (grid < 0) return;
    (void)hipMemsetAsync((char*)d_ws + WS_CTL, 0, CTL_ZERO_BYTES, stream);
    Params p{};
    for (int i = 0; i < 20; ++i) p.in[i] = d_in[i];
    p.in[IN_OUT] = d_out; p.ws = (unsigned char*)d_ws; p.ph_lo = 0; p.ph_hi = N_PHASES;
    hipLaunchKernelGGL(mega_fwd, dim3(grid), dim3(512), LDS_BYTES, stream, p);
}
```
